# Optimizing an MI355X kernel written in HIP

```python
import math
import jax, jax.numpy as jnp
from jax import lax
import numpy as np

D_MODEL = 4096
BATCH = 2
SEQ = 4096
DEPTH = 1

MIX_WIDTH = D_MODEL
ML_HEADS = 8
ML_DV = MIX_WIDTH // 2 // ML_HEADS
ML_DQK = ML_DV // 2
ML_WIDTH = ML_HEADS * ML_DV
ML_QK_WIDTH = ML_HEADS * ML_DQK
ML_CHUNK = 64
ML_CONV = 4
NSA_HEADS = 16
NSA_HD = (MIX_WIDTH - ML_WIDTH) // NSA_HEADS
NSA_GROUPS = 4
NSA_HPG = NSA_HEADS // NSA_GROUPS
NSA_WIDTH = NSA_HEADS * NSA_HD
NSA_KV_WIDTH = NSA_GROUPS * NSA_HD
CMP_STRIDE = 16
CMP_LEN = 2 * CMP_STRIDE
CMP_HIDDEN = 2 * NSA_HD
SEL_LEN = 64
SEL_TOPK = 16
SEL_QBLOCK = 64
WIN = 512
WIN_QBLOCK = 128
N_BRANCH = 3
REL_BUCKETS = 32
REL_MAX_DIST = 128
PLE_DIM = 256
EPS = 1e-6
NEG_INF = -1e30
FORCE_SCORE = 1e4
IN_SPLITS = (ML_QK_WIDTH, ML_QK_WIDTH, ML_WIDTH, ML_WIDTH, ML_WIDTH, ML_HEADS, ML_HEADS,
             NSA_WIDTH, NSA_KV_WIDTH, NSA_KV_WIDTH, NSA_KV_WIDTH, NSA_KV_WIDTH,
             NSA_KV_WIDTH, NSA_KV_WIDTH, NSA_HEADS * N_BRANCH, NSA_WIDTH)
IN_WIDTH = sum(IN_SPLITS)

kernel_name = 'hymba_mlstm_nsa_block'


def _split(u, widths):
    offs = np.cumsum(widths)[:-1].tolist()
    return jnp.split(u, offs, axis=-1)


def _rmsnorm(x, w):
    xf = x.astype(jnp.float32)
    y = xf * lax.rsqrt(jnp.mean(xf * xf, axis=-1, keepdims=True) + EPS)
    return (y * w.astype(jnp.float32)).astype(x.dtype)


def _causal_conv(x, w):
    K, S = w.shape[0], x.shape[1]
    xp = jnp.pad(x, ((0, 0), (K - 1, 0), (0, 0)))
    return sum(xp[:, j:j + S] * w[j] for j in range(K))


def _rel_bucket(dist):
    n = jnp.maximum(dist, 0)
    max_exact = REL_BUCKETS // 2
    nf = jnp.maximum(n, 1).astype(jnp.float32)
    large = max_exact + (jnp.log(nf / max_exact) / math.log(REL_MAX_DIST / max_exact)
                         * (REL_BUCKETS - max_exact)).astype(jnp.int32)
    large = jnp.minimum(large, REL_BUCKETS - 1)
    return jnp.where(n < max_exact, n, large)


def _masked_softmax(scores, mask):
    s = jnp.where(mask, scores, NEG_INF)
    return jnp.where(mask, jax.nn.softmax(s, axis=-1), 0.0)


def _mlstm(q, k, v, log_i, log_f):
    B, S, NH, _ = q.shape
    nc = S // ML_CHUNK

    def to_chunks(a):
        a = a.astype(jnp.float32).reshape((B, nc, ML_CHUNK) + a.shape[2:])
        return jnp.swapaxes(jnp.moveaxis(a, 1, 0), 2, 3)

    tril = jnp.tril(jnp.ones((ML_CHUNK, ML_CHUNK), dtype=bool))

    def step(carry, xs):
        C, n, m = carry
        qc, kc, vc, li, lf = xs
        b = jnp.cumsum(lf, axis=-1)
        D = jnp.where(tril, b[..., :, None] - b[..., None, :] + li[..., None, :], -jnp.inf)
        a = b + m[..., None]
        m_t = jnp.maximum(a, jnp.max(D, axis=-1))
        Dw = jnp.exp(D - m_t[..., None])
        inter = jnp.exp(a - m_t)
        sc = jnp.einsum('bhtd,bhsd->bhts', qc, kc) * Dw
        num = inter[..., None] * jnp.einsum('bhtd,bhdv->bhtv', qc, C) + jnp.einsum('bhts,bhsv->bhtv', sc, vc)
        den = inter * jnp.einsum('bhtd,bhd->bht', qc, n) + jnp.sum(sc, axis=-1)
        h = num / jnp.maximum(jnp.abs(den), jnp.exp(-m_t))[..., None]
        bL = b[..., -1]
        w = bL[..., None] - b + li
        m_new = jnp.maximum(bL + m, jnp.max(w, axis=-1))
        wk = jnp.exp(w - m_new[..., None])
        decay = jnp.exp(bL + m - m_new)
        C_new = decay[..., None, None] * C + jnp.einsum('bhs,bhsd,bhsv->bhdv', wk, kc, vc)
        n_new = decay[..., None] * n + jnp.einsum('bhs,bhsd->bhd', wk, kc)
        return (C_new, n_new, m_new), h

    init = (jnp.zeros((B, NH, ML_DQK, ML_DV), jnp.float32),
            jnp.zeros((B, NH, ML_DQK), jnp.float32),
            jnp.zeros((B, NH), jnp.float32))
    _, h = lax.scan(step, init, (to_chunks(q), to_chunks(k), to_chunks(v),
                                 to_chunks(log_i), to_chunks(log_f)))
    h = jnp.moveaxis(jnp.swapaxes(h, 2, 3), 0, 1)
    return h.reshape(B, S, NH, ML_DV)


def _compress(x, pe, w1, w2):
    B, S, G, hd = x.shape
    seg = x.reshape(B, S // CMP_STRIDE, CMP_STRIDE, G, hd)
    blk = jnp.concatenate([seg[:, :-1], seg[:, 1:]], axis=2) + pe[:, None, :]
    blk = jnp.moveaxis(blk, 2, 3).reshape(B, -1, G, CMP_LEN * hd)
    return jax.nn.silu(blk @ w1) @ w2


def _nsa(q, kc, vc, ks, vs, kwin, vwin, g, q_norm_w, k_norm_w,
         pe_k, pe_v, k_w1, k_w2, v_w1, v_w2, rel_bias):
    B, S = q.shape[:2]
    G, Hg, hd = NSA_GROUPS, NSA_HPG, NSA_HD
    scale = hd ** -0.5
    t = jnp.arange(S)
    qg = _rmsnorm(q.reshape(B, S, G, Hg, hd), q_norm_w)

    kcmp = _rmsnorm(_compress(kc.reshape(B, S, G, hd), pe_k, k_w1, k_w2), k_norm_w[0])
    vcmp = _compress(vc.reshape(B, S, G, hd), pe_v, v_w1, v_w2)
    n_cmp = S // CMP_STRIDE - 1
    cmp_start = jnp.arange(n_cmp) * CMP_STRIDE
    dist_c = t[:, None] - (cmp_start + CMP_LEN - 1)[None, :]
    bias_c = rel_bias[_rel_bucket(dist_c)].reshape(S, n_cmp, G, Hg).transpose(2, 3, 0, 1)
    sc = jnp.einsum('bsghd,bcgd->bghsc', qg, kcmp).astype(jnp.float32) * scale + bias_c.astype(jnp.float32)
    p_c = _masked_softmax(sc, dist_c >= 0)
    o_c = jnp.einsum('bghsc,bcgd->bsghd', p_c.astype(vcmp.dtype), vcmp)

    n_sel = S // SEL_LEN
    sel_start = jnp.arange(n_sel) * SEL_LEN
    overlap = ((cmp_start[:, None] < sel_start[None, :] + SEL_LEN)
               & (cmp_start[:, None] + CMP_LEN > sel_start[None, :])).astype(jnp.float32)
    imp = jnp.einsum('bghsc,cn->bgsn', p_c, overlap)
    cur = (t // SEL_LEN)[:, None]
    blk_i = jnp.arange(n_sel)[None, :]
    forced = (blk_i == 0) | (blk_i == cur) | (blk_i == cur - 1)
    imp = jnp.where(forced, FORCE_SCORE, imp)
    imp = jnp.where(blk_i > cur, NEG_INF, imp)
    k_top = min(SEL_TOPK, n_sel)
    _, idx = lax.top_k(imp, k_top)

    ks_b = _rmsnorm(ks.reshape(B, n_sel, SEL_LEN, G, hd), k_norm_w[1]).transpose(0, 3, 1, 2, 4)
    vs_b = vs.reshape(B, n_sel, SEL_LEN, G, hd).transpose(0, 3, 1, 2, 4)
    nqb = S // SEL_QBLOCK
    q_blocks = jnp.moveaxis(qg.reshape(B, nqb, SEL_QBLOCK, G, Hg, hd), 1, 0)
    idx_blocks = idx.reshape(B, G, nqb, SEL_QBLOCK, k_top).transpose(2, 0, 1, 3, 4)
    t_blocks = t.reshape(nqb, SEL_QBLOCK)
    tbl = rel_bias.reshape(REL_BUCKETS, G, Hg).transpose(1, 0, 2)
    bi = jnp.arange(B)[:, None, None, None]
    gi = jnp.arange(G)[None, :, None, None]
    n_keys = k_top * SEL_LEN

    def sel_block(args):
        qb, ib, tb = args
        kg = ks_b[bi, gi, ib].reshape(B, G, SEL_QBLOCK, n_keys, hd)
        vg = vs_b[bi, gi, ib].reshape(B, G, SEL_QBLOCK, n_keys, hd)
        pos = (ib[..., None] * SEL_LEN + jnp.arange(SEL_LEN)).reshape(B, G, SEL_QBLOCK, n_keys)
        dist = tb[:, None] - pos
        bias = jnp.moveaxis(tbl[gi, _rel_bucket(dist)], -1, 2)
        s = jnp.einsum('bqghd,bgqkd->bghqk', qb, kg).astype(jnp.float32) * scale + bias.astype(jnp.float32)
        pr = _masked_softmax(s, (dist >= 0)[:, :, None])
        return jnp.einsum('bghqk,bgqkd->bqghd', pr.astype(vg.dtype), vg)

    o_s = lax.map(sel_block, (q_blocks, idx_blocks, t_blocks))
    o_s = jnp.moveaxis(o_s, 0, 1).reshape(B, S, G, Hg, hd)

    nwb = S // WIN_QBLOCK
    n_back = WIN // WIN_QBLOCK

    def band(a):
        ap = jnp.pad(a, ((0, 0), (WIN, 0), (0, 0), (0, 0))).reshape(B, nwb + n_back, WIN_QBLOCK, G, hd)
        return jnp.concatenate([ap[:, j:j + nwb] for j in range(n_back + 1)], axis=2)

    kwb = band(_rmsnorm(kwin.reshape(B, S, G, hd), k_norm_w[2]))
    vwb = band(vwin.reshape(B, S, G, hd))
    qw = qg.reshape(B, nwb, WIN_QBLOCK, G, Hg, hd)
    kw_len = (n_back + 1) * WIN_QBLOCK
    qi = jnp.arange(WIN_QBLOCK)
    ki = jnp.arange(kw_len)
    dist_w = qi[:, None] + WIN - ki[None, :]
    k_abs = jnp.arange(nwb)[:, None, None] * WIN_QBLOCK - WIN + ki[None, None, :]
    mask_w = (dist_w >= 0) & (dist_w < WIN) & (k_abs >= 0)
    bias_w = rel_bias[_rel_bucket(dist_w)].reshape(WIN_QBLOCK, kw_len, G, Hg).transpose(2, 3, 0, 1)
    s = jnp.einsum('bnqghd,bnkgd->bnghqk', qw, kwb).astype(jnp.float32) * scale + bias_w.astype(jnp.float32)
    pr = _masked_softmax(s, mask_w[None, :, None, None])
    o_w = jnp.einsum('bnghqk,bnkgd->bnqghd', pr.astype(vwb.dtype), vwb).reshape(B, S, G, Hg, hd)

    gs = jax.nn.sigmoid(g.reshape(B, S, G, Hg, N_BRANCH))
    o = gs[..., 0:1] * o_c + gs[..., 1:2] * o_s + gs[..., 2:3] * o_w
    return o.reshape(B, S, NSA_WIDTH)


def setup_inputs(seed: int = 0) -> dict:
    key = jax.random.key(seed)
    ks = jax.random.split(key, 20)
    L = DEPTH

    def nrm(k, shape, s):
        return s * jax.random.normal(k, shape, jnp.float32)

    return {
        'x': nrm(ks[0], (BATCH, SEQ, D_MODEL), 1.0),
        'p': nrm(ks[1], (DEPTH, BATCH, SEQ, PLE_DIM), 1.0),
        'norm_w': 1.0 + nrm(ks[2], (L, D_MODEL), 0.05),
        'w_in': nrm(ks[3], (L, D_MODEL, IN_WIDTH), D_MODEL ** -0.5),
        'ml_conv_w': nrm(ks[4], (L, ML_CONV, 2 * ML_QK_WIDTH), ML_CONV ** -0.5),
        'ml_i_bias': nrm(ks[5], (L, ML_HEADS), 0.1),
        'ml_f_bias': 3.0 + nrm(ks[6], (L, ML_HEADS), 0.5),
        'ml_head_norm_w': 1.0 + nrm(ks[7], (L, ML_HEADS, ML_DV), 0.05),
        'nsa_q_norm_w': 1.0 + nrm(ks[8], (L, NSA_HD), 0.05),
        'nsa_k_norm_w': 1.0 + nrm(ks[9], (L, N_BRANCH, NSA_HD), 0.05),
        'cmp_pe_k': nrm(ks[10], (L, CMP_LEN, NSA_HD), 0.1),
        'cmp_pe_v': nrm(ks[11], (L, CMP_LEN, NSA_HD), 0.1),
        'cmp_k_w1': nrm(ks[12], (L, CMP_LEN * NSA_HD, CMP_HIDDEN), (CMP_LEN * NSA_HD) ** -0.5),
        'cmp_k_w2': nrm(ks[13], (L, CMP_HIDDEN, NSA_HD), CMP_HIDDEN ** -0.5),
        'cmp_v_w1': nrm(ks[14], (L, CMP_LEN * NSA_HD, CMP_HIDDEN), (CMP_LEN * NSA_HD) ** -0.5),
        'cmp_v_w2': nrm(ks[15], (L, CMP_HIDDEN, NSA_HD), CMP_HIDDEN ** -0.5),
        'rel_bias': nrm(ks[16], (REL_BUCKETS, NSA_HEADS), 0.5),
        'w_out': nrm(ks[17], (L, MIX_WIDTH, D_MODEL), MIX_WIDTH ** -0.5),
        'ple_proj': nrm(ks[18], (L, PLE_DIM, D_MODEL), PLE_DIM ** -0.5),
        'ple_gate': nrm(ks[19], (L, D_MODEL, D_MODEL), D_MODEL ** -0.5),
    }


def reference(x, p, norm_w, w_in, ml_conv_w, ml_i_bias, ml_f_bias, ml_head_norm_w,
              nsa_q_norm_w, nsa_k_norm_w, cmp_pe_k, cmp_pe_v, cmp_k_w1, cmp_k_w2,
              cmp_v_w1, cmp_v_w2, rel_bias, w_out, ple_proj, ple_gate):
    B, S, _ = x.shape
    for layer in range(DEPTH):
        h = _rmsnorm(x, norm_w[layer])
        u = h @ w_in[layer]
        (ml_q, ml_k, ml_v, ml_o, ml_z, ml_i, ml_f,
         ns_q, ns_kc, ns_vc, ns_ks, ns_vs, ns_kw, ns_vw, ns_g, ns_z) = _split(u, IN_SPLITS)

        qk = jax.nn.silu(_causal_conv(jnp.concatenate([ml_q, ml_k], axis=-1), ml_conv_w[layer]))
        mq, mk = jnp.split(qk, 2, axis=-1)
        mq = mq.reshape(B, S, ML_HEADS, ML_DQK)
        mk = mk.reshape(B, S, ML_HEADS, ML_DQK) * (ML_DQK ** -0.5)
        mv = ml_v.reshape(B, S, ML_HEADS, ML_DV)
        log_i = (ml_i + ml_i_bias[layer]).astype(jnp.float32)
        log_f = jax.nn.log_sigmoid((ml_f + ml_f_bias[layer]).astype(jnp.float32))
        hm = _rmsnorm(_mlstm(mq, mk, mv, log_i, log_f).astype(x.dtype), ml_head_norm_w[layer])
        y_ml = hm.reshape(B, S, ML_WIDTH) * jax.nn.sigmoid(ml_o) * jax.nn.silu(ml_z)

        y_ns = _nsa(ns_q, ns_kc, ns_vc, ns_ks, ns_vs, ns_kw, ns_vw, ns_g,
                    nsa_q_norm_w[layer], nsa_k_norm_w[layer], cmp_pe_k[layer], cmp_pe_v[layer],
                    cmp_k_w1[layer], cmp_k_w2[layer], cmp_v_w1[layer], cmp_v_w2[layer],
                    rel_bias) * jax.nn.silu(ns_z)

        x = x + jnp.concatenate([y_ml, y_ns], axis=-1) @ w_out[layer]
        x = x + jax.nn.sigmoid(x @ ple_gate[layer]) * (p[layer] @ ple_proj[layer])
    return x
```

```cpp
#include <hip/hip_runtime.h>
#include <hip/hip_cooperative_groups.h>
#include <cstdio>
#include <cstdint>
namespace cg = cooperative_groups;

#define LAS __attribute__((address_space(3)))
typedef unsigned short bf16_t;
typedef short bf16x8 __attribute__((ext_vector_type(8)));
typedef short bf16x4 __attribute__((ext_vector_type(4)));
typedef float f32x4 __attribute__((ext_vector_type(4)));
typedef float f32x2 __attribute__((ext_vector_type(2)));
typedef unsigned u32x4 __attribute__((ext_vector_type(4)));
typedef unsigned u32x2 __attribute__((ext_vector_type(2)));

constexpr int DM = 4096, NB = 2, SEQ = 4096, MTOK = NB * SEQ;
constexpr int INW = 15424;
constexpr int UW = 12288;
constexpr int UQ = 0, UK = 1024, UO = 2048, UZ = 4096, UNQ = 6144, UKC = 8192, UVC = 8704, UKS = 9216, UKW = 9728, UNZ = 10240;
constexpr int WT_SMALL = 12288;
constexpr int WT_T = 12544;
constexpr int WT_ROWS = 15616;
constexpr int TV = 0, TVS = 2048, TVW = 2560, TROWS = 3072;
constexpr float EPS = 1e-6f;

__device__ __forceinline__ unsigned f2bf(float f) { unsigned u = __float_as_uint(f); return (u + 0x7fffu + ((u >> 16) & 1u)) >> 16; }
typedef __bf16 bf16x2v __attribute__((ext_vector_type(2)));
__device__ __forceinline__ unsigned pk2(float lo, float hi) { const f32x2 v = {lo, hi}; return __builtin_bit_cast(unsigned, __builtin_convertvector(v, bf16x2v)); }
__device__ __forceinline__ float bflo(unsigned w) { return __uint_as_float(w << 16); }
__device__ __forceinline__ float bfhi(unsigned w) { return __uint_as_float(w & 0xffff0000u); }
__device__ __forceinline__ float bf2f(bf16_t b) { return __uint_as_float(((unsigned)b) << 16); }
__device__ __forceinline__ float wave_sum(float v) {
#pragma unroll
    for (int o = 1; o < 64; o <<= 1) v += __shfl_xor(v, o);
    return v;
}
__device__ __forceinline__ int opaque_tid() { int t = threadIdx.x; asm volatile("" : "+v"(t)); return t; }
__device__ __forceinline__ LAS unsigned char* opq(LAS unsigned char* p) { unsigned v = (unsigned)(uintptr_t)p; asm volatile("" : "+s"(v)); return (LAS unsigned char*)(uintptr_t)v; }
#define DPP_F(v, ctrl) __builtin_bit_cast(float, __builtin_amdgcn_update_dpp(0, __builtin_bit_cast(int, (v)), (ctrl), 0xF, 0xF, true))
__device__ __forceinline__ float row16_sum(float v) { v += DPP_F(v, 0xB1); v += DPP_F(v, 0x4E); v += DPP_F(v, 0x141); v += DPP_F(v, 0x140); return v; }
__device__ __forceinline__ void swap16(float& a, float& b) { asm volatile("v_nop\n\tv_nop\n\tv_permlane16_swap_b32 %0, %1" : "+v"(a), "+v"(b)); }
__device__ __forceinline__ void swap32(float& a, float& b) { asm volatile("v_nop\n\tv_nop\n\tv_permlane32_swap_b32 %0, %1" : "+v"(a), "+v"(b)); }
__device__ __forceinline__ float xq_sum(float v) { float a = v, b = v; swap16(a, b); v = a + b; a = v; b = v; swap32(a, b); return a + b; }
__device__ __forceinline__ float xq_max(float v) { float a = v, b = v; swap16(a, b); v = fmaxf(a, b); a = v; b = v; swap32(a, b); return fmaxf(a, b); }
__device__ __forceinline__ float shfl_up_l(float v, int o, int lane_) { const int src = lane_ - o < 0 ? lane_ : lane_ - o; return __builtin_bit_cast(float, __builtin_amdgcn_ds_bpermute(src << 2, __builtin_bit_cast(int, v))); }
__device__ __forceinline__ float row16_max(float v) { v = fmaxf(v, DPP_F(v, 0xB1)); v = fmaxf(v, DPP_F(v, 0x4E)); v = fmaxf(v, DPP_F(v, 0x141)); v = fmaxf(v, DPP_F(v, 0x140)); return v; }
__device__ __forceinline__ float wave_max(float v) { return xq_max(row16_max(v)); }
__device__ __forceinline__ float sigmoidf_(float x) { return __builtin_amdgcn_rcpf(1.f + __expf(-x)); }
__device__ __forceinline__ float siluf_(float x) { return x * __builtin_amdgcn_rcpf(1.f + __expf(-x)); }

__device__ __forceinline__ unsigned pk_fp8x4(float a, float b, float c, float d) {
    int p = 0; p = __builtin_amdgcn_cvt_pk_fp8_f32(a, b, p, false); p = __builtin_amdgcn_cvt_pk_fp8_f32(c, d, p, true); return (unsigned)p;
}
__device__ __forceinline__ int w8_row(int dr) { return (dr >= 6144 && dr < 12288) ? dr - 6144 : (dr >= 14592 ? 6144 + (dr - 14592) : -1); }
__device__ __forceinline__ int wt_row(int c) {
    int r;
    if (c < 2048) r = c;
    else if (c < 4096) r = WT_T + TV + (c - 2048);
    else if (c < 6144) r = UO + (c - 4096);
    else if (c < 8192) r = UZ + (c - 6144);
    else if (c < 8208) r = WT_SMALL + (c - 8192);
    else if (c < 10256) r = UNQ + (c - 8208);
    else if (c < 11280) r = UKC + (c - 10256);
    else if (c < 11792) r = UKS + (c - 11280);
    else if (c < 12304) r = WT_T + TVS + (c - 11792);
    else if (c < 12816) r = UKW + (c - 12304);
    else if (c < 13328) r = WT_T + TVW + (c - 12816);
    else if (c < 13376) r = WT_SMALL + 16 + (c - 13328);
    else r = UNZ + (c - 13376);
    return r;
}

namespace pg8 {
constexpr int BM = 256, BK = 64, HALF = 128, HTB = HALF * BK * 2, STAGE_BYTES = 8 * HTB, NXCD = 8, WGM = 8;
__host__ __device__ __forceinline__ int lds_byte(int r, int c) { const int st = (r >> 4) * 2 + (c >> 5), rr = r & 15, cc = c & 31, ob = rr * 64 + cc * 2; return st * 1024 + (ob ^ (((ob >> 9) & 1) << 5)); }
__host__ __device__ __forceinline__ void stage_rc(int b, int& R, int& C) { const int st = b / 1024, sb = b % 1024, swz = sb ^ (((sb >> 9) & 1) << 5); R = (st >> 1) * 16 + swz / 64; C = (st & 1) * 32 + (swz % 64) / 2; }
__host__ __device__ __forceinline__ int perm32(int rho) { const int n = rho >> 4, i = rho & 15; return 8 * (i >> 2) + 4 * n + (i & 3); }

struct Unit { const char* a; const char* b; int pm, pn, kind; };

__device__ __forceinline__ void tile_order(int L, int nM, int nN, int& pm, int& pn) {
    const int nwg = nM * nN; int wgid = L;
    { const int q = nwg / NXCD, r = nwg % NXCD, xcd = wgid % NXCD, off = wgid / NXCD; wgid = (xcd < r ? xcd * (q + 1) : r * (q + 1) + (xcd - r) * q) + off; }
    const int nig = WGM * nN, gid = wgid / nig, fm = gid * WGM, gsz = (nM - fm) < WGM ? (nM - fm) : WGM;
    pm = fm + ((wgid % nig) % gsz); pn = (wgid % nig) / gsz;
}
struct Sched2 {
    const char* a0; const char* b0; int nM0, nN0, kind0;
    const char* a1; const char* b1; int nM1, nN1, kind1;
    int K, G, c;
    __device__ __forceinline__ bool next(int i, Unit& u) const {
        const long L = (long)i * G + c; const int n0 = nM0 * nN0, n1 = nM1 * nN1; const size_t tstep = (size_t)BM * K * 2;
        if (L < n0) { int pm, pn; tile_order((int)L, nM0, nN0, pm, pn); u.pm = pm; u.pn = pn; u.kind = kind0; u.a = a0 + (size_t)pm * tstep; u.b = b0 + (size_t)pn * tstep; return true; }
        if (L < n0 + n1) { int pm, pn; tile_order((int)(L - n0), nM1, nN1, pm, pn); u.pm = pm; u.pn = pn; u.kind = kind1; u.a = a1 + (size_t)pm * tstep; u.b = b1 + (size_t)pn * tstep; return true; }
        return false;
    }
};

struct SchedG1B {
    const char* hb; const char* wt; int G, c;
    __device__ __forceinline__ bool next(int i, Unit& u) const {
        const int L = i * G + c; const size_t tstep = (size_t)BM * 4096 * 2; int pm, pn;
        if (L < 768) { tile_order(L, 32, 24, pm, pn); u.kind = 0; u.pm = pm; u.pn = pn; u.a = hb + (size_t)pm * tstep; u.b = wt + (size_t)pn * tstep; return true; }
        if (L < 800) { pm = L - 768; u.kind = 0; u.pm = pm; u.pn = 48; u.a = hb + (size_t)pm * tstep; u.b = wt + (size_t)48 * tstep; return true; }
        if (L < 1056) { tile_order(L - 800, 8, 32, pm, pn); u.kind = 1; u.pm = pm; u.pn = pn; u.a = wt + (size_t)(49 + pm) * tstep; u.b = hb + (size_t)pn * tstep; return true; }
        return false;
    }
};
struct SchedG1F {
    const char* hb8; const char* w8; int G, c;
    __device__ __forceinline__ bool next(int i, Unit& u) const {
        int M;
        if (G == 256) { int h = i; if (c < 32) h += 2;
            if (h == 0) M = c - 32; else if (h == 1) M = 224 + (c - 32); else if (h == 2) M = 448 + c; else if (h == 3 && c < 192) M = 704 + c; else return false; }
        else { M = i * G + c; if (M >= 896) return false; }
        const size_t tstep = (size_t)BM * 4096; int pm, pn;
        if (M < 768) { tile_order(M, 32, 24, pm, pn); u.kind = 0; u.pm = pm; u.pn = 24 + pn; u.a = hb8 + (size_t)pm * tstep; u.b = w8 + (size_t)pn * tstep; }
        else { tile_order(M - 768, 4, 32, pm, pn); u.kind = 1; u.pm = 8 + pm; u.pn = pn; u.a = w8 + (size_t)(24 + pm) * tstep; u.b = hb8 + (size_t)pn * tstep; }
        return true;
    }
};

__device__ __forceinline__ unsigned cvt_pk_bf16(float lo, float hi) { return pk2(lo, hi); }

__device__ __forceinline__ const char* uniform_ptr(const char* p) {
    const unsigned long long v = (unsigned long long)p;
    const unsigned lo = __builtin_amdgcn_readfirstlane((unsigned)v), hi = __builtin_amdgcn_readfirstlane((unsigned)(v >> 32));
    return (const char*)(((unsigned long long)hi << 32) | lo);
}
typedef int i32x8 __attribute__((ext_vector_type(8)));
typedef int i32x4v __attribute__((ext_vector_type(4)));
__device__ __forceinline__ i32x8 cat8(bf16x8 a, bf16x8 b) { const i32x4v x = __builtin_bit_cast(i32x4v, a), y = __builtin_bit_cast(i32x4v, b); return (i32x8){x[0], x[1], x[2], x[3], y[0], y[1], y[2], y[3]}; }
template <class Epi, class Sched, bool FP8 = false>
__device__ __forceinline__ void gemm_phase(LAS unsigned char* lds, const int K, const Sched& S, const Epi& E) {
    const int tid = opaque_tid(), wid = __builtin_amdgcn_readfirstlane(tid >> 6), lane = tid & 63, wr = wid >> 2, wc = wid & 3, fr = lane & 15, fq = lane >> 4;
    const int nt = K / BK;
    unsigned voffA[2], voffB[2];
#pragma unroll
    for (int i = 0; i < 2; ++i) { int R, C; stage_rc(tid * 16 + i * 8192, R, C); const int Rb = (R & ~31) + perm32(R & 31);
        voffA[i] = (unsigned)(R * K + C) * 2u; voffB[i] = (unsigned)(Rb * K + C) * 2u; }
    const size_t kstep = (size_t)(BK * 2);
    const size_t hstep = (size_t)HALF * K * 2;
    const unsigned ldsw = (unsigned)wid * 1024u;
    const int aoff = lds_byte(wr * 64 + fr, fq * 8), boff = lds_byte(wc * 32 + fr, fq * 8);
#define PG8_SA(b, h) (((b) * 2 + (h)) * HTB)
#define PG8_SB(b, h) ((4 + (b) * 2 + (h)) * HTB)
#define PG8_VOFF(i_, isB_) ([&]() -> unsigned { int R_, C_; stage_rc((opaque_tid()) * 16 + (i_) * 8192, R_, C_); if (isB_) R_ = (R_ & ~31) + perm32(R_ & 31); return (unsigned)(R_ * K + C_) * 2u; }())
#define PG8_STAGE(bufoff, gbase, voff) do { _Pragma("unroll") for (int _i = 0; _i < 2; ++_i) { \
        unsigned vo_ = (voff)[_i]; if constexpr (FP8) { vo_ = (voff)[0]; asm volatile("" : "+v"(vo_)); vo_ += (unsigned)_i * (unsigned)(64 * K * 2); }     \
        __builtin_amdgcn_global_load_lds((const unsigned*)((const char*)(gbase) + vo_), (LAS unsigned*)(lds + (bufoff) + ldsw + _i * 8192), 16, 0, 0); } } while (0)
#define PG8_LDA(dst, b, h) do { if constexpr (FP8) { _Pragma("unroll") for (int m = 0; m < 4; ++m) { const i32x4v lo_ = *(const LAS i32x4v*)(lds + PG8_SA(b, h) + aoff + m * 2048), hi_ = *(const LAS i32x4v*)(lds + PG8_SA(b, h) + aoff + m * 2048 + 1024); \
            dst##8[m] = __builtin_shufflevector(lo_, hi_, 0, 1, 2, 3, 4, 5, 6, 7); } } \
        else { _Pragma("unroll") for (int m = 0; m < 4; ++m) _Pragma("unroll") for (int k = 0; k < 2; ++k) dst[m][k] = *(const LAS bf16x8*)(lds + PG8_SA(b, h) + aoff + m * 2048 + k * 1024); } } while (0)
#define PG8_LDB(dst, b, h) do { if constexpr (FP8) { _Pragma("unroll") for (int n = 0; n < 2; ++n) { const i32x4v lo_ = *(const LAS i32x4v*)(lds + PG8_SB(b, h) + boff + n * 2048), hi_ = *(const LAS i32x4v*)(lds + PG8_SB(b, h) + boff + n * 2048 + 1024); \
            dst##8[n] = __builtin_shufflevector(lo_, hi_, 0, 1, 2, 3, 4, 5, 6, 7); } } \
        else { _Pragma("unroll") for (int n = 0; n < 2; ++n) _Pragma("unroll") for (int k = 0; k < 2; ++k) dst[n][k] = *(const LAS bf16x8*)(lds + PG8_SB(b, h) + boff + n * 2048 + k * 1024); } } while (0)
#define PG8_MMA(ai, bj, At, Bt) do { __builtin_amdgcn_s_setprio(1); _Pragma("unroll") for (int m = 0; m < 4; ++m) _Pragma("unroll") for (int n = 0; n < 2; ++n) { \
        if constexpr (FP8) acc[ai][bj][m][n] = __builtin_amdgcn_mfma_scale_f32_16x16x128_f8f6f4(Bt##8[n], At##8[m], acc[ai][bj][m][n], 0, 0, 0, 121, 0, 127); \
        else { _Pragma("unroll") for (int k = 0; k < 2; ++k) acc[ai][bj][m][n] = __builtin_amdgcn_mfma_f32_16x16x32_bf16(Bt[n][k], At[m][k], acc[ai][bj][m][n], 0, 0, 0); } } \
        __builtin_amdgcn_s_setprio(0); } while (0)
#define PG8_WAIT_V(n) asm volatile("s_waitcnt vmcnt(" #n ")" ::: "memory")
#define PG8_WAIT_L(n) asm volatile("s_waitcnt lgkmcnt(" #n ")" ::: "memory")
#define PG8_BAR __builtin_amdgcn_s_barrier()
#define PG8_SCHED __builtin_amdgcn_sched_barrier(0)
    Unit cur, nxt; int ui = 0;
    if (!S.next(0, cur)) return;
    f32x4 acc[2][2][4][2];
#pragma unroll
    for (int a = 0; a < 2; ++a)
#pragma unroll
        for (int b = 0; b < 2; ++b)
#pragma unroll
            for (int m = 0; m < 4; ++m)
#pragma unroll
                for (int n = 0; n < 2; ++n) acc[a][b][m][n] = (f32x4){0.f, 0.f, 0.f, 0.f};
    bf16x8 At[4][2], B0[2][2], B1[2][2];
    i32x8 At8[4], B08[2], B18[2];
    const char* cA = cur.a; const char* cB = cur.b;
    PG8_STAGE(PG8_SB(0, 0), cB, voffB); PG8_STAGE(PG8_SB(0, 1), cB + hstep, voffB); PG8_STAGE(PG8_SA(0, 0), cA, voffA); PG8_STAGE(PG8_SA(0, 1), cA + hstep, voffA);
    if (wr == 1) PG8_BAR;
    PG8_WAIT_V(2); PG8_BAR;
    PG8_STAGE(PG8_SB(1, 0), cB + kstep, voffB); PG8_STAGE(PG8_SA(1, 0), cA + kstep, voffA); PG8_STAGE(PG8_SB(1, 1), cB + hstep + kstep, voffB);
    PG8_WAIT_V(6); PG8_BAR;
    for (;;) {
        const bool has_next = S.next(ui + 1, nxt);
        const char* nA = has_next ? nxt.a : cA; const char* nB = has_next ? nxt.b : cB;
        for (int t = 0; t < nt; t += 2) {
            const bool last = (t == nt - 2);
            const char* a1 = uniform_ptr(cA + (size_t)(t + 1) * kstep);
            const char* a2 = uniform_ptr(last ? nA : cA + (size_t)(t + 2) * kstep); const char* b2 = uniform_ptr(last ? nB : cB + (size_t)(t + 2) * kstep);
            const char* a3 = uniform_ptr(a2 + kstep); const char* b3 = uniform_ptr(b2 + kstep);
            PG8_LDB(B0, 0, 0); PG8_LDB(B1, 0, 1); PG8_SCHED; PG8_LDA(At, 0, 0); PG8_STAGE(PG8_SA(1, 1), a1 + hstep, voffA);
            PG8_WAIT_V(8); PG8_WAIT_L(0); PG8_BAR; PG8_MMA(0, 0, At, B0); PG8_MMA(0, 1, At, B1); PG8_BAR; PG8_SCHED;
            PG8_LDA(At, 0, 1); PG8_STAGE(PG8_SB(0, 0), b2, voffB); PG8_STAGE(PG8_SB(0, 1), b2 + hstep, voffB); PG8_STAGE(PG8_SA(0, 0), a2, voffA);
            PG8_WAIT_V(8); PG8_WAIT_L(0); PG8_BAR; PG8_MMA(1, 0, At, B0); PG8_MMA(1, 1, At, B1); PG8_BAR; PG8_SCHED;
            PG8_LDB(B0, 1, 0); PG8_LDB(B1, 1, 1); PG8_SCHED; PG8_LDA(At, 1, 0); PG8_STAGE(PG8_SA(0, 1), a2 + hstep, voffA);
            PG8_WAIT_V(8); PG8_WAIT_L(0); PG8_BAR; PG8_MMA(0, 0, At, B0); PG8_MMA(0, 1, At, B1); PG8_BAR; PG8_SCHED;
            PG8_LDA(At, 1, 1); PG8_STAGE(PG8_SB(1, 0), b3, voffB); PG8_STAGE(PG8_SB(1, 1), b3 + hstep, voffB); PG8_STAGE(PG8_SA(1, 0), a3, voffA);
            PG8_WAIT_V(8); PG8_WAIT_L(0); PG8_BAR; PG8_MMA(1, 0, At, B0); PG8_MMA(1, 1, At, B1); PG8_BAR; PG8_SCHED;
        }
        if (wr == 0) PG8_BAR;
        E(acc, cur, wr, wc, fr, fq);
        if (!has_next) break;
#pragma unroll
        for (int a = 0; a < 2; ++a)
#pragma unroll
            for (int b = 0; b < 2; ++b)
#pragma unroll
                for (int m = 0; m < 4; ++m)
#pragma unroll
                    for (int n = 0; n < 2; ++n) acc[a][b][m][n] = (f32x4){0.f, 0.f, 0.f, 0.f};
        cur = nxt; cA = nA; cB = nB; ++ui;
        if (wr == 1) PG8_BAR;
    }
    PG8_WAIT_V(0);
    PG8_BAR;
#undef PG8_SA
#undef PG8_SB
#undef PG8_STAGE
#undef PG8_LDA
#undef PG8_LDB
#undef PG8_MMA
#undef PG8_WAIT_V
#undef PG8_WAIT_L
#undef PG8_BAR
#undef PG8_SCHED
}

struct UnitM { int pm, pn; };
struct SchedM {
    const char* a; const char* b; const char* a8; const char* b8; int nM, nN, G, c;
    __device__ __forceinline__ bool next(int i, UnitM& u) const {
        const long L = (long)i * G + c; if (L >= (long)nM * nN) return false;
        int pm, pn; tile_order((int)L, nM, nN, pm, pn); u.pm = __builtin_amdgcn_readfirstlane(pm); u.pn = __builtin_amdgcn_readfirstlane(pn); return true;
    }
};
template <class Epi>
__device__ __forceinline__ void gemm_phase_mixed(LAS unsigned char* lds, const SchedM& S, const Epi& E) {
    constexpr int NT1 = 32, NT = 48;
    const int tid = opaque_tid(), wid = __builtin_amdgcn_readfirstlane(tid >> 6), lane = tid & 63, wr = wid >> 2, wc = wid & 3, fr = lane & 15, fq = lane >> 4;
    unsigned voffA0, voffB0;
    { int R, C; stage_rc(tid * 16, R, C); const int Rb = (R & ~31) + perm32(R & 31); voffA0 = (unsigned)(R * 8192 + 2 * C); voffB0 = (unsigned)(Rb * 8192 + 2 * C); }
    const unsigned ldsw = (unsigned)wid * 1024u;
    const int aoff = lds_byte(wr * 64 + fr, fq * 8), boff = lds_byte(wc * 32 + fr, fq * 8);
#define MX_SA(b, h) (((b) * 2 + (h)) * HTB)
#define MX_SB(b, h) ((4 + (b) * 2 + (h)) * HTB)
#define MX_STAGE(bufoff, ISB, PX, tt, half, VOFF0, M) do { \
        const char* gb_ = uniform_ptr((M) ? ((ISB) ? S.b8 : S.a8) + (size_t)(PX) * (256 * 2048) + (size_t)((tt) - NT1) * 128 + (size_t)(half) * 128 * 2048 \
                                          : ((ISB) ? S.b : S.a) + (size_t)(PX) * (256 * 8192) + (size_t)(tt) * 128 + (size_t)(half) * 128 * 8192); \
        unsigned v0_ = (VOFF0); asm volatile("" : "+v"(v0_)); if (M) v0_ -= (v0_ >> 13) * 6144u; \
        _Pragma("unroll") for (int _i = 0; _i < 2; ++_i) { const unsigned vo_ = v0_ + (unsigned)_i * ((M) ? 64u * 2048u : 64u * 8192u); \
            __builtin_amdgcn_global_load_lds((const unsigned*)(gb_ + vo_), (LAS unsigned*)(lds + (bufoff) + ldsw + _i * 8192), 16, 0, 0); } } while (0)
#define MX_PIN(ai, bj) do { _Pragma("unroll") for (int m = 0; m < 4; ++m) _Pragma("unroll") for (int n = 0; n < 2; ++n) asm volatile("" : "+v"(acc[ai][bj][m][n])); } while (0)
#define MX_LDA0(b, h) do { _Pragma("unroll") for (int m = 0; m < 4; ++m) _Pragma("unroll") for (int k = 0; k < 2; ++k) At[m][k] = *(const LAS bf16x8*)(lds + MX_SA(b, h) + aoff + m * 2048 + k * 1024); } while (0)
#define MX_LDB0(dst, b, h) do { _Pragma("unroll") for (int n = 0; n < 2; ++n) _Pragma("unroll") for (int k = 0; k < 2; ++k) dst[n][k] = *(const LAS bf16x8*)(lds + MX_SB(b, h) + boff + n * 2048 + k * 1024); } while (0)
#define MX_MMA0(ai, bj, Bt) do { __builtin_amdgcn_s_setprio(1); _Pragma("unroll") for (int m = 0; m < 4; ++m) _Pragma("unroll") for (int n = 0; n < 2; ++n) _Pragma("unroll") for (int k = 0; k < 2; ++k) \
        acc[ai][bj][m][n] = __builtin_amdgcn_mfma_f32_16x16x32_bf16(Bt[n][k], At[m][k], acc[ai][bj][m][n], 0, 0, 0); MX_PIN(ai, bj); __builtin_amdgcn_s_setprio(0); } while (0)
#define MX_LDA1(b, h) do { _Pragma("unroll") for (int m = 0; m < 4; ++m) { const i32x4v lo_ = *(const LAS i32x4v*)(lds + MX_SA(b, h) + aoff + m * 2048), hi_ = *(const LAS i32x4v*)(lds + MX_SA(b, h) + aoff + m * 2048 + 1024); \
        At8[m] = __builtin_shufflevector(lo_, hi_, 0, 1, 2, 3, 4, 5, 6, 7); } } while (0)
#define MX_LDB1(dst, b, h) do { _Pragma("unroll") for (int n = 0; n < 2; ++n) { const i32x4v lo_ = *(const LAS i32x4v*)(lds + MX_SB(b, h) + boff + n * 2048), hi_ = *(const LAS i32x4v*)(lds + MX_SB(b, h) + boff + n * 2048 + 1024); \
        dst##8[n] = __builtin_shufflevector(lo_, hi_, 0, 1, 2, 3, 4, 5, 6, 7); } } while (0)
#define MX_MMA1(ai, bj, Bt) do { __builtin_amdgcn_s_setprio(1); _Pragma("unroll") for (int m = 0; m < 4; ++m) _Pragma("unroll") for (int n = 0; n < 2; ++n) \
        acc[ai][bj][m][n] = __builtin_amdgcn_mfma_scale_f32_16x16x128_f8f6f4(Bt##8[n], At8[m], acc[ai][bj][m][n], 0, 0, 0, 121, 0, 123); MX_PIN(ai, bj); __builtin_amdgcn_s_setprio(0); } while (0)
#define MX_WAIT_V(n) asm volatile("s_waitcnt vmcnt(" #n ")" ::: "memory")
#define MX_WAIT_L(n) asm volatile("s_waitcnt lgkmcnt(" #n ")" ::: "memory")
#define MX_BAR __builtin_amdgcn_s_barrier()
#define MX_SCHED __builtin_amdgcn_sched_barrier(0)
#define MX_BODY(F, G) do { \
        MX_LDB##F(B0, 0, 0); MX_LDB##F(B1, 0, 1); MX_SCHED; MX_LDA##F(0, 0); MX_STAGE(MX_SA(1, 1), 0, cur.pm, t + 1, 1, voffA0, F); \
        MX_WAIT_V(8); MX_WAIT_L(0); MX_BAR; MX_MMA##F(0, 0, B0); MX_MMA##F(0, 1, B1); MX_BAR; MX_SCHED; \
        MX_LDA##F(0, 1); MX_STAGE(MX_SB(0, 0), 1, xpn, i2, 0, voffB0, G); MX_STAGE(MX_SB(0, 1), 1, xpn, i2, 1, voffB0, G); MX_STAGE(MX_SA(0, 0), 0, xpm, i2, 0, voffA0, G); \
        MX_WAIT_V(8); MX_WAIT_L(0); MX_BAR; MX_MMA##F(1, 0, B0); MX_MMA##F(1, 1, B1); MX_BAR; MX_SCHED; \
        MX_LDB##F(B0, 1, 0); MX_LDB##F(B1, 1, 1); MX_SCHED; MX_LDA##F(1, 0); MX_STAGE(MX_SA(0, 1), 0, xpm, i2, 1, voffA0, G); \
        MX_WAIT_V(8); MX_WAIT_L(0); MX_BAR; MX_MMA##F(0, 0, B0); MX_MMA##F(0, 1, B1); MX_BAR; MX_SCHED; \
        MX_LDA##F(1, 1); MX_STAGE(MX_SB(1, 0), 1, xpn, i3, 0, voffB0, G); MX_STAGE(MX_SB(1, 1), 1, xpn, i3, 1, voffB0, G); MX_STAGE(MX_SA(1, 0), 0, xpm, i3, 0, voffA0, G); \
        MX_WAIT_V(8); MX_WAIT_L(0); MX_BAR; MX_MMA##F(1, 0, B0); MX_MMA##F(1, 1, B1); MX_BAR; MX_SCHED; } while (0)
    UnitM cur, nxt; int ui = 0;
    if (!S.next(0, cur)) return;
    f32x4 acc[2][2][4][2];
#pragma unroll
    for (int a = 0; a < 2; ++a)
#pragma unroll
        for (int b = 0; b < 2; ++b)
#pragma unroll
            for (int m = 0; m < 4; ++m)
#pragma unroll
                for (int n = 0; n < 2; ++n) acc[a][b][m][n] = (f32x4){0.f, 0.f, 0.f, 0.f};
    bf16x8 At[4][2], B0[2][2], B1[2][2];
    i32x8 At8[4], B08[2], B18[2];
    MX_STAGE(MX_SB(0, 0), 1, cur.pn, 0, 0, voffB0, 0); MX_STAGE(MX_SB(0, 1), 1, cur.pn, 0, 1, voffB0, 0); MX_STAGE(MX_SA(0, 0), 0, cur.pm, 0, 0, voffA0, 0); MX_STAGE(MX_SA(0, 1), 0, cur.pm, 0, 1, voffA0, 0);
    if (wr == 1) MX_BAR;
    MX_WAIT_V(2); MX_BAR;
    MX_STAGE(MX_SB(1, 0), 1, cur.pn, 1, 0, voffB0, 0); MX_STAGE(MX_SA(1, 0), 0, cur.pm, 1, 0, voffA0, 0); MX_STAGE(MX_SB(1, 1), 1, cur.pn, 1, 1, voffB0, 0);
    MX_WAIT_V(6); MX_BAR;
    for (;;) {
        const bool has_next = S.next(ui + 1, nxt);
        if (!has_next) nxt = cur;
        { const int xpm = cur.pm, xpn = cur.pn;
          for (int t = 0; t < NT1 - 2; t += 2) { const int i2 = t + 2, i3 = t + 3; MX_BODY(0, 0); }
          { const int t = NT1 - 2, i2 = NT1, i3 = NT1 + 1; MX_BODY(0, 1); }
          for (int t = NT1; t < NT - 2; t += 2) { const int i2 = t + 2, i3 = t + 3; MX_BODY(1, 1); } }
        { const int xpm = nxt.pm, xpn = nxt.pn; const int t = NT - 2, i2 = 0, i3 = 1; MX_BODY(1, 0); }
        if (wr == 0) MX_BAR;
        { Unit eu; eu.a = nullptr; eu.b = nullptr; eu.pm = cur.pm; eu.pn = cur.pn; eu.kind = 0; E(acc, eu, wr, wc, fr, fq); }
        if (!has_next) break;
#pragma unroll
        for (int a = 0; a < 2; ++a)
#pragma unroll
            for (int b = 0; b < 2; ++b)
#pragma unroll
                for (int m = 0; m < 4; ++m)
#pragma unroll
                    for (int n = 0; n < 2; ++n) acc[a][b][m][n] = (f32x4){0.f, 0.f, 0.f, 0.f};
        cur = nxt; ++ui;
        if (wr == 1) MX_BAR;
    }
    MX_WAIT_V(0);
    MX_BAR;
#undef MX_SA
#undef MX_SB
#undef MX_STAGE
#undef MX_LDA0
#undef MX_PIN
#undef MX_LDB0
#undef MX_MMA0
#undef MX_LDA1
#undef MX_LDB1
#undef MX_MMA1
#undef MX_WAIT_V
#undef MX_WAIT_L
#undef MX_BAR
#undef MX_SCHED
#undef MX_BODY
}

struct SchedC {
    const char* U; const char* w1k; const char* w1v; int ukc, uvc; int unit;
    __device__ __forceinline__ bool next(int i, UnitM& u) const { if (i > 0) return false; const int kv = unit & 1, pnh = (unit >> 1) & 1, bg = unit >> 2;
        u.pm = __builtin_amdgcn_readfirstlane(kv * 8 + bg); u.pn = __builtin_amdgcn_readfirstlane(kv * 2 + pnh); return true; }
    __device__ __forceinline__ const char* abase(int ca) const { const int kv = ca >> 3, bg = ca & 7; return U + ((size_t)((bg >> 2) * SEQ) * UW + (kv ? uvc : ukc) + (bg & 3) * 128) * 2; }
    __device__ __forceinline__ const char* bbase(int cb) const { return ((cb >> 1) ? w1v : w1k) + (size_t)(cb & 1) * 2048 * 2; }
};
template <class Epi>
__device__ __forceinline__ void gemm_cmp(LAS unsigned char* lds, const SchedC& S, const Epi& E) {
    constexpr int NT = 32; constexpr unsigned PITCHA = 16u * UW * 2u;
    const int tid = opaque_tid(), wid = __builtin_amdgcn_readfirstlane(tid >> 6), lane = tid & 63, wr = wid >> 2, wc = wid & 3, fr = lane & 15, fq = lane >> 4;
    unsigned voffA0, voffB0;
    { int R, C; stage_rc(tid * 16, R, C); const int Rb = (R & ~31) + perm32(R & 31); voffA0 = (unsigned)R * PITCHA + 2u * C; voffB0 = (unsigned)(Rb * 8192 + 2 * C); }
    const unsigned ldsw = (unsigned)wid * 1024u;
    const int aoff = lds_byte(wr * 64 + fr, fq * 8), boff = lds_byte(wc * 32 + fr, fq * 8);
#define MX_SA(b, h) (((b) * 2 + (h)) * HTB)
#define MX_SB(b, h) ((4 + (b) * 2 + (h)) * HTB)
#define MX_STAGE(bufoff, ISB, PX, tt, half, VOFF0, M) do { \
        const char* gb_ = uniform_ptr((ISB) ? S.bbase(PX) + (size_t)(tt) * 128 + (size_t)(half) * 128 * 8192 \
                                            : S.abase(PX) + (size_t)((tt) >> 1) * (UW * 2) + (size_t)((tt) & 1) * 128 + (size_t)(half) * 128 * PITCHA); \
        unsigned v0_ = (VOFF0); asm volatile("" : "+v"(v0_)); \
        _Pragma("unroll") for (int _i = 0; _i < 2; ++_i) { const unsigned vo_ = v0_ + (unsigned)_i * ((ISB) ? 64u * 8192u : 64u * PITCHA); \
            __builtin_amdgcn_global_load_lds((const unsigned*)(gb_ + vo_), (LAS unsigned*)(lds + (bufoff) + ldsw + _i * 8192), 16, 0, 0); } } while (0)
#define MX_PIN(ai, bj) do { _Pragma("unroll") for (int m = 0; m < 4; ++m) _Pragma("unroll") for (int n = 0; n < 2; ++n) asm volatile("" : "+v"(acc[ai][bj][m][n])); } while (0)
#define MX_LDA0(b, h) do { _Pragma("unroll") for (int m = 0; m < 4; ++m) _Pragma("unroll") for (int k = 0; k < 2; ++k) At[m][k] = *(const LAS bf16x8*)(lds + MX_SA(b, h) + aoff + m * 2048 + k * 1024); } while (0)
#define MX_LDB0(dst, b, h) do { _Pragma("unroll") for (int n = 0; n < 2; ++n) _Pragma("unroll") for (int k = 0; k < 2; ++k) dst[n][k] = *(const LAS bf16x8*)(lds + MX_SB(b, h) + boff + n * 2048 + k * 1024); } while (0)
#define MX_MMA0(ai, bj, Bt) do { __builtin_amdgcn_s_setprio(1); _Pragma("unroll") for (int m = 0; m < 4; ++m) _Pragma("unroll") for (int n = 0; n < 2; ++n) _Pragma("unroll") for (int k = 0; k < 2; ++k) \
        acc[ai][bj][m][n] = __builtin_amdgcn_mfma_f32_16x16x32_bf16(Bt[n][k], At[m][k], acc[ai][bj][m][n], 0, 0, 0); MX_PIN(ai, bj); __builtin_amdgcn_s_setprio(0); } while (0)
#define MX_WAIT_V(n) asm volatile("s_waitcnt vmcnt(" #n ")" ::: "memory")
#define MX_WAIT_L(n) asm volatile("s_waitcnt lgkmcnt(" #n ")" ::: "memory")
#define MX_BAR __builtin_amdgcn_s_barrier()
#define MX_SCHED __builtin_amdgcn_sched_barrier(0)
#define MX_BODY(F, G) do { \
        MX_LDB##F(B0, 0, 0); MX_LDB##F(B1, 0, 1); MX_SCHED; MX_LDA##F(0, 0); MX_STAGE(MX_SA(1, 1), 0, cur.pm, t + 1, 1, voffA0, F); \
        MX_WAIT_V(8); MX_WAIT_L(0); MX_BAR; MX_MMA##F(0, 0, B0); MX_MMA##F(0, 1, B1); MX_BAR; MX_SCHED; \
        MX_LDA##F(0, 1); MX_STAGE(MX_SB(0, 0), 1, xpn, i2, 0, voffB0, G); MX_STAGE(MX_SB(0, 1), 1, xpn, i2, 1, voffB0, G); MX_STAGE(MX_SA(0, 0), 0, xpm, i2, 0, voffA0, G); \
        MX_WAIT_V(8); MX_WAIT_L(0); MX_BAR; MX_MMA##F(1, 0, B0); MX_MMA##F(1, 1, B1); MX_BAR; MX_SCHED; \
        MX_LDB##F(B0, 1, 0); MX_LDB##F(B1, 1, 1); MX_SCHED; MX_LDA##F(1, 0); MX_STAGE(MX_SA(0, 1), 0, xpm, i2, 1, voffA0, G); \
        MX_WAIT_V(8); MX_WAIT_L(0); MX_BAR; MX_MMA##F(0, 0, B0); MX_MMA##F(0, 1, B1); MX_BAR; MX_SCHED; \
        MX_LDA##F(1, 1); MX_STAGE(MX_SB(1, 0), 1, xpn, i3, 0, voffB0, G); MX_STAGE(MX_SB(1, 1), 1, xpn, i3, 1, voffB0, G); MX_STAGE(MX_SA(1, 0), 0, xpm, i3, 0, voffA0, G); \
        MX_WAIT_V(8); MX_WAIT_L(0); MX_BAR; MX_MMA##F(1, 0, B0); MX_MMA##F(1, 1, B1); MX_BAR; MX_SCHED; } while (0)
    UnitM cur, nxt; int ui = 0;
    if (!S.next(0, cur)) return;
    f32x4 acc[2][2][4][2];
#pragma unroll
    for (int a = 0; a < 2; ++a)
#pragma unroll
        for (int b = 0; b < 2; ++b)
#pragma unroll
            for (int m = 0; m < 4; ++m)
#pragma unroll
                for (int n = 0; n < 2; ++n) acc[a][b][m][n] = (f32x4){0.f, 0.f, 0.f, 0.f};
    bf16x8 At[4][2], B0[2][2], B1[2][2];
    MX_STAGE(MX_SB(0, 0), 1, cur.pn, 0, 0, voffB0, 0); MX_STAGE(MX_SB(0, 1), 1, cur.pn, 0, 1, voffB0, 0); MX_STAGE(MX_SA(0, 0), 0, cur.pm, 0, 0, voffA0, 0); MX_STAGE(MX_SA(0, 1), 0, cur.pm, 0, 1, voffA0, 0);
    if (wr == 1) MX_BAR;
    MX_WAIT_V(2); MX_BAR;
    MX_STAGE(MX_SB(1, 0), 1, cur.pn, 1, 0, voffB0, 0); MX_STAGE(MX_SA(1, 0), 0, cur.pm, 1, 0, voffA0, 0); MX_STAGE(MX_SB(1, 1), 1, cur.pn, 1, 1, voffB0, 0);
    MX_WAIT_V(6); MX_BAR;
    for (;;) {
        const bool has_next = S.next(ui + 1, nxt);
        if (!has_next) nxt = cur;
        { const int xpm = cur.pm, xpn = cur.pn;
          for (int t = 0; t < NT - 2; t += 2) { const int i2 = t + 2, i3 = t + 3; MX_BODY(0, 0); } }
        { const int xpm = nxt.pm, xpn = nxt.pn; const int t = NT - 2, i2 = 0, i3 = 1; MX_BODY(0, 0); }
        if (wr == 0) MX_BAR;
        { Unit eu; eu.a = nullptr; eu.b = nullptr; eu.pm = cur.pm; eu.pn = cur.pn; eu.kind = 0; E(acc, eu, wr, wc, fr, fq); }
        if (!has_next) break;
#pragma unroll
        for (int a = 0; a < 2; ++a)
#pragma unroll
            for (int b = 0; b < 2; ++b)
#pragma unroll
                for (int m = 0; m < 4; ++m)
#pragma unroll
                    for (int n = 0; n < 2; ++n) acc[a][b][m][n] = (f32x4){0.f, 0.f, 0.f, 0.f};
        cur = nxt; ++ui;
        if (wr == 1) MX_BAR;
    }
    MX_WAIT_V(0);
    MX_BAR;
#undef MX_SA
#undef MX_SB
#undef MX_STAGE
#undef MX_LDA0
#undef MX_PIN
#undef MX_LDB0
#undef MX_MMA0
#undef MX_WAIT_V
#undef MX_WAIT_L
#undef MX_BAR
#undef MX_SCHED
#undef MX_BODY
}
}

struct EpiStore {
    bf16_t* U; float* small; bf16_t* T; bf16_t* O2; int ldc2;
    __device__ __forceinline__ void operator()(const f32x4 (&acc)[2][2][4][2], const pg8::Unit& u, int wr, int wc, int fr_, int fq_) const {
        const int lane_ = opaque_tid() & 63, fr = lane_ & 15, fq = lane_ >> 4; (void)fr_; (void)fq_;
        const int row0 = u.pm * 256 + wr * 64 + fr;
        if (u.kind == 0 && u.pn == 48) {
            int fq2 = fq; asm volatile("" : "+v"(fq2));
            if (wc < 2) {
#pragma unroll
                for (int ai = 0; ai < 2; ++ai)
#pragma unroll
                    for (int m = 0; m < 4; ++m) { float* rp = small + (size_t)(row0 + ai * 128 + m * 16) * 64 + wc * 32 + 8 * fq2;
                        *(f32x4*)rp = acc[ai][0][m][0]; *(f32x4*)(rp + 4) = acc[ai][0][m][1]; }
            }
            return;
        }
        bf16_t* base = u.kind == 0 ? U : (u.kind == 1 ? T : O2); const int ldc = u.kind == 0 ? UW : (u.kind == 1 ? MTOK : ldc2);
        const int col0 = u.pn * 256 + wc * 32 + 8 * fq;
#pragma unroll
        for (int ai = 0; ai < 2; ++ai)
#pragma unroll
            for (int m = 0; m < 4; ++m) { bf16_t* rowp = base + (size_t)(row0 + ai * 128 + m * 16) * ldc + col0;
#pragma unroll
                for (int bj = 0; bj < 2; ++bj) { const f32x4 v0 = acc[ai][bj][m][0], v1 = acc[ai][bj][m][1];
                    u32x4 w; w.x = pg8::cvt_pk_bf16(v0[0], v0[1]); w.y = pg8::cvt_pk_bf16(v0[2], v0[3]); w.z = pg8::cvt_pk_bf16(v1[0], v1[1]); w.w = pg8::cvt_pk_bf16(v1[2], v1[3]);
                    *(u32x4*)(rowp + bj * 128) = w; } }
    }
};
struct EpiZ {
    float* Z;
    __device__ __forceinline__ void operator()(const f32x4 (&acc)[2][2][4][2], const pg8::Unit& u, int wr, int wc, int fr_, int fq_) const {
        const int lane_ = opaque_tid() & 63, fr = lane_ & 15, fq = lane_ >> 4; (void)fr_; (void)fq_;
        float* base = Z + ((size_t)u.pm * 256 + wr * 64 + fr) * 512 + (u.pn & 1) * 256 + wc * 32 + 8 * fq;
#pragma unroll
        for (int ai = 0; ai < 2; ++ai)
#pragma unroll
            for (int m = 0; m < 4; ++m)
#pragma unroll
                for (int bj = 0; bj < 2; ++bj) { float* rp = base + (size_t)(ai * 128 + m * 16) * 512 + bj * 128; *(f32x4*)rp = acc[ai][bj][m][0]; *(f32x4*)(rp + 4) = acc[ai][bj][m][1]; }
    }
};
struct EpiRes {
    const float* x; bf16_t* x1b;
    __device__ __forceinline__ void operator()(const f32x4 (&acc)[2][2][4][2], const pg8::Unit& u, int wr, int wc, int fr, int fq) const {
        const int row0 = u.pm * 256 + wr * 64 + fr, col0 = u.pn * 256 + wc * 32 + 8 * fq;
#pragma unroll
        for (int ai = 0; ai < 2; ++ai) {
            f32x4 xa[4][2][2];
#pragma unroll
            for (int m = 0; m < 4; ++m) { const size_t off = (size_t)(row0 + ai * 128 + m * 16) * DM + col0;
#pragma unroll
                for (int bj = 0; bj < 2; ++bj) { xa[m][bj][0] = *(const f32x4*)(x + off + bj * 128); xa[m][bj][1] = *(const f32x4*)(x + off + bj * 128 + 4); } }
            __builtin_amdgcn_sched_barrier(0);
#pragma unroll
            for (int m = 0; m < 4; ++m) { const size_t off = (size_t)(row0 + ai * 128 + m * 16) * DM + col0;
#pragma unroll
                for (int bj = 0; bj < 2; ++bj) { const f32x4 v0 = acc[ai][bj][m][0] + xa[m][bj][0], v1 = acc[ai][bj][m][1] + xa[m][bj][1];
                    u32x4 w; w.x = pk2(v0[0], v0[1]); w.y = pk2(v0[2], v0[3]); w.z = pk2(v1[0], v1[1]); w.w = pk2(v1[2], v1[3]);
                    *(u32x4*)(x1b + off + bj * 128) = w; } }
            __builtin_amdgcn_sched_barrier(0);
        }
    }
};
struct EpiGate {
    float* out; const bf16_t* x1b; const bf16_t* pe;
    __device__ __forceinline__ void operator()(const f32x4 (&acc)[2][2][4][2], const pg8::Unit& u, int wr, int wc, int fr, int fq) const {
        const int row0 = u.pm * 256 + wr * 64 + fr, col0 = u.pn * 256 + wc * 32 + 8 * fq;
#pragma unroll
        for (int ai = 0; ai < 2; ++ai) {
            u32x4 xw[4][2], pw[4][2];
#pragma unroll
            for (int m = 0; m < 4; ++m) { const size_t off = (size_t)(row0 + ai * 128 + m * 16) * DM + col0;
#pragma unroll
                for (int bj = 0; bj < 2; ++bj) { xw[m][bj] = *(const u32x4*)(x1b + off + bj * 128); pw[m][bj] = *(const u32x4*)(pe + off + bj * 128); } }
            __builtin_amdgcn_sched_barrier(0);
#pragma unroll
            for (int m = 0; m < 4; ++m) { const size_t off = (size_t)(row0 + ai * 128 + m * 16) * DM + col0;
#pragma unroll
                for (int bj = 0; bj < 2; ++bj) { const u32x4 xv = xw[m][bj], pv = pw[m][bj];
                    const f32x4 a0 = acc[ai][bj][m][0], a1 = acc[ai][bj][m][1];
                    f32x4 v0, v1;
                    v0[0] = bflo(xv.x) + sigmoidf_(a0[0]) * bflo(pv.x); v0[1] = bfhi(xv.x) + sigmoidf_(a0[1]) * bfhi(pv.x);
                    v0[2] = bflo(xv.y) + sigmoidf_(a0[2]) * bflo(pv.y); v0[3] = bfhi(xv.y) + sigmoidf_(a0[3]) * bfhi(pv.y);
                    v1[0] = bflo(xv.z) + sigmoidf_(a1[0]) * bflo(pv.z); v1[1] = bfhi(xv.z) + sigmoidf_(a1[1]) * bfhi(pv.z);
                    v1[2] = bflo(xv.w) + sigmoidf_(a1[2]) * bflo(pv.w); v1[3] = bfhi(xv.w) + sigmoidf_(a1[3]) * bfhi(pv.w);
                    *(f32x4*)(out + off + bj * 128) = v0; *(f32x4*)(out + off + bj * 128 + 4) = v1; } }
            __builtin_amdgcn_sched_barrier(0);
        }
    }
};

constexpr size_t MiB = 1u << 20;
constexpr size_t WS_CTL = 0;
constexpr size_t WS_HB = 1 * MiB;
constexpr size_t WS_WT = WS_HB + 64 * MiB;
constexpr size_t WS_WOT = WS_WT + 122 * MiB;
constexpr size_t WS_WGT = WS_WOT + 32 * MiB;
constexpr size_t WS_WPT = WS_WGT + 32 * MiB;
constexpr size_t WS_PB = WS_WPT + 2 * MiB;
constexpr size_t WS_W1K = WS_PB + 4 * MiB;
constexpr size_t WS_W1V = WS_W1K + 2 * MiB;
constexpr size_t WS_W2 = WS_W1V + 2 * MiB;
constexpr size_t WS_U = WS_W2 + 1 * MiB;
constexpr size_t WS_T = WS_U + 192 * MiB;
constexpr size_t WS_SMALL = WS_T + 48 * MiB;
constexpr size_t WS_PE = WS_SMALL + 2 * MiB;
constexpr size_t WS_DCT = WS_PE + 64 * MiB;
constexpr size_t WS_CT = WS_DCT + 64 * MiB;
constexpr size_t WS_MLS = WS_CT + 64 * MiB;
constexpr size_t WS_NSA = WS_MLS + 2 * MiB;
constexpr size_t WS_OC = WS_NSA + 2 * MiB;
constexpr size_t WS_OW = WS_OC + 32 * MiB;
constexpr size_t WS_HB8 = WS_OW + 32 * MiB;
constexpr size_t WS_W8 = WS_HB8 + 32 * MiB;
constexpr size_t WS_Y8 = WS_W8 + 28 * MiB;
constexpr size_t WS_WO8 = WS_Y8 + 16 * MiB;
constexpr size_t WS_Z = WS_WO8 + 8 * MiB;
constexpr size_t WS_CP = WS_Z + 8 * MiB;
constexpr size_t WS_END = WS_CP + 1 * MiB;

struct Params {
    const float *x, *p, *norm_w, *w_in, *conv_w, *i_bias, *f_bias, *hnorm_w, *qnorm_w, *knorm_w, *pe_k, *pe_v, *k_w1, *k_w2, *v_w1, *v_w2, *rel_bias, *w_out, *ple_proj, *ple_gate;
    float* out;
    unsigned char* ws;
    __device__ __forceinline__ unsigned* ctl() const { return (unsigned*)(ws + (WS_CTL)); }
    __device__ __forceinline__ bf16_t* hb() const { return (bf16_t*)(ws + (WS_HB)); }
    __device__ __forceinline__ bf16_t* Wt() const { return (bf16_t*)(ws + (WS_WT)); }
    __device__ __forceinline__ bf16_t* WoT() const { return (bf16_t*)(ws + (WS_WOT)); }
    __device__ __forceinline__ bf16_t* WgT() const { return (bf16_t*)(ws + (WS_WGT)); }
    __device__ __forceinline__ bf16_t* WpT() const { return (bf16_t*)(ws + (WS_WPT)); }
    __device__ __forceinline__ bf16_t* pb() const { return (bf16_t*)(ws + (WS_PB)); }
    __device__ __forceinline__ bf16_t* w1kT() const { return (bf16_t*)(ws + (WS_W1K)); }
    __device__ __forceinline__ bf16_t* w1vT() const { return (bf16_t*)(ws + (WS_W1V)); }
    __device__ __forceinline__ bf16_t* w2kT() const { return (bf16_t*)(ws + (WS_W2)); }
    __device__ __forceinline__ bf16_t* w2vT() const { return (bf16_t*)(ws + (WS_W2 + 65536)); }
    __device__ __forceinline__ bf16_t* U() const { return (bf16_t*)(ws + (WS_U)); }
    __device__ __forceinline__ bf16_t* T() const { return (bf16_t*)(ws + (WS_T)); }
    __device__ __forceinline__ float* small() const { return (float*)(ws + (WS_SMALL)); }
    __device__ __forceinline__ bf16_t* y() const { return (bf16_t*)(ws + (WS_HB)); }
    __device__ __forceinline__ bf16_t* x1b() const { return (bf16_t*)(ws + (WS_WT)); }
    __device__ __forceinline__ bf16_t* pe() const { return (bf16_t*)(ws + (WS_PE)); }
    __device__ __forceinline__ bf16_t* dCt() const { return (bf16_t*)(ws + (WS_DCT)); }
    __device__ __forceinline__ bf16_t* Ct() const { return (bf16_t*)(ws + (WS_CT)); }
    __device__ __forceinline__ float* dn() const { return (float*)(ws + (WS_MLS)); }
    __device__ __forceinline__ float* nst() const { return (float*)(ws + (WS_MLS + 4 * 131072)); }
    __device__ __forceinline__ float* cbL() const { return (float*)(ws + (WS_MLS + 4 * 262144)); }
    __device__ __forceinline__ float* cgmax() const { return (float*)(ws + (WS_MLS + 4 * 263168)); }
    __device__ __forceinline__ float* cm() const { return (float*)(ws + (WS_MLS + 4 * 264192)); }
    __device__ __forceinline__ float* mb() const { return (float*)(ws + (WS_MLS + 4 * 265216)); }
    __device__ __forceinline__ float* mg() const { return (float*)(ws + (WS_MLS + 4 * (265216 + 65536))); }
    __device__ __forceinline__ bf16_t* kcmp() const { return (bf16_t*)(ws + (WS_NSA)); }
    __device__ __forceinline__ bf16_t* vcmpT() const { return (bf16_t*)(ws + (WS_NSA + 524288)); }
    __device__ __forceinline__ unsigned long long* sel() const { return (unsigned long long*)(ws + (WS_NSA + 1048576)); }
    __device__ __forceinline__ unsigned long long* selu() const { return (unsigned long long*)(ws + (WS_NSA + 1048576 + 262144)); }
    __device__ __forceinline__ bf16_t* oc() const { return (bf16_t*)(ws + (WS_OC)); }
    __device__ __forceinline__ bf16_t* ow() const { return (bf16_t*)(ws + (WS_OW)); }
    __device__ __forceinline__ unsigned char* hb8() const { return (unsigned char*)(ws + (WS_HB8)); }
    __device__ __forceinline__ unsigned char* W8() const { return (unsigned char*)(ws + (WS_W8)); }
    __device__ __forceinline__ unsigned char* y8() const { return (unsigned char*)(ws + (WS_Y8)); }
    __device__ __forceinline__ unsigned char* Wo8() const { return (unsigned char*)(ws + (WS_WO8)); }
    __device__ __forceinline__ float* Z() const { return (float*)(ws + (WS_Z)); }
    __device__ __forceinline__ float* cpart() const { return (float*)(ws + (WS_CP)); }
};
__host__ __device__ inline void fill_params(Params& P, void* const* d_in, void* d_out, void* d_ws) {
    const float* const* in = (const float* const*)d_in;
    P.x = in[0]; P.p = in[1]; P.norm_w = in[2]; P.w_in = in[3]; P.conv_w = in[4]; P.i_bias = in[5]; P.f_bias = in[6]; P.hnorm_w = in[7]; P.qnorm_w = in[8]; P.knorm_w = in[9];
    P.pe_k = in[10]; P.pe_v = in[11]; P.k_w1 = in[12]; P.k_w2 = in[13]; P.v_w1 = in[14]; P.v_w2 = in[15]; P.rel_bias = in[16]; P.w_out = in[17]; P.ple_proj = in[18]; P.ple_gate = in[19];
    P.out = (float*)d_out; P.ws = (unsigned char*)d_ws;
}

__device__ __forceinline__ void p0_transpose_item(const float* W, int K, int N, bf16_t* WT, LAS float* scr, int item, int lane, bool remap, unsigned char* P8, const float* pev = nullptr, float* cp = nullptr) {
    const int nblk = N / 32, kb = item / nblk, nb = item % nblk, k0 = 64 * kb, n0 = 32 * nb;
#pragma unroll 8
    for (int i = 0; i < 32; ++i) { const int kk = 2 * i + (lane >> 5); scr[kk * 33 + (lane & 31)] = W[(size_t)(k0 + kk) * N + n0 + (lane & 31)]; }
    asm volatile("s_waitcnt lgkmcnt(0)" ::: "memory");
    if (pev != nullptr) {
        const int n = lane & 31, kh = lane >> 5; float s = 0.f;
#pragma unroll 8
        for (int kk = 0; kk < 32; ++kk) s += scr[(kh * 32 + kk) * 33 + n] * pev[k0 + kh * 32 + kk];
        s += __shfl_xor(s, 32);
        if (lane < 32) cp[(size_t)kb * N + n0 + n] = s;
    }
    const int c = lane & 7;
#pragma unroll
    for (int j = 0; j < 4; ++j) { const int n = (lane >> 3) + 8 * j; const LAS float* s = scr + (8 * c) * 33 + n;
        u32x4 o; o.x = pk2(s[0 * 33], s[1 * 33]); o.y = pk2(s[2 * 33], s[3 * 33]); o.z = pk2(s[4 * 33], s[5 * 33]); o.w = pk2(s[6 * 33], s[7 * 33]);
        const int dr = remap ? wt_row(n0 + n) : (n0 + n);
        int r8 = remap ? w8_row(dr) : -1; int kk8 = k0;
        if (!remap && P8 != nullptr && k0 >= 2048) { r8 = dr; kk8 = k0 - 2048; }
        const size_t pitch8 = remap ? 4096 : 2048;
        if (r8 < 0) *(u32x4*)(WT + (size_t)dr * K + k0 + 8 * c) = o;
        else { u32x2 q8; q8.x = pk_fp8x4(64.f * s[0 * 33], 64.f * s[1 * 33], 64.f * s[2 * 33], 64.f * s[3 * 33]); q8.y = pk_fp8x4(64.f * s[4 * 33], 64.f * s[5 * 33], 64.f * s[6 * 33], 64.f * s[7 * 33]);
               *(u32x2*)(P8 + (size_t)r8 * pitch8 + kk8 + 8 * c) = q8; } }
    asm volatile("s_waitcnt lgkmcnt(0)" ::: "memory");
}
__device__ __forceinline__ void p0_norm_row(const float* xrow, const float* w, bf16_t* orow, unsigned char* orow8, int lane) {
    const f32x4* xr = (const f32x4*)xrow + lane; const f32x4* wr = (const f32x4*)w + lane;
    f32x4 v[16]; float s = 0.f;
#pragma unroll
    for (int j = 0; j < 16; ++j) { v[j] = xr[64 * j]; s += (v[j][0] * v[j][0] + v[j][1] * v[j][1]) + (v[j][2] * v[j][2] + v[j][3] * v[j][3]); }
    const float rstd = 1.f / sqrtf(wave_sum(s) * (1.f / DM) + EPS);
    u32x2* o8 = (u32x2*)orow + lane;
#pragma unroll
    for (int j = 0; j < 16; ++j) { const f32x4 ww = wr[64 * j]; const float h0 = v[j][0] * rstd * ww[0], h1 = v[j][1] * rstd * ww[1], h2 = v[j][2] * rstd * ww[2], h3 = v[j][3] * rstd * ww[3];
        u32x2 o; o.x = pk2(h0, h1); o.y = pk2(h2, h3); o8[64 * j] = o;
        ((unsigned*)orow8)[lane + 64 * j] = pk_fp8x4(h0, h1, h2, h3); }
}
__device__ __forceinline__ void phase0(const Params& P, LAS unsigned char* lds_, int bid, int nblk) {
    LAS unsigned char* lds = opq(lds_);
    const int tid = opaque_tid(), lane = tid & 63, wave = tid >> 6;
    LAS float* scr = (LAS float*)(lds + wave * 8704);
    const int gw = bid * 8 + wave, NGW = nblk * 8;
    constexpr int I_IN = (DM / 64) * (INW / 32), I_SQ = (DM / 64) * (DM / 32), I_PP = (256 / 64) * (DM / 32), I_W1 = (DM / 64) * (256 / 32), I_W2 = (256 / 64) * (128 / 32);
    constexpr int NITEMS = I_IN + 2 * I_SQ + I_PP + 2 * I_W1 + 2 * I_W2;
    for (int it = gw; it < NITEMS; it += NGW) {
        int r = it;
        if (r < I_IN) { p0_transpose_item(P.w_in, DM, INW, P.Wt(), scr, r, lane, true, P.W8()); continue; } r -= I_IN;
        if (r < I_SQ) { p0_transpose_item(P.w_out, DM, DM, P.WoT(), scr, r, lane, false, P.Wo8()); continue; } r -= I_SQ;
        if (r < I_SQ) { p0_transpose_item(P.ple_gate, DM, DM, P.WgT(), scr, r, lane, false, nullptr); continue; } r -= I_SQ;
        if (r < I_PP) { p0_transpose_item(P.ple_proj, 256, DM, P.WpT(), scr, r, lane, false, nullptr); continue; } r -= I_PP;
        if (r < I_W1) { p0_transpose_item(P.k_w1, DM, 256, P.w1kT(), scr, r, lane, false, nullptr, P.pe_k, P.cpart()); continue; } r -= I_W1;
        if (r < I_W1) { p0_transpose_item(P.v_w1, DM, 256, P.w1vT(), scr, r, lane, false, nullptr, P.pe_v, P.cpart() + 64 * 256); continue; } r -= I_W1;
        if (r < I_W2) { p0_transpose_item(P.k_w2, 256, 128, P.w2kT(), scr, r, lane, false, nullptr); continue; } r -= I_W2;
        p0_transpose_item(P.v_w2, 256, 128, P.w2vT(), scr, r, lane, false, nullptr);
    }
    for (int m = gw; m < MTOK; m += NGW) p0_norm_row(P.x + (size_t)m * DM, P.norm_w, P.hb() + (size_t)m * DM, P.hb8() + (size_t)m * DM, lane);
    for (size_t i = (size_t)bid * 512 + tid; i < (size_t)MTOK * 256 / 8; i += (size_t)nblk * 512) {
        const f32x4 a = ((const f32x4*)P.p)[2 * i], b = ((const f32x4*)P.p)[2 * i + 1];
        u32x4 o; o.x = pk2(a[0], a[1]); o.y = pk2(a[2], a[3]); o.z = pk2(b[0], b[1]); o.w = pk2(b[2], b[3]); ((u32x4*)P.pb())[i] = o; }
    { u32x4* z = (u32x4*)(P.Wt() + (size_t)(WT_SMALL + 64) * DM); const size_t n = (size_t)(WT_T - WT_SMALL - 64) * DM / 8;
      for (size_t i = (size_t)bid * 512 + tid; i < n; i += (size_t)nblk * 512) z[i] = (u32x4){0u, 0u, 0u, 0u}; }
}

__device__ __forceinline__ void phase_gemm1(const Params& P, LAS unsigned char* lds, int bid, int nblk) {
    EpiStore E{P.U(), P.small(), P.T(), nullptr, 0};
    { pg8::SchedG1B S; S.hb = (const char*)P.hb(); S.wt = (const char*)P.Wt(); S.G = nblk; S.c = bid;
      pg8::gemm_phase<EpiStore, pg8::SchedG1B, false>(lds, DM, S, E); }
    { pg8::SchedG1F S; S.hb8 = (const char*)P.hb8(); S.w8 = (const char*)P.W8(); S.G = nblk; S.c = bid;
      pg8::gemm_phase<EpiStore, pg8::SchedG1F, true>(lds, DM / 2, S, E); }
}
__device__ __forceinline__ void phase_gemm_pe(const Params& P, LAS unsigned char* lds, int bid, int nblk) {
    if (bid < 0) return;
    pg8::Sched2 S; S.K = 256; S.G = nblk; S.c = bid;
    S.a0 = (const char*)P.pb(); S.b0 = (const char*)P.WpT(); S.nM0 = MTOK / 256; S.nN0 = DM / 256; S.kind0 = 2;
    S.a1 = nullptr; S.b1 = nullptr; S.nM1 = 0; S.nN1 = 0; S.kind1 = 2;
    EpiStore E{nullptr, nullptr, nullptr, P.pe(), DM};
    pg8::gemm_phase<EpiStore, pg8::Sched2>(lds, 256, S, E);
}
__device__ __forceinline__ void phase_gemm2(const Params& P, LAS unsigned char* lds, int bid, int nblk) {
    pg8::SchedM S; S.a = (const char*)P.y(); S.b = (const char*)P.WoT(); S.a8 = (const char*)P.y8(); S.b8 = (const char*)P.Wo8(); S.nM = MTOK / 256; S.nN = DM / 256; S.G = nblk; S.c = bid;
    EpiRes E{P.x, P.x1b()};
    pg8::gemm_phase_mixed<EpiRes>(lds, S, E);
}
__device__ __forceinline__ void phase_gemm3(const Params& P, LAS unsigned char* lds, int bid, int nblk) {
    pg8::Sched2 S; S.K = DM; S.G = nblk; S.c = bid;
    S.a0 = (const char*)P.x1b(); S.b0 = (const char*)P.WgT(); S.nM0 = MTOK / 256; S.nN0 = DM / 256; S.kind0 = 0;
    S.a1 = nullptr; S.b1 = nullptr; S.nM1 = 0; S.nN1 = 0; S.kind1 = 0;
    EpiGate E{P.out, P.x1b(), P.pe()};
    pg8::gemm_phase<EpiGate, pg8::Sched2>(lds, DM, S, E);
}

#define MFMA16(a, b, c) __builtin_amdgcn_mfma_f32_16x16x32_bf16((a), (b), (c), 0, 0, 0)
__device__ __forceinline__ bf16x8 mk_frag(u32x4 w) { return __builtin_bit_cast(bf16x8, w); }
__device__ __forceinline__ bf16x8 mk_frag2(u32x2 lo, u32x2 hi) { u32x4 w; w.x = lo.x; w.y = lo.y; w.z = hi.x; w.w = hi.y; return __builtin_bit_cast(bf16x8, w); }

struct ConvW { f32x4 w0[4], w1[4]; };
__device__ __forceinline__ void conv_load_w(const Params& P, int chan0, ConvW& cw) {
#pragma unroll
    for (int j = 0; j < 4; ++j) { cw.w0[j] = *(const f32x4*)(P.conv_w + j * 2048 + chan0); cw.w1[j] = *(const f32x4*)(P.conv_w + j * 2048 + chan0 + 4); }
}
__device__ __forceinline__ void conv_load_x(const Params& P, int b, int spos, int ucol0, u32x4 (&raw)[4]) {
#pragma unroll
    for (int j = 0; j < 4; ++j) { const int ts = spos - 3 + j, tc = ts < 0 ? 0 : ts; raw[j] = *(const u32x4*)(P.U() + (size_t)(b * SEQ + tc) * UW + ucol0); }
}
__device__ __forceinline__ void conv_apply(const ConvW& cw, const u32x4 (&raw)[4], int spos, float (&o)[8]) {
#pragma unroll
    for (int e = 0; e < 8; ++e) o[e] = 0.f;
#pragma unroll
    for (int j = 0; j < 4; ++j) {
        const float z = (spos - 3 + j) < 0 ? 0.f : 1.f;
        o[0] += z * cw.w0[j][0] * bflo(raw[j].x); o[1] += z * cw.w0[j][1] * bfhi(raw[j].x); o[2] += z * cw.w0[j][2] * bflo(raw[j].y); o[3] += z * cw.w0[j][3] * bfhi(raw[j].y);
        o[4] += z * cw.w1[j][0] * bflo(raw[j].z); o[5] += z * cw.w1[j][1] * bfhi(raw[j].z); o[6] += z * cw.w1[j][2] * bflo(raw[j].w); o[7] += z * cw.w1[j][3] * bfhi(raw[j].w);
    }
#pragma unroll
    for (int e = 0; e < 8; ++e) o[e] = siluf_(o[e]);
}

__device__ __forceinline__ void ml_step1(const Params& P, LAS unsigned char* lds_, int task) {
    LAS unsigned char* lds = opq(lds_);
    const int tid = opaque_tid(), lane = tid & 63, wave = tid >> 6, q4 = lane >> 4, l15 = lane & 15, half = wave >> 2, hw = wave & 3, ht = tid & 255;
    const int ch = 2 * task + half;
    const int bh = ch >> 6, c = ch & 63, b = bh >> 3, h = bh & 7, tok0 = b * SEQ + c * 64;
    LAS bf16_t* kT = (LAS bf16_t*)(lds + half * 18944);
    LAS float* wk = (LAS float*)(lds + half * 18944 + 18432);
    if (hw == 0) {
        const float fi = P.small()[(size_t)(tok0 + lane) * 64 + h] + P.i_bias[h];
        const float ff = P.small()[(size_t)(tok0 + lane) * 64 + 8 + h] + P.f_bias[h];
        const float lf = fminf(ff, 0.f) - log1pf(expf(-fabsf(ff)));
        float bc = lf;
#pragma unroll
        for (int o = 1; o < 64; o <<= 1) { const float v = shfl_up_l(bc, o, lane); if (lane >= o) bc += v; }
        const float g = fi - bc; const float gm = wave_max(g);
        const float bL = __builtin_bit_cast(float, __builtin_amdgcn_readlane(__builtin_bit_cast(int, bc), 63));
        wk[lane] = expf(g - gm);
        P.mb()[(size_t)bh * SEQ + c * 64 + lane] = bc; P.mg()[(size_t)bh * SEQ + c * 64 + lane] = g;
        if (lane == 0) { P.cbL()[ch] = bL; P.cgmax()[ch] = gm; }
    }
    float kv[4][8];
    { ConvW cw; conv_load_w(P, 1024 + h * 128 + (ht & 15) * 8, cw);
      u32x4 raw[4][4];
#pragma unroll
      for (int i = 0; i < 4; ++i) { const int id = ht + 256 * i, s = id >> 4, d8 = id & 15; conv_load_x(P, b, c * 64 + s, UK + h * 128 + d8 * 8, raw[i]); }
#pragma unroll
      for (int i = 0; i < 4; ++i) { const int id = ht + 256 * i, s = id >> 4; conv_apply(cw, raw[i], c * 64 + s, kv[i]); } }
    __syncthreads();
#pragma unroll
    for (int i = 0; i < 4; ++i) {
        const int id = ht + 256 * i, s = id >> 4, d8 = id & 15;
        const float sc = wk[s] * 0.08838834764831845f;
#pragma unroll
        for (int e = 0; e < 8; ++e) kT[(d8 * 8 + e) * 72 + s] = (bf16_t)f2bf(kv[i][e] * sc);
    }
    __syncthreads();
    if (ht < 128) { float s = 0.f; for (int j = 0; j < 64; ++j) s += bf2f(kT[ht * 72 + j]); P.dn()[(size_t)ch * 128 + ht] = s; }
    bf16x8 af[2][2];
#pragma unroll
    for (int dt = 0; dt < 2; ++dt)
#pragma unroll
        for (int ks = 0; ks < 2; ++ks) af[dt][ks] = *(const LAS bf16x8*)(kT + (32 * hw + 16 * dt + l15) * 72 + 32 * ks + 8 * q4);
    const bf16_t* vbase = P.T() + (size_t)(TV + h * 256 + l15) * MTOK + tok0 + 8 * q4;
#pragma unroll 8
    for (int vt = 0; vt < 16; ++vt) {
        bf16x8 bfr[2];
#pragma unroll
        for (int ks = 0; ks < 2; ++ks) bfr[ks] = mk_frag(*(const u32x4*)(vbase + (size_t)(16 * vt) * MTOK + 32 * ks));
#pragma unroll
        for (int dt = 0; dt < 2; ++dt) {
            f32x4 acc = {0.f, 0.f, 0.f, 0.f};
#pragma unroll
            for (int ks = 0; ks < 2; ++ks) acc = MFMA16(af[dt][ks], bfr[ks], acc);
            u32x2 w; w.x = pk2(acc[0], acc[1]); w.y = pk2(acc[2], acc[3]);
            *(u32x2*)(P.dCt() + ((size_t)ch * 256 + 16 * vt + l15) * 128 + 32 * hw + 16 * dt + 4 * q4) = w;
        }
    }
    __syncthreads();
}

__device__ __forceinline__ void ml_step2(const Params& P, int bh, int part) {
    const int tid = opaque_tid(), lane = tid & 63; const size_t e4 = ((size_t)part * 512 + tid) * 4;
    const float bLl = P.cbL()[bh * 64 + lane], gml = P.cgmax()[bh * 64 + lane];
    float decl = 0.f, scl = 0.f, ml = 0.f;
    {
        float m = 0.f;
#pragma unroll
        for (int c = 0; c < 64; ++c) {
            const float bL = __builtin_bit_cast(float, __builtin_amdgcn_readlane(__builtin_bit_cast(int, bLl), c)), gm = __builtin_bit_cast(float, __builtin_amdgcn_readlane(__builtin_bit_cast(int, gml), c));
            const float mn = fmaxf(bL + m, bL + gm), dec = expf(bL + m - mn), sc = expf(bL + gm - mn);
            if (lane == c) { decl = dec; scl = sc; ml = m; }
            m = mn;
        }
    }
    if (part == 0 && tid < 64) P.cm()[bh * 64 + tid] = ml;
    const bool do_n = (part == 0 && tid < 128);
    f32x4 C = {0.f, 0.f, 0.f, 0.f}; float nn = 0.f;
    const bf16_t* __restrict__ dsrc = P.dCt() + (size_t)bh * 64 * 32768 + e4;
    bf16_t* __restrict__ cdst = P.Ct() + (size_t)bh * 64 * 32768 + e4;
    for (int c0 = 0; c0 < 64; c0 += 8) {
        u32x2 d[8]; float dnv[8];
#pragma unroll
        for (int i = 0; i < 8; ++i) { d[i] = *(const u32x2*)(dsrc + (size_t)(c0 + i) * 32768); dnv[i] = do_n ? P.dn()[(size_t)(bh * 64 + c0 + i) * 128 + tid] : 0.f; }
#pragma unroll
        for (int i = 0; i < 8; ++i) {
            const int c = c0 + i;
            { u32x2 w; w.x = pk2(C[0], C[1]); w.y = pk2(C[2], C[3]); *(u32x2*)(cdst + (size_t)c * 32768) = w; }
            if (do_n) P.nst()[(size_t)(bh * 64 + c) * 128 + tid] = nn;
            const float decc = __builtin_bit_cast(float, __builtin_amdgcn_readlane(__builtin_bit_cast(int, decl), c)), scc = __builtin_bit_cast(float, __builtin_amdgcn_readlane(__builtin_bit_cast(int, scl), c));
            C[0] = decc * C[0] + scc * bflo(d[i].x); C[1] = decc * C[1] + scc * bfhi(d[i].x); C[2] = decc * C[2] + scc * bflo(d[i].y); C[3] = decc * C[3] + scc * bfhi(d[i].y);
            nn = decc * nn + scc * dnv[i];
        }
    }
}

__device__ __forceinline__ void ml_step3(const Params& P, LAS unsigned char* lds_, int task) {
    LAS unsigned char* lds = opq(lds_);
    const int tid = opaque_tid(), lane = tid & 63, wave = tid >> 6, q4 = lane >> 4, l15 = lane & 15, half = wave >> 2, tq = wave & 3, ht = tid & 255;
    const int ch = 2 * task + half;
    const int bh = ch >> 6, c = ch & 63, b = bh >> 3, h = bh & 7, tok0 = b * SEQ + c * 64;
    LAS unsigned char* hl = lds + half * 36864;
    LAS bf16_t* qs = (LAS bf16_t*)hl;
    LAS bf16_t* ks_ = (LAS bf16_t*)(hl + 17408);
    LAS float* fb = (LAS float*)(hl + 34816);
    LAS float* fg = fb + 64;
    LAS float* fpm = fb + 128;
#pragma unroll
    for (int isk = 0; isk < 2; ++isk) {
        ConvW cw; conv_load_w(P, isk * 1024 + h * 128 + (ht & 15) * 8, cw);
        u32x4 raw[4][4];
#pragma unroll
        for (int i = 0; i < 4; ++i) { const int id = ht + 256 * i, s = id >> 4, d8 = id & 15; conv_load_x(P, b, c * 64 + s, (isk ? UK : UQ) + h * 128 + d8 * 8, raw[i]); }
#pragma unroll
        for (int i = 0; i < 4; ++i) { const int id = ht + 256 * i, s = id >> 4, d8 = id & 15;
            float o[8]; conv_apply(cw, raw[i], c * 64 + s, o);
            const float sc = isk ? 0.08838834764831845f : 1.f;
            u32x4 w; w.x = pk2(o[0] * sc, o[1] * sc); w.y = pk2(o[2] * sc, o[3] * sc); w.z = pk2(o[4] * sc, o[5] * sc); w.w = pk2(o[6] * sc, o[7] * sc);
            *(LAS u32x4*)((isk ? ks_ : qs) + s * 136 + d8 * 8) = w; }
    }
    if (tq == 0) {
        const float bc = P.mb()[(size_t)bh * SEQ + c * 64 + lane], g = P.mg()[(size_t)bh * SEQ + c * 64 + lane];
        float pm = g;
#pragma unroll
        for (int o = 1; o < 64; o <<= 1) { const float v = shfl_up_l(pm, o, lane); if (lane >= o) pm = fmaxf(pm, v); }
        fb[lane] = bc; fg[lane] = g; fpm[lane] = pm;
    }
    const float m_c = P.cm()[ch];
    const int t = 16 * tq + l15;
    const size_t tok = (size_t)(tok0 + t);
    __syncthreads();
    bf16x8 qf[4];
#pragma unroll
    for (int ks = 0; ks < 4; ++ks) qf[ks] = *(const LAS bf16x8*)(qs + t * 136 + 32 * ks + 8 * q4);
    const float Mt = fmaxf(m_c, fpm[t]);
    float sc[4][4]; float rowsum = 0.f;
#pragma unroll
    for (int st = 0; st < 4; ++st) {
        f32x4 a = {0.f, 0.f, 0.f, 0.f};
#pragma unroll
        for (int ks = 0; ks < 4; ++ks) { const bf16x8 kf = *(const LAS bf16x8*)(ks_ + (16 * st + l15) * 136 + 32 * ks + 8 * q4); a = MFMA16(kf, qf[ks], a); }
#pragma unroll
        for (int r = 0; r < 4; ++r) { const int s = 16 * st + 4 * q4 + r; const float v = (s <= t) ? a[r] * __expf(fg[s] - Mt) : 0.f; sc[st][r] = v; rowsum += v; }
    }
    rowsum = xq_sum(rowsum);
    bf16x8 pf[2];
#pragma unroll
    for (int k2 = 0; k2 < 2; ++k2) { u32x4 w; w.x = pk2(sc[2 * k2][0], sc[2 * k2][1]); w.y = pk2(sc[2 * k2][2], sc[2 * k2][3]); w.z = pk2(sc[2 * k2 + 1][0], sc[2 * k2 + 1][1]); w.w = pk2(sc[2 * k2 + 1][2], sc[2 * k2 + 1][3]); pf[k2] = mk_frag(w); }
    float qn = 0.f;
    { const float* np = P.nst() + (size_t)ch * 128;
#pragma unroll
      for (int ks = 0; ks < 4; ++ks) { const f32x4 n0 = *(const f32x4*)(np + 32 * ks + 8 * q4), n1 = *(const f32x4*)(np + 32 * ks + 8 * q4 + 4);
          const u32x4 qw = __builtin_bit_cast(u32x4, qf[ks]);
          qn += bflo(qw.x) * n0[0] + bfhi(qw.x) * n0[1] + bflo(qw.y) * n0[2] + bfhi(qw.y) * n0[3] + bflo(qw.z) * n1[0] + bfhi(qw.z) * n1[1] + bflo(qw.w) * n1[2] + bfhi(qw.w) * n1[3]; }
      qn = xq_sum(qn); }
    const float inter = __expf(m_c - Mt);
    const float den = inter * qn + rowsum;
    const float inv = 1.f / fmaxf(fabsf(den), __expf(-(fb[t] + Mt)));
    f32x4 hv[16]; float ss = 0.f;
    const bf16_t* vbase = P.T() + (size_t)(TV + h * 256 + l15) * MTOK + tok0 + 4 * q4;
    const bf16_t* cbase = P.Ct() + ((size_t)ch * 256 + l15) * 128 + 8 * q4;
#pragma unroll
    for (int vb = 0; vb < 4; ++vb) {
        u32x4 cfr[4][4]; u32x2 vfr[4][2][2];
#pragma unroll
        for (int v = 0; v < 4; ++v) { const int vt = 4 * vb + v;
#pragma unroll
            for (int ks = 0; ks < 4; ++ks) cfr[v][ks] = *(const u32x4*)(cbase + (size_t)(16 * vt) * 128 + 32 * ks);
#pragma unroll
            for (int k2 = 0; k2 < 2; ++k2) { const bf16_t* vp = vbase + (size_t)(16 * vt) * MTOK + 32 * k2; vfr[v][k2][0] = *(const u32x2*)vp; vfr[v][k2][1] = *(const u32x2*)(vp + 16); } }
        __builtin_amdgcn_sched_barrier(0);
#pragma unroll
        for (int v = 0; v < 4; ++v) { const int vt = 4 * vb + v;
            f32x4 a1 = {0.f, 0.f, 0.f, 0.f}, a2 = {0.f, 0.f, 0.f, 0.f};
#pragma unroll
            for (int ks = 0; ks < 4; ++ks) a1 = MFMA16(mk_frag(cfr[v][ks]), qf[ks], a1);
#pragma unroll
            for (int k2 = 0; k2 < 2; ++k2) a2 = MFMA16(mk_frag2(vfr[v][k2][0], vfr[v][k2][1]), pf[k2], a2);
#pragma unroll
            for (int r = 0; r < 4; ++r) { const float hh = (inter * a1[r] + a2[r]) * inv; hv[vt][r] = hh; ss += hh * hh; } }
        __builtin_amdgcn_sched_barrier(0);
    }
    ss = xq_sum(ss);
    const float rstd = __builtin_amdgcn_rsqf(ss * (1.f / 256.f) + EPS);
    {
        u32x2 owv[16], zwv[16]; f32x4 nwv[16];
#pragma unroll
        for (int vt = 0; vt < 16; ++vt) { const int v = 16 * vt + 4 * q4;
            owv[vt] = *(const u32x2*)(P.U() + tok * UW + UO + h * 256 + v); zwv[vt] = *(const u32x2*)(P.U() + tok * UW + UZ + h * 256 + v); nwv[vt] = *(const f32x4*)(P.hnorm_w + h * 256 + v); }
        __builtin_amdgcn_sched_barrier(0);
#pragma unroll
        for (int vt = 0; vt < 16; ++vt) {
            const int v = 16 * vt + 4 * q4;
            const u32x2 ow = owv[vt], zw = zwv[vt]; const f32x4 nw = nwv[vt];
            const float o0 = bflo(ow.x), o1 = bfhi(ow.x), o2 = bflo(ow.y), o3 = bfhi(ow.y), z0 = bflo(zw.x), z1 = bfhi(zw.x), z2 = bflo(zw.y), z3 = bfhi(zw.y);
            const float y0 = hv[vt][0] * rstd * nw[0] * sigmoidf_(o0) * siluf_(z0), y1 = hv[vt][1] * rstd * nw[1] * sigmoidf_(o1) * siluf_(z1);
            const float y2 = hv[vt][2] * rstd * nw[2] * sigmoidf_(o2) * siluf_(z2), y3 = hv[vt][3] * rstd * nw[3] * sigmoidf_(o3) * siluf_(z3);
            u32x2 w; w.x = pk2(y0, y1); w.y = pk2(y2, y3);
            *(u32x2*)(P.y() + tok * DM + h * 256 + v) = w;
        }
    }
    __syncthreads();
}

constexpr float LOG2E = 1.4426950408889634f;
__device__ __forceinline__ void cmp_gemm_task(const Params& P, LAS unsigned char* lds, int unit) {
    pg8::SchedC S; S.U = (const char*)P.U(); S.w1k = (const char*)P.w1kT(); S.w1v = (const char*)P.w1vT(); S.ukc = UKC; S.uvc = UVC; S.unit = unit;
    EpiZ E{P.Z()};
    pg8::gemm_cmp<EpiZ>(lds, S, E);
    __syncthreads();
}
__device__ __forceinline__ void cmp_task(const Params& P, LAS unsigned char* lds_, int task) {
    LAS unsigned char* lds = opq(lds_);
    const int tid = opaque_tid(), lane = tid & 63, wave = tid >> 6, q4 = lane >> 4, l15 = lane & 15;
    const int kv = task & 1, bg = (task >> 1) & 7, it = task >> 4;
    LAS float* cs = (LAS float*)lds;
    LAS bf16_t* H1 = (LAS bf16_t*)(lds + 16384);
    LAS float* O2 = (LAS float*)(lds + 33280);
    const bf16_t* w2T = kv ? P.w2vT() : P.w2kT();
    if (tid < 256) { const float* cp = P.cpart() + (size_t)kv * 64 * 256 + tid; float s = 0.f;
#pragma unroll 16
        for (int kb = 0; kb < 64; ++kb) s += cp[kb * 256];
        cs[tid] = s; }
    __syncthreads();
    { const int m = tid >> 4, n0 = (tid & 15) * 16, i = 32 * it + m, i1 = i + 1 > 255 ? 255 : i + 1;
      const float* z0 = P.Z() + ((size_t)(kv * 8 + bg) * 256 + i) * 512 + n0; const float* z1 = P.Z() + ((size_t)(kv * 8 + bg) * 256 + i1) * 512 + 256 + n0;
#pragma unroll
      for (int j = 0; j < 4; ++j) { const f32x4 a = *(const f32x4*)(z0 + 4 * j), b = *(const f32x4*)(z1 + 4 * j), c = *(const LAS f32x4*)(cs + n0 + 4 * j);
          u32x2 w; w.x = pk2(siluf_(a[0] + b[0] + c[0]), siluf_(a[1] + b[1] + c[1])); w.y = pk2(siluf_(a[2] + b[2] + c[2]), siluf_(a[3] + b[3] + c[3]));
          *(LAS u32x2*)(H1 + m * 264 + n0 + 4 * j) = w; } }
    __syncthreads();
    {
        f32x4 a2[2] = {(f32x4){0.f, 0.f, 0.f, 0.f}, (f32x4){0.f, 0.f, 0.f, 0.f}};
#pragma unroll
        for (int ks = 0; ks < 8; ++ks) {
            const bf16x8 af = mk_frag(*(const u32x4*)(w2T + (size_t)(16 * wave + l15) * 256 + 32 * ks + 8 * q4));
#pragma unroll
            for (int mt = 0; mt < 2; ++mt) { const bf16x8 bf = *(const LAS bf16x8*)(H1 + (16 * mt + l15) * 264 + 32 * ks + 8 * q4); a2[mt] = MFMA16(af, bf, a2[mt]); }
        }
#pragma unroll
        for (int mt = 0; mt < 2; ++mt) *(LAS f32x4*)(O2 + (16 * mt + l15) * 132 + 16 * wave + 4 * q4) = a2[mt];
    }
    __syncthreads();
    if (kv == 0) {
        const int m = 4 * wave + q4, i = 32 * it + m;
        const LAS float* op = O2 + m * 132 + 8 * l15; float v[8]; float ss = 0.f;
#pragma unroll
        for (int e = 0; e < 8; ++e) { v[e] = op[e]; ss += v[e] * v[e]; }
        ss += __shfl_xor(ss, 1); ss += __shfl_xor(ss, 2); ss += __shfl_xor(ss, 4); ss += __shfl_xor(ss, 8);
        const float rstd = (i == 255) ? 0.f : __builtin_amdgcn_rsqf(ss * (1.f / 128.f) + EPS);
        const f32x4 w0 = *(const f32x4*)(P.knorm_w + 8 * l15), w1 = *(const f32x4*)(P.knorm_w + 8 * l15 + 4);
        u32x4 w; w.x = pk2(v[0] * rstd * w0[0], v[1] * rstd * w0[1]); w.y = pk2(v[2] * rstd * w0[2], v[3] * rstd * w0[3]);
        w.z = pk2(v[4] * rstd * w1[0], v[5] * rstd * w1[1]); w.w = pk2(v[6] * rstd * w1[2], v[7] * rstd * w1[3]);
        *(u32x4*)(P.kcmp() + ((size_t)bg * 256 + i) * 128 + 8 * l15) = w;
    } else {
        const int d = tid >> 2, ms = (tid & 3) * 8; float v[8];
#pragma unroll
        for (int e = 0; e < 8; ++e) v[e] = (32 * it + ms + e == 255) ? 0.f : O2[(ms + e) * 132 + d];
        u32x4 w; w.x = pk2(v[0], v[1]); w.y = pk2(v[2], v[3]); w.z = pk2(v[4], v[5]); w.w = pk2(v[6], v[7]);
        *(u32x4*)(P.vcmpT() + ((size_t)bg * 128 + d) * 256 + 32 * it + ms) = w;
    }
    __syncthreads();
}

__device__ __forceinline__ void ksnorm_task(const Params& P, int task) {
    const int tid = opaque_tid(), l16 = tid & 15, r0 = tid >> 4;
    const f32x4 w0 = *(const f32x4*)(P.knorm_w + 128 + 8 * l16), w1 = *(const f32x4*)(P.knorm_w + 128 + 8 * l16 + 4);
#pragma unroll 4
    for (int p = 0; p < 16; ++p) {
        const int row = 32 * p + r0, tok = 128 * task + (row >> 2), g = row & 3;
        bf16_t* ptr = P.U() + (size_t)tok * UW + UKS + g * 128 + 8 * l16;
        const u32x4 raw = *(const u32x4*)ptr;
        float v[8] = {bflo(raw.x), bfhi(raw.x), bflo(raw.y), bfhi(raw.y), bflo(raw.z), bfhi(raw.z), bflo(raw.w), bfhi(raw.w)};
        float ss = 0.f;
#pragma unroll
        for (int e = 0; e < 8; ++e) ss += v[e] * v[e];
        ss = row16_sum(ss);
        const float rstd = __builtin_amdgcn_rsqf(ss * (1.f / 128.f) + EPS);
        u32x4 o; o.x = pk2(v[0] * rstd * w0[0], v[1] * rstd * w0[1]); o.y = pk2(v[2] * rstd * w0[2], v[3] * rstd * w0[3]);
        o.z = pk2(v[4] * rstd * w1[0], v[5] * rstd * w1[1]); o.w = pk2(v[6] * rstd * w1[2], v[7] * rstd * w1[3]);
        *(u32x4*)ptr = o;
    }
}

__device__ __forceinline__ int rel_bucket(int n) {
    if (n < 16) return n;
    int v = 16 + (int)(logf((float)n * (1.f / 16.f)) / 2.0794415416798357f * 16.f);
    return v > 31 ? 31 : v;
}

__device__ __forceinline__ unsigned cvtpk(float lo, float hi) { return pk2(lo, hi); }
template <int MODE>
__device__ __forceinline__ void attn_task(const Params& P, LAS unsigned char* lds_, int bg, int qb) {
    LAS unsigned char* lds = opq(lds_);
    const int tid = opaque_tid(), lane = tid & 63, wave = tid >> 6, q4 = lane >> 4, l15 = lane & 15;
    const int b = bg >> 2, g = bg & 3, hd = wave >> 1, qhalf = wave & 1, head = g * 4 + hd;
    LAS float* tab = (LAS float*)(lds + 35840);
    LAS float* imps = (LAS float*)(lds + 38912);
    LAS unsigned* um = (LAS unsigned*)(lds + 104448);
    for (int i = tid; i < 4 * 129; i += 512) { const int hh = i / 129, dd = i % 129; tab[hh * 132 + dd] = P.rel_bias[rel_bucket(dd) * 16 + g * 4 + hh] * LOG2E; }
    bf16x8 qf[2][4];
#pragma unroll
    for (int qt = 0; qt < 2; ++qt) {
        const size_t tok = (size_t)b * SEQ + 64 * qb + 32 * qhalf + 16 * qt + l15;
        u32x4 raw[4]; float ss = 0.f;
#pragma unroll
        for (int ks = 0; ks < 4; ++ks) { raw[ks] = *(const u32x4*)(P.U() + tok * UW + UNQ + head * 128 + 32 * ks + 8 * q4);
            const float a0 = bflo(raw[ks].x), a1 = bfhi(raw[ks].x), a2 = bflo(raw[ks].y), a3 = bfhi(raw[ks].y), a4 = bflo(raw[ks].z), a5 = bfhi(raw[ks].z), a6 = bflo(raw[ks].w), a7 = bfhi(raw[ks].w);
            ss += a0 * a0 + a1 * a1 + a2 * a2 + a3 * a3 + a4 * a4 + a5 * a5 + a6 * a6 + a7 * a7; }
        ss = xq_sum(ss);
        const float sc = __builtin_amdgcn_rsqf(ss * (1.f / 128.f) + EPS) * (0.08838834764831845f * LOG2E);
#pragma unroll
        for (int ks = 0; ks < 4; ++ks) { const f32x4 w0 = *(const f32x4*)(P.qnorm_w + 32 * ks + 8 * q4), w1 = *(const f32x4*)(P.qnorm_w + 32 * ks + 8 * q4 + 4);
            u32x4 w; w.x = cvtpk(bflo(raw[ks].x) * sc * w0[0], bfhi(raw[ks].x) * sc * w0[1]); w.y = cvtpk(bflo(raw[ks].y) * sc * w0[2], bfhi(raw[ks].y) * sc * w0[3]);
            w.z = cvtpk(bflo(raw[ks].z) * sc * w1[0], bfhi(raw[ks].z) * sc * w1[1]); w.w = cvtpk(bflo(raw[ks].w) * sc * w1[2], bfhi(raw[ks].w) * sc * w1[3]);
            qf[qt][ks] = mk_frag(w); }
    }
    unsigned long long smask[2] = {0ull, 0ull};
    if (MODE == 2) {
#pragma unroll
        for (int qt = 0; qt < 2; ++qt) smask[qt] = P.sel()[(size_t)bg * SEQ + 64 * qb + 32 * qhalf + 16 * qt + l15];
    }
    f32x4 ao[8][2]; f32x4 ai[4][2];
#pragma unroll
    for (int dt = 0; dt < 8; ++dt) { ao[dt][0] = (f32x4){0.f, 0.f, 0.f, 0.f}; ao[dt][1] = (f32x4){0.f, 0.f, 0.f, 0.f}; }
#pragma unroll
    for (int nt = 0; nt < 4; ++nt) { ai[nt][0] = (f32x4){0.f, 0.f, 0.f, 0.f}; ai[nt][1] = (f32x4){0.f, 0.f, 0.f, 0.f}; }
    float mrun[2] = {-1e30f, -1e30f}, lsum[2] = {0.f, 0.f};
    unsigned long long rem;
    if (MODE == 0) { const int jl = qb - 8 < 0 ? 0 : qb - 8; rem = ((2ull << qb) - 1ull) & ~((1ull << jl) - 1ull); }
    else if (MODE == 1) { rem = (2ull << ((4 * qb + 2) >> 6)) - 1ull; }
    else { rem = P.selu()[bg * 64 + qb] & ((2ull << qb) - 1ull); }
    const int krow = tid >> 4, kc16 = tid & 15, vrow = tid >> 3, vc8 = tid & 7;
    const bf16_t* kbase = (MODE == 1) ? P.kcmp() + ((size_t)bg * 256 + krow) * 128 + 8 * kc16 : P.U() + ((size_t)b * SEQ + krow) * UW + (MODE == 0 ? UKW : UKS) + g * 128 + 8 * kc16;
    const size_t kstride = (MODE == 1) ? (size_t)32 * 128 : (size_t)32 * UW;
    const bf16_t* vbase = (MODE == 1) ? P.vcmpT() + ((size_t)bg * 128 + vrow) * 256 + 8 * vc8 : P.T() + (size_t)((MODE == 0 ? TVW : TVS) + g * 128 + vrow) * MTOK + (size_t)b * SEQ + 8 * vc8;
    const size_t vstride = (MODE == 1) ? (size_t)64 * 256 : (size_t)64 * MTOK;
    const size_t ktile = (MODE == 1) ? (size_t)64 * 128 : (size_t)64 * UW;
    f32x4 kw0 = {1.f, 1.f, 1.f, 1.f}, kw1 = {1.f, 1.f, 1.f, 1.f};
    if (MODE == 0) { const float* kw = P.knorm_w + 256 + 8 * kc16; kw0 = *(const f32x4*)kw; kw1 = *(const f32x4*)(kw + 4); }
    u32x4 kr[2], vr[2];
#define AT_LOAD(J) do { _Pragma("unroll") for (int _i = 0; _i < 2; ++_i) { kr[_i] = *(const u32x4*)(kbase + (size_t)(J) * ktile + _i * kstride); vr[_i] = *(const u32x4*)(vbase + (size_t)(J) * 64 + _i * vstride); } } while (0)
    int j = __builtin_ctzll(rem); rem &= rem - 1ull;
    AT_LOAD(j);
    int buf = 0;
    for (;;) {
        LAS bf16_t* Ks = (LAS bf16_t*)(lds + buf * 38912);
        LAS bf16_t* Vs = (LAS bf16_t*)(lds + buf * 38912 + 17408);
#pragma unroll
        for (int i = 0; i < 2; ++i) {
            u32x4 raw = kr[i];
            if (MODE == 0) {
                float v[8] = {bflo(raw.x), bfhi(raw.x), bflo(raw.y), bfhi(raw.y), bflo(raw.z), bfhi(raw.z), bflo(raw.w), bfhi(raw.w)};
                float ss = 0.f;
#pragma unroll
                for (int e = 0; e < 8; ++e) ss += v[e] * v[e];
                ss = row16_sum(ss);
                const float rstd = __builtin_amdgcn_rsqf(ss * (1.f / 128.f) + EPS);
                raw.x = cvtpk(v[0] * rstd * kw0[0], v[1] * rstd * kw0[1]); raw.y = cvtpk(v[2] * rstd * kw0[2], v[3] * rstd * kw0[3]);
                raw.z = cvtpk(v[4] * rstd * kw1[0], v[5] * rstd * kw1[1]); raw.w = cvtpk(v[6] * rstd * kw1[2], v[7] * rstd * kw1[3]);
            }
            *(LAS u32x4*)(Ks + (krow + 32 * i) * 136 + 8 * kc16) = raw;
            *(LAS u32x4*)(Vs + (vrow + 64 * i) * 72 + 8 * vc8) = vr[i];
        }
        __syncthreads();
        const bool more = rem != 0ull; int jn = j;
        if (more) { jn = __builtin_ctzll(rem); rem &= rem - 1ull; if (MODE != 1) AT_LOAD(jn); }
        f32x4 s[4][2];
        {
            const LAS bf16_t* kp = Ks + l15 * 136 + 8 * q4;
            bf16x8 ka[4], kb[4];
#define AT_LDK(dst, kt) do { _Pragma("unroll") for (int ks = 0; ks < 4; ++ks) dst[ks] = *(const LAS bf16x8*)(kp + (16 * (kt)) * 136 + 32 * ks); } while (0)
#define AT_MMS(src, kt) do { s[kt][0] = (f32x4){0.f, 0.f, 0.f, 0.f}; s[kt][1] = (f32x4){0.f, 0.f, 0.f, 0.f}; \
            _Pragma("unroll") for (int ks = 0; ks < 4; ++ks) { s[kt][0] = MFMA16(src[ks], qf[0][ks], s[kt][0]); s[kt][1] = MFMA16(src[ks], qf[1][ks], s[kt][1]); } } while (0)
            AT_LDK(ka, 0); AT_LDK(kb, 1); __builtin_amdgcn_sched_barrier(0);
            AT_MMS(ka, 0); __builtin_amdgcn_sched_barrier(0);
            AT_LDK(ka, 2); __builtin_amdgcn_sched_barrier(0);
            AT_MMS(kb, 1); __builtin_amdgcn_sched_barrier(0);
            AT_LDK(kb, 3); __builtin_amdgcn_sched_barrier(0);
            AT_MMS(ka, 2); __builtin_amdgcn_sched_barrier(0);
            AT_MMS(kb, 3); __builtin_amdgcn_sched_barrier(0);
#undef AT_LDK
#undef AT_MMS
        }
        const bool plain = (MODE == 0) ? (qb - j >= 3 && qb - j <= 7) : (MODE == 2 ? (qb - j >= 3) : false);
        const float cbias = tab[hd * 132 + 128];
        bf16x8 pf[2][2];
#pragma unroll
        for (int qt = 0; qt < 2; ++qt) {
            const int tl = 32 * qhalf + 16 * qt + l15;
            const bool selok = (MODE == 2) ? (((smask[qt] >> j) & 1ull) != 0ull) : true;
            float mx = -INFINITY;
            if (plain) {
                const float cb = selok ? cbias : -INFINITY;
#pragma unroll
                for (int kt = 0; kt < 4; ++kt)
#pragma unroll
                    for (int r = 0; r < 4; ++r) { const float v = s[kt][qt][r] + cb; s[kt][qt][r] = v; mx = fmaxf(mx, v); }
            } else if (MODE == 0) {
#pragma unroll
                for (int kt = 0; kt < 4; ++kt) {
                    float tb[4];
#pragma unroll
                    for (int r = 0; r < 4; ++r) {
                        const int dist = 64 * (qb - j) + tl - (16 * kt + 4 * q4 + r);
                        const int di = dist < 0 ? 0 : (dist > 128 ? 128 : dist);
                        tb[r] = tab[hd * 132 + di];
                    }
                    asm volatile("" : "+v"(tb[0]), "+v"(tb[1]), "+v"(tb[2]), "+v"(tb[3]));
#pragma unroll
                    for (int r = 0; r < 4; ++r) {
                        const int dist = 64 * (qb - j) + tl - (16 * kt + 4 * q4 + r);
                        const bool ok = dist >= 0 && dist < 512;
                        const float v = ok ? s[kt][qt][r] + tb[r] : -INFINITY;
                        s[kt][qt][r] = v; mx = fmaxf(mx, v);
                    }
                }
            } else {
#pragma unroll
                for (int kt = 0; kt < 4; ++kt)
#pragma unroll
                    for (int r = 0; r < 4; ++r) {
                        const int kl = 16 * kt + 4 * q4 + r;
                        int dist; bool ok;
                        if (MODE == 1) { dist = 64 * qb + tl - (16 * (64 * j + kl) + 31); ok = dist >= 0; }
                        else { dist = 64 * (qb - j) + tl - kl; ok = dist >= 0 && selok; if (MODE == 0) ok = ok && dist < 512; }
                        const int di = dist < 0 ? 0 : (dist > 128 ? 128 : dist);
                        const float v = ok ? s[kt][qt][r] + tab[hd * 132 + di] : -INFINITY;
                        s[kt][qt][r] = v; mx = fmaxf(mx, v);
                    }
            }
            mx = xq_max(mx);
            const float mn = fmaxf(mrun[qt], mx), alpha = __builtin_amdgcn_exp2f(mrun[qt] - mn); mrun[qt] = mn;
            float ps = 0.f;
#pragma unroll
            for (int kt = 0; kt < 4; ++kt)
#pragma unroll
                for (int r = 0; r < 4; ++r) { const float p = __builtin_amdgcn_exp2f(s[kt][qt][r] - mn); s[kt][qt][r] = p; ps += p; }
            lsum[qt] = lsum[qt] * alpha + ps;
            if (__ballot(alpha != 1.f) != 0ull) {
#pragma unroll
                for (int dt = 0; dt < 8; ++dt) ao[dt][qt] = ao[dt][qt] * alpha;
                if (MODE == 1) {
#pragma unroll
                    for (int nt = 0; nt < 4; ++nt) ai[nt][qt] = ai[nt][qt] * alpha;
                }
            }
#pragma unroll
            for (int k2 = 0; k2 < 2; ++k2) { u32x4 w; w.x = cvtpk(s[2 * k2][qt][0], s[2 * k2][qt][1]); w.y = cvtpk(s[2 * k2][qt][2], s[2 * k2][qt][3]);
                w.z = cvtpk(s[2 * k2 + 1][qt][0], s[2 * k2 + 1][qt][1]); w.w = cvtpk(s[2 * k2 + 1][qt][2], s[2 * k2 + 1][qt][3]); pf[qt][k2] = mk_frag(w); }
        }
        {
            const LAS bf16_t* vp0 = Vs + l15 * 72 + 4 * q4;
            bf16x8 va[2], vb[2];
#define AT_LDV(dst, dt) do { _Pragma("unroll") for (int k2 = 0; k2 < 2; ++k2) { const LAS bf16_t* vp = vp0 + (16 * (dt)) * 72 + 32 * k2; dst[k2] = mk_frag2(*(const LAS u32x2*)vp, *(const LAS u32x2*)(vp + 16)); } } while (0)
#define AT_MMO(src, dt) do { _Pragma("unroll") for (int k2 = 0; k2 < 2; ++k2) { ao[dt][0] = MFMA16(src[k2], pf[0][k2], ao[dt][0]); ao[dt][1] = MFMA16(src[k2], pf[1][k2], ao[dt][1]); } } while (0)
            AT_LDV(va, 0); AT_LDV(vb, 1); __builtin_amdgcn_sched_barrier(0);
            AT_MMO(va, 0); __builtin_amdgcn_sched_barrier(0); AT_LDV(va, 2); __builtin_amdgcn_sched_barrier(0);
            AT_MMO(vb, 1); __builtin_amdgcn_sched_barrier(0); AT_LDV(vb, 3); __builtin_amdgcn_sched_barrier(0);
            AT_MMO(va, 2); __builtin_amdgcn_sched_barrier(0); AT_LDV(va, 4); __builtin_amdgcn_sched_barrier(0);
            AT_MMO(vb, 3); __builtin_amdgcn_sched_barrier(0); AT_LDV(vb, 5); __builtin_amdgcn_sched_barrier(0);
            AT_MMO(va, 4); __builtin_amdgcn_sched_barrier(0); AT_LDV(va, 6); __builtin_amdgcn_sched_barrier(0);
            AT_MMO(vb, 5); __builtin_amdgcn_sched_barrier(0); AT_LDV(vb, 7); __builtin_amdgcn_sched_barrier(0);
            AT_MMO(va, 6); __builtin_amdgcn_sched_barrier(0);
            AT_MMO(vb, 7); __builtin_amdgcn_sched_barrier(0);
#undef AT_LDV
#undef AT_MMO
        }
        if (MODE == 1) {
#pragma unroll
            for (int nt = 0; nt < 4; ++nt)
#pragma unroll
                for (int k2 = 0; k2 < 2; ++k2) {
                    const int n = 16 * nt + l15, cb = 64 * j + 32 * k2 + 4 * q4;
                    unsigned e[8];
#pragma unroll
                    for (int jj = 0; jj < 8; ++jj) { const int c = cb + (jj < 4 ? jj : 12 + jj); e[jj] = (c >= 4 * n - 1 && c <= 4 * n + 3) ? 0x3F80u : 0u; }
                    u32x4 w; w.x = e[0] | (e[1] << 16); w.y = e[2] | (e[3] << 16); w.z = e[4] | (e[5] << 16); w.w = e[6] | (e[7] << 16);
                    const bf16x8 of = mk_frag(w);
                    ai[nt][0] = MFMA16(of, pf[0][k2], ai[nt][0]); ai[nt][1] = MFMA16(of, pf[1][k2], ai[nt][1]);
                }
        }
        if (!more) break;
        if (MODE == 1) { __syncthreads(); AT_LOAD(jn); }
        else buf ^= 1;
        j = jn;
    }
#undef AT_LOAD
    float inv[2];
#pragma unroll
    for (int qt = 0; qt < 2; ++qt) { const float l = xq_sum(lsum[qt]); inv[qt] = l > 0.f ? 1.f / l : 0.f; }
    if (MODE == 0 || MODE == 1) {
        bf16_t* ob = (MODE == 0) ? P.ow() : P.oc();
#pragma unroll
        for (int qt = 0; qt < 2; ++qt) { const size_t tok = (size_t)b * SEQ + 64 * qb + 32 * qhalf + 16 * qt + l15;
#pragma unroll
            for (int dt = 0; dt < 8; ++dt) { const f32x4 o = ao[dt][qt] * inv[qt]; u32x2 w; w.x = cvtpk(o[0], o[1]); w.y = cvtpk(o[2], o[3]);
                *(u32x2*)(ob + tok * 2048 + head * 128 + 16 * dt + 4 * q4) = w; } }
    }
    if (MODE == 1) {
        __syncthreads();
#pragma unroll
        for (int qt = 0; qt < 2; ++qt)
#pragma unroll
            for (int nt = 0; nt < 4; ++nt) *(LAS f32x4*)(imps + (hd * 64 + 32 * qhalf + 16 * qt + l15) * 64 + 16 * nt + 4 * q4) = ai[nt][qt] * inv[qt];
        __syncthreads();
        unsigned long long uni = 0ull;
        for (int qq = 0; qq < 8; ++qq) {
            const int tl = 8 * wave + qq;
            float v = imps[(0 * 64 + tl) * 64 + lane] + imps[(1 * 64 + tl) * 64 + lane] + imps[(2 * 64 + tl) * 64 + lane] + imps[(3 * 64 + tl) * 64 + lane];
            if (lane == 0 || lane == qb || lane == qb - 1) v = 1e4f;
            if (lane > qb) v = -1e30f;
            int rank = 0;
#pragma unroll
            for (int jn2 = 0; jn2 < 64; ++jn2) { const float vj = __builtin_bit_cast(float, __builtin_amdgcn_readlane(__builtin_bit_cast(int, v), jn2)); rank += (vj > v || (vj == v && jn2 < lane)) ? 1 : 0; }
            unsigned long long mk = __ballot(rank < 16 && lane <= qb);
            uni |= mk;
            if (lane == 0) P.sel()[(size_t)bg * SEQ + 64 * qb + tl] = mk;
        }
        if (lane == 0) { um[2 * wave] = (unsigned)uni; um[2 * wave + 1] = (unsigned)(uni >> 32); }
        __syncthreads();
        if (tid == 0) { unsigned lo = 0u, hi = 0u; for (int w = 0; w < 8; ++w) { lo |= um[2 * w]; hi |= um[2 * w + 1]; } P.selu()[bg * 64 + qb] = ((unsigned long long)hi << 32) | lo; }
    }
    if (MODE == 2) {
#pragma unroll
        for (int qt = 0; qt < 2; ++qt) { const size_t tok = (size_t)b * SEQ + 64 * qb + 32 * qhalf + 16 * qt + l15;
            const float* gp = P.small() + tok * 64 + 16 + head * 3;
            const float g0 = sigmoidf_(gp[0]), g1 = sigmoidf_(gp[1]), g2 = sigmoidf_(gp[2]);
#pragma unroll
            for (int dt = 0; dt < 8; ++dt) { const int col = head * 128 + 16 * dt + 4 * q4;
                const u32x2 cw = *(const u32x2*)(P.oc() + tok * 2048 + col), ww = *(const u32x2*)(P.ow() + tok * 2048 + col), zw = *(const u32x2*)(P.U() + tok * UW + UNZ + col);
                const f32x4 o = ao[dt][qt] * inv[qt];
                const float y0 = (g0 * bflo(cw.x) + g1 * o[0] + g2 * bflo(ww.x)) * siluf_(bflo(zw.x)), y1 = (g0 * bfhi(cw.x) + g1 * o[1] + g2 * bfhi(ww.x)) * siluf_(bfhi(zw.x));
                const float y2 = (g0 * bflo(cw.y) + g1 * o[2] + g2 * bflo(ww.y)) * siluf_(bflo(zw.y)), y3 = (g0 * bfhi(cw.y) + g1 * o[3] + g2 * bfhi(ww.y)) * siluf_(bfhi(zw.y));
                u32x2 w; w.x = cvtpk(y0, y1); w.y = cvtpk(y2, y3);
                *(u32x2*)(P.y() + tok * DM + 2048 + col) = w; } }
    }
    __syncthreads();
}

typedef float f32x16 __attribute__((ext_vector_type(16)));
#define MFMA32(a, b, c) __builtin_amdgcn_mfma_f32_32x32x16_bf16((a), (b), (c), 0, 0, 0)
__device__ __forceinline__ float half_swap_max(float v) { float a = v, b = v; swap32(a, b); return fmaxf(a, b); }
__device__ __forceinline__ float half_swap_sum(float v) { float a = v, b = v; swap32(a, b); return a + b; }
template <int MODE>
__device__ __forceinline__ void attn_fast(const Params& P, LAS unsigned char* lds_, int bg, int qb) {
    LAS unsigned char* lds = opq(lds_);
    const int tid = opaque_tid(), lane = tid & 63, wave = tid >> 6, r32 = lane & 31, hi = lane >> 5;
    const int b = bg >> 2, g = bg & 3, hd = wave >> 1, qhalf = wave & 1, head = g * 4 + hd, tl = 32 * qhalf + r32;
    constexpr int BUFB = 35840;
    LAS float* tab = (LAS float*)(lds + 3 * BUFB);
    for (int i = tid; i < 4 * 129; i += 512) { const int hh = i / 129, dd = i % 129; tab[hh * 132 + dd] = P.rel_bias[rel_bucket(dd) * 16 + g * 4 + hh] * LOG2E; }
    bf16x8 qf[8];
    {
        const size_t tok = (size_t)b * SEQ + 64 * qb + tl;
        u32x4 raw[8]; float ss = 0.f;
#pragma unroll
        for (int ks = 0; ks < 8; ++ks) { raw[ks] = *(const u32x4*)(P.U() + tok * UW + UNQ + head * 128 + 16 * ks + 8 * hi);
            const float a0 = bflo(raw[ks].x), a1 = bfhi(raw[ks].x), a2 = bflo(raw[ks].y), a3 = bfhi(raw[ks].y), a4 = bflo(raw[ks].z), a5 = bfhi(raw[ks].z), a6 = bflo(raw[ks].w), a7 = bfhi(raw[ks].w);
            ss += a0 * a0 + a1 * a1 + a2 * a2 + a3 * a3 + a4 * a4 + a5 * a5 + a6 * a6 + a7 * a7; }
        ss = half_swap_sum(ss);
        const float sc = __builtin_amdgcn_rsqf(ss * (1.f / 128.f) + EPS) * (0.08838834764831845f * LOG2E);
#pragma unroll
        for (int ks = 0; ks < 8; ++ks) { const f32x4 w0 = *(const f32x4*)(P.qnorm_w + 16 * ks + 8 * hi), w1 = *(const f32x4*)(P.qnorm_w + 16 * ks + 8 * hi + 4);
            u32x4 w; w.x = cvtpk(bflo(raw[ks].x) * sc * w0[0], bfhi(raw[ks].x) * sc * w0[1]); w.y = cvtpk(bflo(raw[ks].y) * sc * w0[2], bfhi(raw[ks].y) * sc * w0[3]);
            w.z = cvtpk(bflo(raw[ks].z) * sc * w1[0], bfhi(raw[ks].z) * sc * w1[1]); w.w = cvtpk(bflo(raw[ks].w) * sc * w1[2], bfhi(raw[ks].w) * sc * w1[3]);
            qf[ks] = mk_frag(w); }
    }
    unsigned long long smask = ~0ull;
    if (MODE == 2) smask = P.sel()[(size_t)bg * SEQ + 64 * qb + tl];
    f32x16 o[4];
#pragma unroll
    for (int dt = 0; dt < 4; ++dt)
#pragma unroll
        for (int r = 0; r < 16; ++r) o[dt][r] = 0.f;
    float mrun = -1e30f, lrun = 0.f;
    unsigned long long pset, sset;
    {
        const unsigned long long upto = (2ull << qb) - 1ull;
        const unsigned long long near = upto & ~((qb >= 3) ? ((1ull << (qb - 2)) - 1ull) : 0ull);
        if (MODE == 0) { const int jl = qb - 8 < 0 ? 0 : qb - 8; const unsigned long long win = upto & ~((1ull << jl) - 1ull);
            sset = near | ((qb >= 8) ? (1ull << (qb - 8)) : 0ull); pset = win & ~sset; }
        else { const unsigned long long un = P.selu()[bg * 64 + qb] & upto; sset = near & un; pset = un & ~near; }
    }
    const int krow = tid >> 4, kc16 = tid & 15, vrow = tid >> 3, vc8 = tid & 7;
    const bf16_t* kbase = P.U() + ((size_t)b * SEQ + krow) * UW + (MODE == 0 ? UKW : UKS) + g * 128 + 8 * kc16;
    const bf16_t* vbase = P.T() + (size_t)((MODE == 0 ? TVW : TVS) + g * 128 + vrow) * MTOK + (size_t)b * SEQ + 8 * vc8;
    f32x4 kw0 = {1.f, 1.f, 1.f, 1.f}, kw1 = {1.f, 1.f, 1.f, 1.f};
    if (MODE == 0) { const float* kw = P.knorm_w + 256 + 8 * kc16; kw0 = *(const f32x4*)kw; kw1 = *(const f32x4*)(kw + 4); }
    u32x4 kr[2], vr[2];
#define AF_LOAD(J) do { _Pragma("unroll") for (int _i = 0; _i < 2; ++_i) { kr[_i] = *(const u32x4*)(kbase + (size_t)(J) * 64 * UW + (size_t)_i * 32 * UW); vr[_i] = *(const u32x4*)(vbase + (size_t)(J) * 64 + (size_t)_i * 64 * MTOK); } } while (0)
#define AF_WRITE(BUF) do { LAS bf16_t* Ks_ = (LAS bf16_t*)(lds + (BUF) * BUFB); LAS bf16_t* Vs_ = (LAS bf16_t*)(lds + (BUF) * BUFB + 17408); \
        _Pragma("unroll") for (int i = 0; i < 2; ++i) { u32x4 raw = kr[i]; \
            if (MODE == 0) { float v[8] = {bflo(raw.x), bfhi(raw.x), bflo(raw.y), bfhi(raw.y), bflo(raw.z), bfhi(raw.z), bflo(raw.w), bfhi(raw.w)}; float ss = 0.f; \
                _Pragma("unroll") for (int e = 0; e < 8; ++e) ss += v[e] * v[e]; \
                ss = row16_sum(ss); const float rstd = __builtin_amdgcn_rsqf(ss * (1.f / 128.f) + EPS); \
                raw.x = cvtpk(v[0] * rstd * kw0[0], v[1] * rstd * kw0[1]); raw.y = cvtpk(v[2] * rstd * kw0[2], v[3] * rstd * kw0[3]); \
                raw.z = cvtpk(v[4] * rstd * kw1[0], v[5] * rstd * kw1[1]); raw.w = cvtpk(v[6] * rstd * kw1[2], v[7] * rstd * kw1[3]); } \
            *(LAS u32x4*)(Ks_ + (krow + 32 * i) * 136 + 8 * kc16) = raw; \
            LAS bf16_t* vp_ = Vs_ + (vrow + 64 * i) * 72 + 16 * (vc8 >> 1) + 4 * (vc8 & 1); \
            *(LAS u32x2*)vp_ = (u32x2){vr[i].x, vr[i].y}; *(LAS u32x2*)(vp_ + 8) = (u32x2){vr[i].z, vr[i].w}; } } while (0)
#define AF_LDK(DST, KP, KS2) do { DST[0] = *(const LAS bf16x8*)((KP) + 32 * (KS2)); DST[1] = *(const LAS bf16x8*)((KP) + 32 * 136 + 32 * (KS2)); \
                                  DST[2] = *(const LAS bf16x8*)((KP) + 32 * (KS2) + 16); DST[3] = *(const LAS bf16x8*)((KP) + 32 * 136 + 32 * (KS2) + 16); } while (0)
#define AF_MMK(SRC, S0, S1, KS2) do { S0 = MFMA32(SRC[0], qf[2 * (KS2)], S0); S1 = MFMA32(SRC[1], qf[2 * (KS2)], S1); S0 = MFMA32(SRC[2], qf[2 * (KS2) + 1], S0); S1 = MFMA32(SRC[3], qf[2 * (KS2) + 1], S1); } while (0)
#define AF_S(S0, S1, BUF) do { const LAS bf16_t* kp = (const LAS bf16_t*)(lds + (BUF) * BUFB) + r32 * 136 + 8 * hi; \
        bf16x8 fa[4], fb[4]; \
        _Pragma("unroll") for (int r = 0; r < 16; ++r) { S0[r] = 0.f; S1[r] = 0.f; } \
        AF_LDK(fa, kp, 0); AF_LDK(fb, kp, 1); __builtin_amdgcn_sched_barrier(0); \
        AF_MMK(fa, S0, S1, 0); __builtin_amdgcn_sched_barrier(0); AF_LDK(fa, kp, 2); __builtin_amdgcn_sched_barrier(0); \
        AF_MMK(fb, S0, S1, 1); __builtin_amdgcn_sched_barrier(0); AF_LDK(fb, kp, 3); __builtin_amdgcn_sched_barrier(0); \
        AF_MMK(fa, S0, S1, 2); __builtin_amdgcn_sched_barrier(0); \
        AF_MMK(fb, S0, S1, 3); __builtin_amdgcn_sched_barrier(0); } while (0)
#define AF_SMH(S0, S1, CB, ALPHA) do { float mx = fmaxf(S0[0], S1[0]); \
        _Pragma("unroll") for (int r = 1; r < 16; ++r) mx = fmaxf(mx, fmaxf(S0[r], S1[r])); \
        mx = half_swap_max(mx) + (CB); \
        const bool keep = __all(mx - mrun <= 11.5f); \
        const float mn = keep ? mrun : fmaxf(mrun, mx); ALPHA = __builtin_amdgcn_exp2f(mrun - mn); mrun = mn; \
        const float cc = (CB) - mn; \
        _Pragma("unroll") for (int r = 0; r < 16; ++r) { S0[r] = __builtin_amdgcn_exp2f(S0[r] + cc); S1[r] = __builtin_amdgcn_exp2f(S1[r] + cc); } } while (0)
#define AF_SMT(S0, S1, ALPHA) do { float ps = S0[0] + S1[0]; \
        _Pragma("unroll") for (int r = 1; r < 16; ++r) ps += S0[r] + S1[r]; \
        ps = half_swap_sum(ps); lrun = lrun * (ALPHA) + ps; \
        _Pragma("unroll") for (int s2 = 0; s2 < 2; ++s2) { \
            u32x4 w; w.x = cvtpk(S0[8 * s2 + 0], S0[8 * s2 + 1]); w.y = cvtpk(S0[8 * s2 + 2], S0[8 * s2 + 3]); w.z = cvtpk(S0[8 * s2 + 4], S0[8 * s2 + 5]); w.w = cvtpk(S0[8 * s2 + 6], S0[8 * s2 + 7]); pf[0][s2] = mk_frag(w); \
            u32x4 x; x.x = cvtpk(S1[8 * s2 + 0], S1[8 * s2 + 1]); x.y = cvtpk(S1[8 * s2 + 2], S1[8 * s2 + 3]); x.z = cvtpk(S1[8 * s2 + 4], S1[8 * s2 + 5]); x.w = cvtpk(S1[8 * s2 + 6], S1[8 * s2 + 7]); pf[1][s2] = mk_frag(x); } } while (0)
#define AF_RESC(ALPHA) do { if (__any((ALPHA) != 1.f)) { _Pragma("unroll") for (int dt = 0; dt < 4; ++dt) o[dt] = o[dt] * (ALPHA); } } while (0)
#define AF_LDV(DST, VP, dt) do { _Pragma("unroll") for (int kh = 0; kh < 2; ++kh) _Pragma("unroll") for (int s2 = 0; s2 < 2; ++s2) { \
            DST[2 * kh + s2] = *(const LAS bf16x8*)((VP) + (32 * (dt)) * 72 + 32 * kh + 16 * s2); } } while (0)
#define AF_MMV(SRC, dt) do { o[dt] = MFMA32(SRC[0], pf[0][0], o[dt]); o[dt] = MFMA32(SRC[1], pf[0][1], o[dt]); o[dt] = MFMA32(SRC[2], pf[1][0], o[dt]); o[dt] = MFMA32(SRC[3], pf[1][1], o[dt]); } while (0)
#define AF_VP(BUF) ((const LAS bf16_t*)(lds + (BUF) * BUFB + 17408) + r32 * 72 + 8 * hi)
#define AF_PV(BUF) do { const LAS bf16_t* vp0 = AF_VP(BUF); bf16x8 va[4], vb[4]; \
        AF_LDV(va, vp0, 0); AF_LDV(vb, vp0, 1); __builtin_amdgcn_sched_barrier(0); \
        AF_MMV(va, 0); __builtin_amdgcn_sched_barrier(0); AF_LDV(va, vp0, 2); __builtin_amdgcn_sched_barrier(0); \
        AF_MMV(vb, 1); __builtin_amdgcn_sched_barrier(0); AF_LDV(vb, vp0, 3); __builtin_amdgcn_sched_barrier(0); \
        AF_MMV(va, 2); __builtin_amdgcn_sched_barrier(0); AF_MMV(vb, 3); __builtin_amdgcn_sched_barrier(0); } while (0)
#define AF_PV_SMH(BUF, S0, S1, CB, ALPHA) do { const LAS bf16_t* vp0 = AF_VP(BUF); bf16x8 va[4], vb[4]; float mx; \
        AF_LDV(va, vp0, 0); AF_LDV(vb, vp0, 1); __builtin_amdgcn_sched_barrier(0); \
        AF_MMV(va, 0); mx = fmaxf(S0[0], S0[1]); _Pragma("unroll") for (int r = 2; r < 16; ++r) mx = fmaxf(mx, S0[r]); __builtin_amdgcn_sched_barrier(0); \
        AF_LDV(va, vp0, 2); __builtin_amdgcn_sched_barrier(0); \
        AF_MMV(vb, 1); _Pragma("unroll") for (int r = 0; r < 16; ++r) mx = fmaxf(mx, S1[r]); \
        mx = half_swap_max(mx) + (CB); \
        const bool keep = __all(mx - mrun <= 11.5f); \
        const float mn = keep ? mrun : fmaxf(mrun, mx); ALPHA = __builtin_amdgcn_exp2f(mrun - mn); mrun = mn; \
        const float cc = (CB) - mn; __builtin_amdgcn_sched_barrier(0); \
        AF_LDV(vb, vp0, 3); __builtin_amdgcn_sched_barrier(0); \
        AF_MMV(va, 2); _Pragma("unroll") for (int r = 0; r < 16; ++r) S0[r] = __builtin_amdgcn_exp2f(S0[r] + cc); __builtin_amdgcn_sched_barrier(0); \
        AF_MMV(vb, 3); _Pragma("unroll") for (int r = 0; r < 16; ++r) S1[r] = __builtin_amdgcn_exp2f(S1[r] + cc); __builtin_amdgcn_sched_barrier(0); } while (0)
    bf16x8 pf[2][2];
    const float cbias = 0.f;
    (void)cbias;
    unsigned long long srem = sset; int js = -1;
    if (srem) { js = __builtin_ctzll(srem); srem &= srem - 1ull; }
    if (pset) {
        unsigned long long rem = pset;
        f32x16 s0, s1; float al = 1.f;
        int jt0 = __builtin_ctzll(rem); rem &= rem - 1ull;
        AF_LOAD(jt0); AF_WRITE(0);
        int jn1 = -1; if (rem) { jn1 = __builtin_ctzll(rem); rem &= rem - 1ull; AF_LOAD(jn1); }
        __syncthreads();
        const float cb_all = tab[hd * 132 + 128];
#define AF_CB(J) ((MODE == 2) ? ((((smask >> (J)) & 1ull) != 0ull) ? cb_all : -INFINITY) : cb_all)
        int bufS = 0;
        if (jn1 >= 0) AF_WRITE(1);
        int jn2 = -1; if (rem) { jn2 = __builtin_ctzll(rem); rem &= rem - 1ull; AF_LOAD(jn2); }
        AF_S(s0, s1, 0);
        { const float cb = AF_CB(jt0); AF_SMH(s0, s1, cb, al); }
        AF_RESC(al);
        int jcur = jn1, jnext = jn2;
        while (jcur >= 0) {
            const int bufN = bufS == 2 ? 0 : bufS + 1;
            const int bufW = bufN == 2 ? 0 : bufN + 1;
            __syncthreads();
            if (jnext >= 0) AF_WRITE(bufW);
            int jn3 = -1; if (rem) { jn3 = __builtin_ctzll(rem); rem &= rem - 1ull; AF_LOAD(jn3); }
            AF_SMT(s0, s1, al);
            __builtin_amdgcn_sched_barrier(0);
            AF_S(s0, s1, bufN);
            { const float cb = AF_CB(jcur); AF_PV_SMH(bufS, s0, s1, cb, al); }
            AF_RESC(al);
            bufS = bufN; jcur = jnext; jnext = jn3;
        }
        if (js >= 0) AF_LOAD(js);
        AF_SMT(s0, s1, al);
        AF_PV(bufS);
    } else if (js >= 0) AF_LOAD(js);
    if (js >= 0) {
        __syncthreads();
        int sb = 0;
        while (js >= 0) {
            const int j = js;
            AF_WRITE(sb);
            __syncthreads();
            js = -1; if (srem) { js = __builtin_ctzll(srem); srem &= srem - 1ull; AF_LOAD(js); }
            f32x16 s0, s1; float al;
            AF_S(s0, s1, sb);
            const bool selok = (MODE == 2) ? (((smask >> j) & 1ull) != 0ull) : true;
#pragma unroll
            for (int kh = 0; kh < 2; ++kh)
#pragma unroll
                for (int rq = 0; rq < 4; ++rq) {
                    float tb[4];
#pragma unroll
                    for (int e = 0; e < 4; ++e) { const int kl = 32 * kh + 8 * rq + 4 * hi + e; const int dist = 64 * (qb - j) + tl - kl;
                        const int di = dist < 0 ? 0 : (dist > 128 ? 128 : dist); tb[e] = tab[hd * 132 + di]; }
                    asm volatile("" : "+v"(tb[0]), "+v"(tb[1]), "+v"(tb[2]), "+v"(tb[3]));
#pragma unroll
                    for (int e = 0; e < 4; ++e) { const int kl = 32 * kh + 8 * rq + 4 * hi + e; const int dist = 64 * (qb - j) + tl - kl;
                        bool ok = dist >= 0 && selok; if (MODE == 0) ok = ok && dist < 512;
                        if (kh == 0) s0[4 * rq + e] = ok ? s0[4 * rq + e] + tb[e] : -INFINITY; else s1[4 * rq + e] = ok ? s1[4 * rq + e] + tb[e] : -INFINITY; }
                }
            AF_SMH(s0, s1, 0.f, al);
            AF_SMT(s0, s1, al);
            AF_RESC(al);
            AF_PV(sb);
            sb ^= 1;
        }
    }
#undef AF_LOAD
#undef AF_WRITE
#undef AF_S
#undef AF_SMH
#undef AF_SMT
#undef AF_RESC
#undef AF_PV
#undef AF_PV_SMH
#undef AF_LDK
#undef AF_MMK
#undef AF_LDV
#undef AF_MMV
#undef AF_VP
#undef AF_CB
    const float inv = lrun > 0.f ? 1.f / lrun : 0.f;
    int lane2 = lane; asm volatile("" : "+v"(lane2));
    const int hi2 = lane2 >> 5, tl2 = 32 * qhalf + (lane2 & 31);
    const size_t tok = (size_t)b * SEQ + 64 * qb + tl2;
    if (MODE == 0) {
#pragma unroll
        for (int dt = 0; dt < 4; ++dt)
#pragma unroll
            for (int rq = 0; rq < 4; ++rq) { u32x2 w; w.x = cvtpk(o[dt][4 * rq] * inv, o[dt][4 * rq + 1] * inv); w.y = cvtpk(o[dt][4 * rq + 2] * inv, o[dt][4 * rq + 3] * inv);
                *(u32x2*)(P.ow() + tok * 2048 + head * 128 + 32 * dt + 8 * rq + 4 * hi2) = w; }
    } else {
        const float* gp = P.small() + tok * 64 + 16 + head * 3;
        const float g0 = sigmoidf_(gp[0]), g1 = sigmoidf_(gp[1]), g2 = sigmoidf_(gp[2]);
#pragma unroll
        for (int dt = 0; dt < 4; ++dt)
#pragma unroll
            for (int rq = 0; rq < 4; ++rq) { const int col = head * 128 + 32 * dt + 8 * rq + 4 * hi2;
                const u32x2 cw = *(const u32x2*)(P.oc() + tok * 2048 + col), ww = *(const u32x2*)(P.ow() + tok * 2048 + col), zw = *(const u32x2*)(P.U() + tok * UW + UNZ + col);
                const float o0 = o[dt][4 * rq] * inv, o1 = o[dt][4 * rq + 1] * inv, o2 = o[dt][4 * rq + 2] * inv, o3 = o[dt][4 * rq + 3] * inv;
                const float y0 = (g0 * bflo(cw.x) + g1 * o0 + g2 * bflo(ww.x)) * siluf_(bflo(zw.x)), y1 = (g0 * bfhi(cw.x) + g1 * o1 + g2 * bfhi(ww.x)) * siluf_(bfhi(zw.x));
                const float y2 = (g0 * bflo(cw.y) + g1 * o2 + g2 * bflo(ww.y)) * siluf_(bflo(zw.y)), y3 = (g0 * bfhi(cw.y) + g1 * o3 + g2 * bfhi(ww.y)) * siluf_(bfhi(zw.y));
                *(unsigned*)(P.y8() + tok * 2048 + col) = pk_fp8x4(__builtin_amdgcn_fmed3f(16.f * y0, -440.f, 440.f), __builtin_amdgcn_fmed3f(16.f * y1, -440.f, 440.f), __builtin_amdgcn_fmed3f(16.f * y2, -440.f, 440.f), __builtin_amdgcn_fmed3f(16.f * y3, -440.f, 440.f)); }
    }
    __syncthreads();
}

#ifndef R_CMP
#define R_CMP 1
#endif
#ifndef R_WIN
#define R_WIN 1
#endif
#ifndef R_ML1
#define R_ML1 1
#endif
#ifndef R_CA
#define R_CA 1
#endif
#ifndef R_ML2
#define R_ML2 1
#endif
#ifndef R_SEL
#define R_SEL 1
#endif
#ifndef R_ML3
#define R_ML3 1
#endif
#ifndef REP_P0
#define REP_P0 1
#endif
#ifndef REP_P1
#define REP_P1 1
#endif
#ifndef REP_P2
#define REP_P2 1
#endif
#ifndef REP_P3
#define REP_P3 1
#endif
#ifndef REP_P4
#define REP_P4 1
#endif
#ifndef REP_P5
#define REP_P5 1
#endif
constexpr int LDS_BYTES = 131072 + 1024;
constexpr int LDS_SLOT = 131072;
extern __shared__ __attribute__((aligned(16))) unsigned char dyn_lds[];

__device__ __forceinline__ int next_task(unsigned* ctr, LAS unsigned char* lds_) {
    LAS int* slot = (LAS int*)(opq(lds_) + LDS_SLOT);
    __syncthreads();
    if (opaque_tid() == 0) *slot = (int)atomicAdd(ctr, 1u);
    __syncthreads();
    return *slot;
}

#define XB_TMO      128
#define XB_XCNT(j)  (256  + 64 * (j))
#define XB_XSUB(j)  (1280 + 64 * (j))
#define XB_XGEN(j)  (2304 + 64 * (j))
#define XB_TOP      3328
#define XB_TOPGEN   3392
#define XCD_BAR_WORDS 3456
#define XB_SPIN_CAP (1u << 18)
__device__ __forceinline__ unsigned xb_ld(unsigned* p)              { return __hip_atomic_load(p, __ATOMIC_RELAXED, __HIP_MEMORY_SCOPE_AGENT); }
__device__ __forceinline__ unsigned xb_add(unsigned* p, unsigned v) { return __hip_atomic_fetch_add(p, v, __ATOMIC_RELAXED, __HIP_MEMORY_SCOPE_AGENT); }
__device__ __forceinline__ unsigned xb_xcc_id() { return (unsigned)__builtin_amdgcn_s_getreg((3 << 11) | 20) & 0xFu; }
#define XB_SPIN(cond, bar) do { unsigned _sp = 0; while (cond) { __builtin_amdgcn_s_sleep(1); \
    if ((++_sp & 255u) == 0u) { if (xb_ld(&(bar)[XB_TMO])) break; if (_sp > XB_SPIN_CAP) { atomicAdd(&(bar)[XB_TMO], 1u); break; } } } } while (0)
__device__ __forceinline__ void xcd_barrier_post(unsigned* bar) { if (threadIdx.x == 0) (void)xb_add(&bar[XB_XCNT(xb_xcc_id())], 1u); }
__device__ __forceinline__ void xcd_barrier_complete(unsigned* bar, unsigned x, unsigned& nloc, unsigned& nx) {
    const unsigned G = gridDim.x * gridDim.y * gridDim.z;
    unsigned sum, cnt, mine, sp = 0u;
    for (;;) {
        sum = 0u; cnt = 0u; mine = 0u;
#pragma unroll
        for (unsigned j = 0; j < 16; ++j) { const unsigned c = xb_ld(&bar[XB_XCNT(j)]); sum += c; cnt += (c > 0u) ? 1u : 0u; mine = (j == x) ? c : mine; }
        if (sum == G) break;
        __builtin_amdgcn_s_sleep(1);
        if ((++sp & 255u) == 0u) { if (xb_ld(&bar[XB_TMO])) break; if (sp > XB_SPIN_CAP) { atomicAdd(&bar[XB_TMO], 1u); break; } }
    }
    nloc = mine > 0u ? mine : 1u; nx = cnt > 0u ? cnt : 1u;
}
__device__ __forceinline__ void xcd_barrier(unsigned* bar, volatile LAS unsigned* st) {
    asm volatile("s_waitcnt vmcnt(0)" ::: "memory");
    __syncthreads();
    if (threadIdx.x == 0) {
        const unsigned x = xb_xcc_id();
        __builtin_amdgcn_s_waitcnt(0);
        unsigned nloc = st[0], nx = st[1];
        if (nloc == 0u) { xcd_barrier_complete(bar, x, nloc, nx); st[0] = nloc; st[1] = nx; }
        const unsigned old = xb_add(&bar[XB_XSUB(x)], 1u);
        const unsigned gen = old / nloc;
        if (old + 1u == (gen + 1u) * nloc) {
            __builtin_amdgcn_fence(__ATOMIC_RELEASE, "agent");
            asm volatile("s_waitcnt vmcnt(0)" ::: "memory");
            const unsigned og = xb_add(&bar[XB_TOP], 1u);
            const unsigned tg = og / nx;
            if (og + 1u == (tg + 1u) * nx) xb_add(&bar[XB_TOPGEN], 1u);
            else XB_SPIN(xb_ld(&bar[XB_TOPGEN]) == tg, bar);
            __builtin_amdgcn_fence(__ATOMIC_ACQUIRE, "agent");
            xb_add(&bar[XB_XGEN(x)], 1u);
            asm volatile("s_waitcnt vmcnt(0)" ::: "memory");
        } else {
            XB_SPIN(xb_ld(&bar[XB_XGEN(x)]) == gen, bar);
            __builtin_amdgcn_fence(__ATOMIC_ACQUIRE, "agent");
            asm volatile("s_waitcnt vmcnt(0)" ::: "memory");
        }
    }
    __syncthreads();
}

struct KArgs { const float* in[20]; float* out; unsigned char* ws; };
__global__ void __launch_bounds__(512, 2) hymba_mega(KArgs ka) {
    Params P; fill_params(P, (void* const*)ka.in, (void*)ka.out, (void*)ka.ws);
    cg::grid_group grid = cg::this_grid();
    LAS unsigned char* lds = (LAS unsigned char*)dyn_lds;
    const int bid = blockIdx.x, G = gridDim.x;
    if (threadIdx.x == 0) { *(volatile LAS unsigned*)(lds + LDS_SLOT + 64) = 0u; *(volatile LAS unsigned*)(lds + LDS_SLOT + 68) = 0u; }
    __syncthreads();
    xcd_barrier_post(P.ctl() + 4096);
    if (ka.out == nullptr) grid.sync();
#define GSYNC() xcd_barrier(P.ctl() + 4096, (volatile LAS unsigned*)(opq(lds) + LDS_SLOT + 64))
#define PH_P0 { phase0(P, lds, bid, G); GSYNC(); }
#define PH_P1 { phase_gemm1(P, lds, bid, G); phase_gemm_pe(P, lds, bid, G); GSYNC(); }
#define PH_P2(CB) { \
        for (int t = next_task(P.ctl() + (CB) + 0, lds); t < 32 * R_CMP + 512 * R_WIN + 512 * R_ML1 + 64; t = next_task(P.ctl() + (CB) + 0, lds)) { \
            if (t < 32 * R_CMP) cmp_gemm_task(P, lds, t % 32); \
            else if (t < 32 * R_CMP + 512 * R_WIN) { const int u = (t - 32 * R_CMP) % 512; attn_fast<0>(P, lds, u & 7, 63 - (u >> 3)); } \
            else if (t < 32 * R_CMP + 512 * R_WIN + 512 * R_ML1) ml_step1(P, lds, (t - 32 * R_CMP - 512 * R_WIN) % 512); \
            else ksnorm_task(P, t - (32 * R_CMP + 512 * R_WIN + 512 * R_ML1)); \
        } \
        GSYNC(); }
#define PH_P3(CB) { \
        for (int t = next_task(P.ctl() + (CB) + 64, lds); t < 256 * R_ML2 + 128 * R_CMP; t = next_task(P.ctl() + (CB) + 64, lds)) { \
            if (t < 256 * R_ML2) { const int u = t % 256; ml_step2(P, u >> 4, u & 15); } \
            else cmp_task(P, lds, (t - 256 * R_ML2) % 128); \
        } \
        GSYNC(); }
#define PH_P4(CB) { \
        for (int t = next_task(P.ctl() + (CB) + 128, lds); t < 512 * R_SEL + 512 * R_ML3; t = next_task(P.ctl() + (CB) + 128, lds)) { \
            if (t < 512 * R_SEL) { const int u = t % 512; attn_task<1>(P, lds, u & 7, 63 - (u >> 3)); __threadfence_block(); __syncthreads(); attn_fast<2>(P, lds, u & 7, 63 - (u >> 3)); } \
            else ml_step3(P, lds, (t - 512 * R_SEL) % 512); \
        } \
        GSYNC(); }
#define PH_P5 { phase_gemm2(P, lds, bid, G); GSYNC(); }
    PH_P0
#if REP_P0 > 1
    PH_P0
#endif
    PH_P1
#if REP_P1 > 1
    PH_P1
#endif
    PH_P2(0)
#if REP_P2 > 1
    PH_P2(256)
#endif
    PH_P3(0)
#if REP_P3 > 1
    PH_P3(256)
#endif
    PH_P4(0)
#if REP_P4 > 1
    PH_P4(256)
#endif
    PH_P5
#if REP_P5 > 1
    PH_P5
#endif
    phase_gemm3(P, lds, bid, G);
}

extern "C" void kernel_launch(void* const* d_in, const int* in_sizes, int n_in, void* d_out, int out_size, void* d_ws, size_t ws_size, hipStream_t stream) {
    static int grid_blocks = 0;
    if (!grid_blocks) {
        if (ws_size < WS_END) { fprintf(stderr, "kernel_launch: workspace too small: %zu < %zu\n", ws_size, (size_t)WS_END); grid_blocks = -1; return; }
        int dev = 0, cus = 0, per_cu = 0;
        (void)hipGetDevice(&dev);
        (void)hipDeviceGetAttribute(&cus, hipDeviceAttributeMultiprocessorCount, dev);
        (void)hipFuncSetAttribute((const void*)hymba_mega, hipFuncAttributeMaxDynamicSharedMemorySize, LDS_BYTES);
        (void)hipOccupancyMaxActiveBlocksPerMultiprocessor(&per_cu, (const void*)hymba_mega, 512, LDS_BYTES);
        if (per_cu < 1) { fprintf(stderr, "kernel_launch: occupancy query says %d blocks per CU\n", per_cu); per_cu = 1; }
        grid_blocks = cus * (per_cu > 1 ? 1 : per_cu);
    }
    if (grid_blocks < 0) return;
    (void)hipMemsetAsync((char*)d_ws + WS_CTL, 0, 32768, stream);
    KArgs ka{}; for (int i = 0; i < 20; ++i) ka.in[i] = (const float*)d_in[i]; ka.out = (float*)d_out; ka.ws = (unsigned char*)d_ws;
    void* args[] = {&ka};
    hipError_t e = hipLaunchCooperativeKernel((const void*)hymba_mega, dim3(grid_blocks), dim3(512), args, LDS_BYTES, stream);
    if (e != hipSuccess) fprintf(stderr, "cooperative launch failed: %s (grid %d)\n", hipGetErrorString(e), grid_blocks);
}
```

```cpp
#include <hip/hip_runtime.h>
#include <hip/hip_cooperative_groups.h>
#include <cstdio>
#include <cstdint>
namespace cg = cooperative_groups;

#define LAS __attribute__((address_space(3)))
typedef unsigned short bf16_t;
typedef short bf16x8 __attribute__((ext_vector_type(8)));
typedef short bf16x4 __attribute__((ext_vector_type(4)));
typedef float f32x4 __attribute__((ext_vector_type(4)));
typedef float f32x2 __attribute__((ext_vector_type(2)));
typedef unsigned u32x4 __attribute__((ext_vector_type(4)));
typedef unsigned u32x2 __attribute__((ext_vector_type(2)));

constexpr int DM = 4096, NB = 2, SEQ = 4096, MTOK = NB * SEQ;
constexpr int INW = 15424;
constexpr int UW = 12288;
constexpr int UQ = 0, UK = 1024, UO = 2048, UZ = 4096, UNQ = 6144, UKC = 8192, UVC = 8704, UKS = 9216, UKW = 9728, UNZ = 10240;
constexpr int WT_SMALL = 12288;
constexpr int WT_T = 12544;
constexpr int WT_ROWS = 15616;
constexpr int TV = 0, TVS = 2048, TVW = 2560, TROWS = 3072;
constexpr float EPS = 1e-6f;

__device__ __forceinline__ unsigned f2bf(float f) { unsigned u = __float_as_uint(f); return (u + 0x7fffu + ((u >> 16) & 1u)) >> 16; }
typedef __bf16 bf16x2v __attribute__((ext_vector_type(2)));
__device__ __forceinline__ unsigned pk2(float lo, float hi) { const f32x2 v = {lo, hi}; return __builtin_bit_cast(unsigned, __builtin_convertvector(v, bf16x2v)); }
__device__ __forceinline__ float bflo(unsigned w) { return __uint_as_float(w << 16); }
__device__ __forceinline__ float bfhi(unsigned w) { return __uint_as_float(w & 0xffff0000u); }
__device__ __forceinline__ float bf2f(bf16_t b) { return __uint_as_float(((unsigned)b) << 16); }
__device__ __forceinline__ float wave_sum(float v) {
#pragma unroll
    for (int o = 1; o < 64; o <<= 1) v += __shfl_xor(v, o);
    return v;
}
__device__ __forceinline__ int opaque_tid() { int t = threadIdx.x; asm volatile("" : "+v"(t)); return t; }
__device__ __forceinline__ LAS unsigned char* opq(LAS unsigned char* p) { unsigned v = (unsigned)(uintptr_t)p; asm volatile("" : "+s"(v)); return (LAS unsigned char*)(uintptr_t)v; }
#define DPP_F(v, ctrl) __builtin_bit_cast(float, __builtin_amdgcn_update_dpp(0, __builtin_bit_cast(int, (v)), (ctrl), 0xF, 0xF, true))
__device__ __forceinline__ float row16_sum(float v) { v += DPP_F(v, 0xB1); v += DPP_F(v, 0x4E); v += DPP_F(v, 0x141); v += DPP_F(v, 0x140); return v; }
__device__ __forceinline__ void swap16(float& a, float& b) { asm volatile("v_nop\n\tv_nop\n\tv_permlane16_swap_b32 %0, %1" : "+v"(a), "+v"(b)); }
__device__ __forceinline__ void swap32(float& a, float& b) { asm volatile("v_nop\n\tv_nop\n\tv_permlane32_swap_b32 %0, %1" : "+v"(a), "+v"(b)); }
__device__ __forceinline__ float xq_sum(float v) { float a = v, b = v; swap16(a, b); v = a + b; a = v; b = v; swap32(a, b); return a + b; }
__device__ __forceinline__ float xq_max(float v) { float a = v, b = v; swap16(a, b); v = fmaxf(a, b); a = v; b = v; swap32(a, b); return fmaxf(a, b); }
__device__ __forceinline__ float shfl_up_l(float v, int o, int lane_) { const int src = lane_ - o < 0 ? lane_ : lane_ - o; return __builtin_bit_cast(float, __builtin_amdgcn_ds_bpermute(src << 2, __builtin_bit_cast(int, v))); }
__device__ __forceinline__ float row16_max(float v) { v = fmaxf(v, DPP_F(v, 0xB1)); v = fmaxf(v, DPP_F(v, 0x4E)); v = fmaxf(v, DPP_F(v, 0x141)); v = fmaxf(v, DPP_F(v, 0x140)); return v; }
__device__ __forceinline__ float wave_max(float v) { return xq_max(row16_max(v)); }
__device__ __forceinline__ float sigmoidf_(float x) { return __builtin_amdgcn_rcpf(1.f + __expf(-x)); }
__device__ __forceinline__ float siluf_(float x) { return x * __builtin_amdgcn_rcpf(1.f + __expf(-x)); }

__device__ __forceinline__ unsigned pk_fp8x4(float a, float b, float c, float d) {
    int p = 0; p = __builtin_amdgcn_cvt_pk_fp8_f32(a, b, p, false); p = __builtin_amdgcn_cvt_pk_fp8_f32(c, d, p, true); return (unsigned)p;
}
__device__ __forceinline__ int w8_row(int dr) { return (dr >= 6144 && dr < 12288) ? dr - 6144 : (dr >= 14592 ? 6144 + (dr - 14592) : -1); }
__device__ __forceinline__ int wt_row(int c) {
    int r;
    if (c < 2048) r = c;
    else if (c < 4096) r = WT_T + TV + (c - 2048);
    else if (c < 6144) r = UO + (c - 4096);
    else if (c < 8192) r = UZ + (c - 6144);
    else if (c < 8208) r = WT_SMALL + (c - 8192);
    else if (c < 10256) r = UNQ + (c - 8208);
    else if (c < 11280) r = UKC + (c - 10256);
    else if (c < 11792) r = UKS + (c - 11280);
    else if (c < 12304) r = WT_T + TVS + (c - 11792);
    else if (c < 12816) r = UKW + (c - 12304);
    else if (c < 13328) r = WT_T + TVW + (c - 12816);
    else if (c < 13376) r = WT_SMALL + 16 + (c - 13328);
    else r = UNZ + (c - 13376);
    return r;
}

namespace pg8 {
constexpr int BM = 256, BK = 64, HALF = 128, HTB = HALF * BK * 2, STAGE_BYTES = 8 * HTB, NXCD = 8, WGM = 8;
__host__ __device__ __forceinline__ int lds_byte(int r, int c) { const int st = (r >> 4) * 2 + (c >> 5), rr = r & 15, cc = c & 31, ob = rr * 64 + cc * 2; return st * 1024 + (ob ^ (((ob >> 9) & 1) << 5)); }
__host__ __device__ __forceinline__ void stage_rc(int b, int& R, int& C) { const int st = b / 1024, sb = b % 1024, swz = sb ^ (((sb >> 9) & 1) << 5); R = (st >> 1) * 16 + swz / 64; C = (st & 1) * 32 + (swz % 64) / 2; }
__host__ __device__ __forceinline__ int perm32(int rho) { const int n = rho >> 4, i = rho & 15; return 8 * (i >> 2) + 4 * n + (i & 3); }

struct Unit { const char* a; const char* b; int pm, pn, kind; };

__device__ __forceinline__ void tile_order(int L, int nM, int nN, int& pm, int& pn) {
    const int nwg = nM * nN; int wgid = L;
    { const int q = nwg / NXCD, r = nwg % NXCD, xcd = wgid % NXCD, off = wgid / NXCD; wgid = (xcd < r ? xcd * (q + 1) : r * (q + 1) + (xcd - r) * q) + off; }
    const int nig = WGM * nN, gid = wgid / nig, fm = gid * WGM, gsz = (nM - fm) < WGM ? (nM - fm) : WGM;
    pm = fm + ((wgid % nig) % gsz); pn = (wgid % nig) / gsz;
}
struct Sched2 {
    const char* a0; const char* b0; int nM0, nN0, kind0;
    const char* a1; const char* b1; int nM1, nN1, kind1;
    int K, G, c;
    __device__ __forceinline__ bool next(int i, Unit& u) const {
        const long L = (long)i * G + c; const int n0 = nM0 * nN0, n1 = nM1 * nN1; const size_t tstep = (size_t)BM * K * 2;
        if (L < n0) { int pm, pn; tile_order((int)L, nM0, nN0, pm, pn); u.pm = pm; u.pn = pn; u.kind = kind0; u.a = a0 + (size_t)pm * tstep; u.b = b0 + (size_t)pn * tstep; return true; }
        if (L < n0 + n1) { int pm, pn; tile_order((int)(L - n0), nM1, nN1, pm, pn); u.pm = pm; u.pn = pn; u.kind = kind1; u.a = a1 + (size_t)pm * tstep; u.b = b1 + (size_t)pn * tstep; return true; }
        return false;
    }
};

struct SchedG1B {
    const char* hb; const char* wt; int G, c;
    __device__ __forceinline__ bool next(int i, Unit& u) const {
        const int L = i * G + c; const size_t tstep = (size_t)BM * 4096 * 2; int pm, pn;
        if (L < 768) { tile_order(L, 32, 24, pm, pn); u.kind = 0; u.pm = pm; u.pn = pn; u.a = hb + (size_t)pm * tstep; u.b = wt + (size_t)pn * tstep; return true; }
        if (L < 800) { pm = L - 768; u.kind = 0; u.pm = pm; u.pn = 48; u.a = hb + (size_t)pm * tstep; u.b = wt + (size_t)48 * tstep; return true; }
        if (L < 1056) { tile_order(L - 800, 8, 32, pm, pn); u.kind = 1; u.pm = pm; u.pn = pn; u.a = wt + (size_t)(49 + pm) * tstep; u.b = hb + (size_t)pn * tstep; return true; }
        return false;
    }
};
struct SchedG1F {
    const char* hb8; const char* w8; int G, c;
    __device__ __forceinline__ bool next(int i, Unit& u) const {
        int M;
        if (G == 256) { int h = i; if (c < 32) h += 2;
            if (h == 0) M = c - 32; else if (h == 1) M = 224 + (c - 32); else if (h == 2) M = 448 + c; else if (h == 3 && c < 192) M = 704 + c; else return false; }
        else { M = i * G + c; if (M >= 896) return false; }
        const size_t tstep = (size_t)BM * 4096; int pm, pn;
        if (M < 768) { tile_order(M, 32, 24, pm, pn); u.kind = 0; u.pm = pm; u.pn = 24 + pn; u.a = hb8 + (size_t)pm * tstep; u.b = w8 + (size_t)pn * tstep; }
        else { tile_order(M - 768, 4, 32, pm, pn); u.kind = 1; u.pm = 8 + pm; u.pn = pn; u.a = w8 + (size_t)(24 + pm) * tstep; u.b = hb8 + (size_t)pn * tstep; }
        return true;
    }
};

__device__ __forceinline__ unsigned cvt_pk_bf16(float lo, float hi) { return pk2(lo, hi); }

__device__ __forceinline__ const char* uniform_ptr(const char* p) {
    const unsigned long long v = (unsigned long long)p;
    const unsigned lo = __builtin_amdgcn_readfirstlane((unsigned)v), hi = __builtin_amdgcn_readfirstlane((unsigned)(v >> 32));
    return (const char*)(((unsigned long long)hi << 32) | lo);
}
typedef int i32x8 __attribute__((ext_vector_type(8)));
typedef int i32x4v __attribute__((ext_vector_type(4)));
__device__ __forceinline__ i32x8 cat8(bf16x8 a, bf16x8 b) { const i32x4v x = __builtin_bit_cast(i32x4v, a), y = __builtin_bit_cast(i32x4v, b); return (i32x8){x[0], x[1], x[2], x[3], y[0], y[1], y[2], y[3]}; }
template <class Epi, class Sched, bool FP8 = false>
__device__ __forceinline__ void gemm_phase(LAS unsigned char* lds, const int K, const Sched& S, const Epi& E) {
    const int tid = opaque_tid(), wid = __builtin_amdgcn_readfirstlane(tid >> 6), lane = tid & 63, wr = wid >> 2, wc = wid & 3, fr = lane & 15, fq = lane >> 4;
    const int nt = K / BK;
    unsigned voffA[2], voffB[2];
#pragma unroll
    for (int i = 0; i < 2; ++i) { int R, C; stage_rc(tid * 16 + i * 8192, R, C); const int Rb = (R & ~31) + perm32(R & 31);
        voffA[i] = (unsigned)(R * K + C) * 2u; voffB[i] = (unsigned)(Rb * K + C) * 2u; }
    const size_t kstep = (size_t)(BK * 2);
    const size_t hstep = (size_t)HALF * K * 2;
    const unsigned ldsw = (unsigned)wid * 1024u;
    const int aoff = lds_byte(wr * 64 + fr, fq * 8), boff = lds_byte(wc * 32 + fr, fq * 8);
#define PG8_SA(b, h) (((b) * 2 + (h)) * HTB)
#define PG8_SB(b, h) ((4 + (b) * 2 + (h)) * HTB)
#define PG8_VOFF(i_, isB_) ([&]() -> unsigned { int R_, C_; stage_rc((opaque_tid()) * 16 + (i_) * 8192, R_, C_); if (isB_) R_ = (R_ & ~31) + perm32(R_ & 31); return (unsigned)(R_ * K + C_) * 2u; }())
#define PG8_STAGE(bufoff, gbase, voff) do { _Pragma("unroll") for (int _i = 0; _i < 2; ++_i) { \
        unsigned vo_ = (voff)[_i]; if constexpr (FP8) { vo_ = (voff)[0]; asm volatile("" : "+v"(vo_)); vo_ += (unsigned)_i * (unsigned)(64 * K * 2); }     \
        __builtin_amdgcn_global_load_lds((const unsigned*)((const char*)(gbase) + vo_), (LAS unsigned*)(lds + (bufoff) + ldsw + _i * 8192), 16, 0, 0); } } while (0)
#define PG8_LDA(dst, b, h) do { if constexpr (FP8) { _Pragma("unroll") for (int m = 0; m < 4; ++m) { const i32x4v lo_ = *(const LAS i32x4v*)(lds + PG8_SA(b, h) + aoff + m * 2048), hi_ = *(const LAS i32x4v*)(lds + PG8_SA(b, h) + aoff + m * 2048 + 1024); \
            dst##8[m] = __builtin_shufflevector(lo_, hi_, 0, 1, 2, 3, 4, 5, 6, 7); } } \
        else { _Pragma("unroll") for (int m = 0; m < 4; ++m) _Pragma("unroll") for (int k = 0; k < 2; ++k) dst[m][k] = *(const LAS bf16x8*)(lds + PG8_SA(b, h) + aoff + m * 2048 + k * 1024); } } while (0)
#define PG8_LDB(dst, b, h) do { if constexpr (FP8) { _Pragma("unroll") for (int n = 0; n < 2; ++n) { const i32x4v lo_ = *(const LAS i32x4v*)(lds + PG8_SB(b, h) + boff + n * 2048), hi_ = *(const LAS i32x4v*)(lds + PG8_SB(b, h) + boff + n * 2048 + 1024); \
            dst##8[n] = __builtin_shufflevector(lo_, hi_, 0, 1, 2, 3, 4, 5, 6, 7); } } \
        else { _Pragma("unroll") for (int n = 0; n < 2; ++n) _Pragma("unroll") for (int k = 0; k < 2; ++k) dst[n][k] = *(const LAS bf16x8*)(lds + PG8_SB(b, h) + boff + n * 2048 + k * 1024); } } while (0)
#define PG8_MMA(ai, bj, At, Bt) do { __builtin_amdgcn_s_setprio(1); _Pragma("unroll") for (int m = 0; m < 4; ++m) _Pragma("unroll") for (int n = 0; n < 2; ++n) { \
        if constexpr (FP8) acc[ai][bj][m][n] = __builtin_amdgcn_mfma_scale_f32_16x16x128_f8f6f4(Bt##8[n], At##8[m], acc[ai][bj][m][n], 0, 0, 0, 121, 0, 127); \
        else { _Pragma("unroll") for (int k = 0; k < 2; ++k) acc[ai][bj][m][n] = __builtin_amdgcn_mfma_f32_16x16x32_bf16(Bt[n][k], At[m][k], acc[ai][bj][m][n], 0, 0, 0); } } \
        __builtin_amdgcn_s_setprio(0); } while (0)
#define PG8_WAIT_V(n) asm volatile("s_waitcnt vmcnt(" #n ")" ::: "memory")
#define PG8_WAIT_L(n) asm volatile("s_waitcnt lgkmcnt(" #n ")" ::: "memory")
#define PG8_BAR __builtin_amdgcn_s_barrier()
#define PG8_SCHED __builtin_amdgcn_sched_barrier(0)
    Unit cur, nxt; int ui = 0;
    if (!S.next(0, cur)) return;
    f32x4 acc[2][2][4][2];
#pragma unroll
    for (int a = 0; a < 2; ++a)
#pragma unroll
        for (int b = 0; b < 2; ++b)
#pragma unroll
            for (int m = 0; m < 4; ++m)
#pragma unroll
                for (int n = 0; n < 2; ++n) acc[a][b][m][n] = (f32x4){0.f, 0.f, 0.f, 0.f};
    bf16x8 At[4][2], B0[2][2], B1[2][2];
    i32x8 At8[4], B08[2], B18[2];
    const char* cA = cur.a; const char* cB = cur.b;
    PG8_STAGE(PG8_SB(0, 0), cB, voffB); PG8_STAGE(PG8_SB(0, 1), cB + hstep, voffB); PG8_STAGE(PG8_SA(0, 0), cA, voffA); PG8_STAGE(PG8_SA(0, 1), cA + hstep, voffA);
    if (wr == 1) PG8_BAR;
    PG8_WAIT_V(2); PG8_BAR;
    PG8_STAGE(PG8_SB(1, 0), cB + kstep, voffB); PG8_STAGE(PG8_SA(1, 0), cA + kstep, voffA); PG8_STAGE(PG8_SB(1, 1), cB + hstep + kstep, voffB);
    PG8_WAIT_V(6); PG8_BAR;
    for (;;) {
        const bool has_next = S.next(ui + 1, nxt);
        const char* nA = has_next ? nxt.a : cA; const char* nB = has_next ? nxt.b : cB;
        for (int t = 0; t < nt; t += 2) {
            const bool last = (t == nt - 2);
            const char* a1 = uniform_ptr(cA + (size_t)(t + 1) * kstep);
            const char* a2 = uniform_ptr(last ? nA : cA + (size_t)(t + 2) * kstep); const char* b2 = uniform_ptr(last ? nB : cB + (size_t)(t + 2) * kstep);
            const char* a3 = uniform_ptr(a2 + kstep); const char* b3 = uniform_ptr(b2 + kstep);
            PG8_LDB(B0, 0, 0); PG8_LDB(B1, 0, 1); PG8_SCHED; PG8_LDA(At, 0, 0); PG8_STAGE(PG8_SA(1, 1), a1 + hstep, voffA);
            PG8_WAIT_V(8); PG8_WAIT_L(0); PG8_BAR; PG8_MMA(0, 0, At, B0); PG8_MMA(0, 1, At, B1); PG8_BAR; PG8_SCHED;
            PG8_LDA(At, 0, 1); PG8_STAGE(PG8_SB(0, 0), b2, voffB); PG8_STAGE(PG8_SB(0, 1), b2 + hstep, voffB); PG8_STAGE(PG8_SA(0, 0), a2, voffA);
            PG8_WAIT_V(8); PG8_WAIT_L(0); PG8_BAR; PG8_MMA(1, 0, At, B0); PG8_MMA(1, 1, At, B1); PG8_BAR; PG8_SCHED;
            PG8_LDB(B0, 1, 0); PG8_LDB(B1, 1, 1); PG8_SCHED; PG8_LDA(At, 1, 0); PG8_STAGE(PG8_SA(0, 1), a2 + hstep, voffA);
            PG8_WAIT_V(8); PG8_WAIT_L(0); PG8_BAR; PG8_MMA(0, 0, At, B0); PG8_MMA(0, 1, At, B1); PG8_BAR; PG8_SCHED;
            PG8_LDA(At, 1, 1); PG8_STAGE(PG8_SB(1, 0), b3, voffB); PG8_STAGE(PG8_SB(1, 1), b3 + hstep, voffB); PG8_STAGE(PG8_SA(1, 0), a3, voffA);
            PG8_WAIT_V(8); PG8_WAIT_L(0); PG8_BAR; PG8_MMA(1, 0, At, B0); PG8_MMA(1, 1, At, B1); PG8_BAR; PG8_SCHED;
        }
        if (wr == 0) PG8_BAR;
        E(acc, cur, wr, wc, fr, fq);
        if (!has_next) break;
#pragma unroll
        for (int a = 0; a < 2; ++a)
#pragma unroll
            for (int b = 0; b < 2; ++b)
#pragma unroll
                for (int m = 0; m < 4; ++m)
#pragma unroll
                    for (int n = 0; n < 2; ++n) acc[a][b][m][n] = (f32x4){0.f, 0.f, 0.f, 0.f};
        cur = nxt; cA = nA; cB = nB; ++ui;
        if (wr == 1) PG8_BAR;
    }
    PG8_WAIT_V(0);
    PG8_BAR;
#undef PG8_SA
#undef PG8_SB
#undef PG8_STAGE
#undef PG8_LDA
#undef PG8_LDB
#undef PG8_MMA
#undef PG8_WAIT_V
#undef PG8_WAIT_L
#undef PG8_BAR
#undef PG8_SCHED
}

struct UnitM { int pm, pn; };
struct SchedM {
    const char* a; const char* b; const char* a8; const char* b8; int nM, nN, G, c;
    __device__ __forceinline__ bool next(int i, UnitM& u) const {
        const long L = (long)i * G + c; if (L >= (long)nM * nN) return false;
        int pm, pn; tile_order((int)L, nM, nN, pm, pn); u.pm = __builtin_amdgcn_readfirstlane(pm); u.pn = __builtin_amdgcn_readfirstlane(pn); return true;
    }
};
template <class Epi>
__device__ __forceinline__ void gemm_phase_mixed(LAS unsigned char* lds, const SchedM& S, const Epi& E) {
    constexpr int NT1 = 32, NT = 48;
    const int tid = opaque_tid(), wid = __builtin_amdgcn_readfirstlane(tid >> 6), lane = tid & 63, wr = wid >> 2, wc = wid & 3, fr = lane & 15, fq = lane >> 4;
    unsigned voffA0, voffB0;
    { int R, C; stage_rc(tid * 16, R, C); const int Rb = (R & ~31) + perm32(R & 31); voffA0 = (unsigned)(R * 8192 + 2 * C); voffB0 = (unsigned)(Rb * 8192 + 2 * C); }
    const unsigned ldsw = (unsigned)wid * 1024u;
    const int aoff = lds_byte(wr * 64 + fr, fq * 8), boff = lds_byte(wc * 32 + fr, fq * 8);
#define MX_SA(b, h) (((b) * 2 + (h)) * HTB)
#define MX_SB(b, h) ((4 + (b) * 2 + (h)) * HTB)
#define MX_STAGE(bufoff, ISB, PX, tt, half, VOFF0, M) do { \
        const char* gb_ = uniform_ptr((M) ? ((ISB) ? S.b8 : S.a8) + (size_t)(PX) * (256 * 2048) + (size_t)((tt) - NT1) * 128 + (size_t)(half) * 128 * 2048 \
                                          : ((ISB) ? S.b : S.a) + (size_t)(PX) * (256 * 8192) + (size_t)(tt) * 128 + (size_t)(half) * 128 * 8192); \
        unsigned v0_ = (VOFF0); asm volatile("" : "+v"(v0_)); if (M) v0_ -= (v0_ >> 13) * 6144u; \
        _Pragma("unroll") for (int _i = 0; _i < 2; ++_i) { const unsigned vo_ = v0_ + (unsigned)_i * ((M) ? 64u * 2048u : 64u * 8192u); \
            __builtin_amdgcn_global_load_lds((const unsigned*)(gb_ + vo_), (LAS unsigned*)(lds + (bufoff) + ldsw + _i * 8192), 16, 0, 0); } } while (0)
#define MX_PIN(ai, bj) do { _Pragma("unroll") for (int m = 0; m < 4; ++m) _Pragma("unroll") for (int n = 0; n < 2; ++n) asm volatile("" : "+v"(acc[ai][bj][m][n])); } while (0)
#define MX_LDA0(b, h) do { _Pragma("unroll") for (int m = 0; m < 4; ++m) _Pragma("unroll") for (int k = 0; k < 2; ++k) At[m][k] = *(const LAS bf16x8*)(lds + MX_SA(b, h) + aoff + m * 2048 + k * 1024); } while (0)
#define MX_LDB0(dst, b, h) do { _Pragma("unroll") for (int n = 0; n < 2; ++n) _Pragma("unroll") for (int k = 0; k < 2; ++k) dst[n][k] = *(const LAS bf16x8*)(lds + MX_SB(b, h) + boff + n * 2048 + k * 1024); } while (0)
#define MX_MMA0(ai, bj, Bt) do { __builtin_amdgcn_s_setprio(1); _Pragma("unroll") for (int m = 0; m < 4; ++m) _Pragma("unroll") for (int n = 0; n < 2; ++n) _Pragma("unroll") for (int k = 0; k < 2; ++k) \
        acc[ai][bj][m][n] = __builtin_amdgcn_mfma_f32_16x16x32_bf16(Bt[n][k], At[m][k], acc[ai][bj][m][n], 0, 0, 0); MX_PIN(ai, bj); __builtin_amdgcn_s_setprio(0); } while (0)
#define MX_LDA1(b, h) do { _Pragma("unroll") for (int m = 0; m < 4; ++m) { const i32x4v lo_ = *(const LAS i32x4v*)(lds + MX_SA(b, h) + aoff + m * 2048), hi_ = *(const LAS i32x4v*)(lds + MX_SA(b, h) + aoff + m * 2048 + 1024); \
        At8[m] = __builtin_shufflevector(lo_, hi_, 0, 1, 2, 3, 4, 5, 6, 7); } } while (0)
#define MX_LDB1(dst, b, h) do { _Pragma("unroll") for (int n = 0; n < 2; ++n) { const i32x4v lo_ = *(const LAS i32x4v*)(lds + MX_SB(b, h) + boff + n * 2048), hi_ = *(const LAS i32x4v*)(lds + MX_SB(b, h) + boff + n * 2048 + 1024); \
        dst##8[n] = __builtin_shufflevector(lo_, hi_, 0, 1, 2, 3, 4, 5, 6, 7); } } while (0)
#define MX_MMA1(ai, bj, Bt) do { __builtin_amdgcn_s_setprio(1); _Pragma("unroll") for (int m = 0; m < 4; ++m) _Pragma("unroll") for (int n = 0; n < 2; ++n) \
        acc[ai][bj][m][n] = __builtin_amdgcn_mfma_scale_f32_16x16x128_f8f6f4(Bt##8[n], At8[m], acc[ai][bj][m][n], 0, 0, 0, 121, 0, 123); MX_PIN(ai, bj); __builtin_amdgcn_s_setprio(0); } while (0)
#define MX_WAIT_V(n) asm volatile("s_waitcnt vmcnt(" #n ")" ::: "memory")
#define MX_WAIT_L(n) asm volatile("s_waitcnt lgkmcnt(" #n ")" ::: "memory")
#define MX_BAR __builtin_amdgcn_s_barrier()
#define MX_SCHED __builtin_amdgcn_sched_barrier(0)
#define MX_BODY(F, G) do { \
        MX_LDB##F(B0, 0, 0); MX_LDB##F(B1, 0, 1); MX_SCHED; MX_LDA##F(0, 0); MX_STAGE(MX_SA(1, 1), 0, cur.pm, t + 1, 1, voffA0, F); \
        MX_WAIT_V(8); MX_WAIT_L(0); MX_BAR; MX_MMA##F(0, 0, B0); MX_MMA##F(0, 1, B1); MX_BAR; MX_SCHED; \
        MX_LDA##F(0, 1); MX_STAGE(MX_SB(0, 0), 1, xpn, i2, 0, voffB0, G); MX_STAGE(MX_SB(0, 1), 1, xpn, i2, 1, voffB0, G); MX_STAGE(MX_SA(0, 0), 0, xpm, i2, 0, voffA0, G); \
        MX_WAIT_V(8); MX_WAIT_L(0); MX_BAR; MX_MMA##F(1, 0, B0); MX_MMA##F(1, 1, B1); MX_BAR; MX_SCHED; \
        MX_LDB##F(B0, 1, 0); MX_LDB##F(B1, 1, 1); MX_SCHED; MX_LDA##F(1, 0); MX_STAGE(MX_SA(0, 1), 0, xpm, i2, 1, voffA0, G); \
        MX_WAIT_V(8); MX_WAIT_L(0); MX_BAR; MX_MMA##F(0, 0, B0); MX_MMA##F(0, 1, B1); MX_BAR; MX_SCHED; \
        MX_LDA##F(1, 1); MX_STAGE(MX_SB(1, 0), 1, xpn, i3, 0, voffB0, G); MX_STAGE(MX_SB(1, 1), 1, xpn, i3, 1, voffB0, G); MX_STAGE(MX_SA(1, 0), 0, xpm, i3, 0, voffA0, G); \
        MX_WAIT_V(8); MX_WAIT_L(0); MX_BAR; MX_MMA##F(1, 0, B0); MX_MMA##F(1, 1, B1); MX_BAR; MX_SCHED; } while (0)
    UnitM cur, nxt; int ui = 0;
    if (!S.next(0, cur)) return;
    f32x4 acc[2][2][4][2];
#pragma unroll
    for (int a = 0; a < 2; ++a)
#pragma unroll
        for (int b = 0; b < 2; ++b)
#pragma unroll
            for (int m = 0; m < 4; ++m)
#pragma unroll
                for (int n = 0; n < 2; ++n) acc[a][b][m][n] = (f32x4){0.f, 0.f, 0.f, 0.f};
    bf16x8 At[4][2], B0[2][2], B1[2][2];
    i32x8 At8[4], B08[2], B18[2];
    MX_STAGE(MX_SB(0, 0), 1, cur.pn, 0, 0, voffB0, 0); MX_STAGE(MX_SB(0, 1), 1, cur.pn, 0, 1, voffB0, 0); MX_STAGE(MX_SA(0, 0), 0, cur.pm, 0, 0, voffA0, 0); MX_STAGE(MX_SA(0, 1), 0, cur.pm, 0, 1, voffA0, 0);
    if (wr == 1) MX_BAR;
    MX_WAIT_V(2); MX_BAR;
    MX_STAGE(MX_SB(1, 0), 1, cur.pn, 1, 0, voffB0, 0); MX_STAGE(MX_SA(1, 0), 0, cur.pm, 1, 0, voffA0, 0); MX_STAGE(MX_SB(1, 1), 1, cur.pn, 1, 1, voffB0, 0);
    MX_WAIT_V(6); MX_BAR;
    for (;;) {
        const bool has_next = S.next(ui + 1, nxt);
        if (!has_next) nxt = cur;
        { const int xpm = cur.pm, xpn = cur.pn;
          for (int t = 0; t < NT1 - 2; t += 2) { const int i2 = t + 2, i3 = t + 3; MX_BODY(0, 0); }
          { const int t = NT1 - 2, i2 = NT1, i3 = NT1 + 1; MX_BODY(0, 1); }
          for (int t = NT1; t < NT - 2; t += 2) { const int i2 = t + 2, i3 = t + 3; MX_BODY(1, 1); } }
        { const int xpm = nxt.pm, xpn = nxt.pn; const int t = NT - 2, i2 = 0, i3 = 1; MX_BODY(1, 0); }
        if (wr == 0) MX_BAR;
        { Unit eu; eu.a = nullptr; eu.b = nullptr; eu.pm = cur.pm; eu.pn = cur.pn; eu.kind = 0; E(acc, eu, wr, wc, fr, fq); }
        if (!has_next) break;
#pragma unroll
        for (int a = 0; a < 2; ++a)
#pragma unroll
            for (int b = 0; b < 2; ++b)
#pragma unroll
                for (int m = 0; m < 4; ++m)
#pragma unroll
                    for (int n = 0; n < 2; ++n) acc[a][b][m][n] = (f32x4){0.f, 0.f, 0.f, 0.f};
        cur = nxt; ++ui;
        if (wr == 1) MX_BAR;
    }
    MX_WAIT_V(0);
    MX_BAR;
#undef MX_SA
#undef MX_SB
#undef MX_STAGE
#undef MX_LDA0
#undef MX_PIN
#undef MX_LDB0
#undef MX_MMA0
#undef MX_LDA1
#undef MX_LDB1
#undef MX_MMA1
#undef MX_WAIT_V
#undef MX_WAIT_L
#undef MX_BAR
#undef MX_SCHED
#undef MX_BODY
}

struct SchedC {
    const char* U; const char* w1k; const char* w1v; int ukc, uvc; int unit;
    __device__ __forceinline__ bool next(int i, UnitM& u) const { if (i > 0) return false; const int kv = unit & 1, pnh = (unit >> 1) & 1, bg = unit >> 2;
        u.pm = __builtin_amdgcn_readfirstlane(kv * 8 + bg); u.pn = __builtin_amdgcn_readfirstlane(kv * 2 + pnh); return true; }
    __device__ __forceinline__ const char* abase(int ca) const { const int kv = ca >> 3, bg = ca & 7; return U + ((size_t)((bg >> 2) * SEQ) * UW + (kv ? uvc : ukc) + (bg & 3) * 128) * 2; }
    __device__ __forceinline__ const char* bbase(int cb) const { return ((cb >> 1) ? w1v : w1k) + (size_t)(cb & 1) * 2048 * 2; }
};
template <class Epi>
__device__ __forceinline__ void gemm_cmp(LAS unsigned char* lds, const SchedC& S, const Epi& E) {
    constexpr int NT = 32; constexpr unsigned PITCHA = 16u * UW * 2u;
    const int tid = opaque_tid(), wid = __builtin_amdgcn_readfirstlane(tid >> 6), lane = tid & 63, wr = wid >> 2, wc = wid & 3, fr = lane & 15, fq = lane >> 4;
    unsigned voffA0, voffB0;
    { int R, C; stage_rc(tid * 16, R, C); const int Rb = (R & ~31) + perm32(R & 31); voffA0 = (unsigned)R * PITCHA + 2u * C; voffB0 = (unsigned)(Rb * 8192 + 2 * C); }
    const unsigned ldsw = (unsigned)wid * 1024u;
    const int aoff = lds_byte(wr * 64 + fr, fq * 8), boff = lds_byte(wc * 32 + fr, fq * 8);
#define MX_SA(b, h) (((b) * 2 + (h)) * HTB)
#define MX_SB(b, h) ((4 + (b) * 2 + (h)) * HTB)
#define MX_STAGE(bufoff, ISB, PX, tt, half, VOFF0, M) do { \
        const char* gb_ = uniform_ptr((ISB) ? S.bbase(PX) + (size_t)(tt) * 128 + (size_t)(half) * 128 * 8192 \
                                            : S.abase(PX) + (size_t)((tt) >> 1) * (UW * 2) + (size_t)((tt) & 1) * 128 + (size_t)(half) * 128 * PITCHA); \
        unsigned v0_ = (VOFF0); asm volatile("" : "+v"(v0_)); \
        _Pragma("unroll") for (int _i = 0; _i < 2; ++_i) { const unsigned vo_ = v0_ + (unsigned)_i * ((ISB) ? 64u * 8192u : 64u * PITCHA); \
            __builtin_amdgcn_global_load_lds((const unsigned*)(gb_ + vo_), (LAS unsigned*)(lds + (bufoff) + ldsw + _i * 8192), 16, 0, 0); } } while (0)
#define MX_PIN(ai, bj) do { _Pragma("unroll") for (int m = 0; m < 4; ++m) _Pragma("unroll") for (int n = 0; n < 2; ++n) asm volatile("" : "+v"(acc[ai][bj][m][n])); } while (0)
#define MX_LDA0(b, h) do { _Pragma("unroll") for (int m = 0; m < 4; ++m) _Pragma("unroll") for (int k = 0; k < 2; ++k) At[m][k] = *(const LAS bf16x8*)(lds + MX_SA(b, h) + aoff + m * 2048 + k * 1024); } while (0)
#define MX_LDB0(dst, b, h) do { _Pragma("unroll") for (int n = 0; n < 2; ++n) _Pragma("unroll") for (int k = 0; k < 2; ++k) dst[n][k] = *(const LAS bf16x8*)(lds + MX_SB(b, h) + boff + n * 2048 + k * 1024); } while (0)
#define MX_MMA0(ai, bj, Bt) do { __builtin_amdgcn_s_setprio(1); _Pragma("unroll") for (int m = 0; m < 4; ++m) _Pragma("unroll") for (int n = 0; n < 2; ++n) _Pragma("unroll") for (int k = 0; k < 2; ++k) \
        acc[ai][bj][m][n] = __builtin_amdgcn_mfma_f32_16x16x32_bf16(Bt[n][k], At[m][k], acc[ai][bj][m][n], 0, 0, 0); MX_PIN(ai, bj); __builtin_amdgcn_s_setprio(0); } while (0)
#define MX_WAIT_V(n) asm volatile("s_waitcnt vmcnt(" #n ")" ::: "memory")
#define MX_WAIT_L(n) asm volatile("s_waitcnt lgkmcnt(" #n ")" ::: "memory")
#define MX_BAR __builtin_amdgcn_s_barrier()
#define MX_SCHED __builtin_amdgcn_sched_barrier(0)
#define MX_BODY(F, G) do { \
        MX_LDB##F(B0, 0, 0); MX_LDB##F(B1, 0, 1); MX_SCHED; MX_LDA##F(0, 0); MX_STAGE(MX_SA(1, 1), 0, cur.pm, t + 1, 1, voffA0, F); \
        MX_WAIT_V(8); MX_WAIT_L(0); MX_BAR; MX_MMA##F(0, 0, B0); MX_MMA##F(0, 1, B1); MX_BAR; MX_SCHED; \
        MX_LDA##F(0, 1); MX_STAGE(MX_SB(0, 0), 1, xpn, i2, 0, voffB0, G); MX_STAGE(MX_SB(0, 1), 1, xpn, i2, 1, voffB0, G); MX_STAGE(MX_SA(0, 0), 0, xpm, i2, 0, voffA0, G); \
        MX_WAIT_V(8); MX_WAIT_L(0); MX_BAR; MX_MMA##F(1, 0, B0); MX_MMA##F(1, 1, B1); MX_BAR; MX_SCHED; \
        MX_LDB##F(B0, 1, 0); MX_LDB##F(B1, 1, 1); MX_SCHED; MX_LDA##F(1, 0); MX_STAGE(MX_SA(0, 1), 0, xpm, i2, 1, voffA0, G); \
        MX_WAIT_V(8); MX_WAIT_L(0); MX_BAR; MX_MMA##F(0, 0, B0); MX_MMA##F(0, 1, B1); MX_BAR; MX_SCHED; \
        MX_LDA##F(1, 1); MX_STAGE(MX_SB(1, 0), 1, xpn, i3, 0, voffB0, G); MX_STAGE(MX_SB(1, 1), 1, xpn, i3, 1, voffB0, G); MX_STAGE(MX_SA(1, 0), 0, xpm, i3, 0, voffA0, G); \
        MX_WAIT_V(8); MX_WAIT_L(0); MX_BAR; MX_MMA##F(1, 0, B0); MX_MMA##F(1, 1, B1); MX_BAR; MX_SCHED; } while (0)
    UnitM cur, nxt; int ui = 0;
    if (!S.next(0, cur)) return;
    f32x4 acc[2][2][4][2];
#pragma unroll
    for (int a = 0; a < 2; ++a)
#pragma unroll
        for (int b = 0; b < 2; ++b)
#pragma unroll
            for (int m = 0; m < 4; ++m)
#pragma unroll
                for (int n = 0; n < 2; ++n) acc[a][b][m][n] = (f32x4){0.f, 0.f, 0.f, 0.f};
    bf16x8 At[4][2], B0[2][2], B1[2][2];
    MX_STAGE(MX_SB(0, 0), 1, cur.pn, 0, 0, voffB0, 0); MX_STAGE(MX_SB(0, 1), 1, cur.pn, 0, 1, voffB0, 0); MX_STAGE(MX_SA(0, 0), 0, cur.pm, 0, 0, voffA0, 0); MX_STAGE(MX_SA(0, 1), 0, cur.pm, 0, 1, voffA0, 0);
    if (wr == 1) MX_BAR;
    MX_WAIT_V(2); MX_BAR;
    MX_STAGE(MX_SB(1, 0), 1, cur.pn, 1, 0, voffB0, 0); MX_STAGE(MX_SA(1, 0), 0, cur.pm, 1, 0, voffA0, 0); MX_STAGE(MX_SB(1, 1), 1, cur.pn, 1, 1, voffB0, 0);
    MX_WAIT_V(6); MX_BAR;
    for (;;) {
        const bool has_next = S.next(ui + 1, nxt);
        if (!has_next) nxt = cur;
        { const int xpm = cur.pm, xpn = cur.pn;
          for (int t = 0; t < NT - 2; t += 2) { const int i2 = t + 2, i3 = t + 3; MX_BODY(0, 0); } }
        { const int xpm = nxt.pm, xpn = nxt.pn; const int t = NT - 2, i2 = 0, i3 = 1; MX_BODY(0, 0); }
        if (wr == 0) MX_BAR;
        { Unit eu; eu.a = nullptr; eu.b = nullptr; eu.pm = cur.pm; eu.pn = cur.pn; eu.kind = 0; E(acc, eu, wr, wc, fr, fq); }
        if (!has_next) break;
#pragma unroll
        for (int a = 0; a < 2; ++a)
#pragma unroll
            for (int b = 0; b < 2; ++b)
#pragma unroll
                for (int m = 0; m < 4; ++m)
#pragma unroll
                    for (int n = 0; n < 2; ++n) acc[a][b][m][n] = (f32x4){0.f, 0.f, 0.f, 0.f};
        cur = nxt; ++ui;
        if (wr == 1) MX_BAR;
    }
    MX_WAIT_V(0);
    MX_BAR;
#undef MX_SA
#undef MX_SB
#undef MX_STAGE
#undef MX_LDA0
#undef MX_PIN
#undef MX_LDB0
#undef MX_MMA0
#undef MX_WAIT_V
#undef MX_WAIT_L
#undef MX_BAR
#undef MX_SCHED
#undef MX_BODY
}
}

struct EpiStore {
    bf16_t* U; float* small; bf16_t* T; bf16_t* O2; int ldc2;
    __device__ __forceinline__ void operator()(const f32x4 (&acc)[2][2][4][2], const pg8::Unit& u, int wr, int wc, int fr_, int fq_) const {
        const int lane_ = opaque_tid() & 63, fr = lane_ & 15, fq = lane_ >> 4; (void)fr_; (void)fq_;
        const int row0 = u.pm * 256 + wr * 64 + fr;
        if (u.kind == 0 && u.pn == 48) {
            int fq2 = fq; asm volatile("" : "+v"(fq2));
            if (wc < 2) {
#pragma unroll
                for (int ai = 0; ai < 2; ++ai)
#pragma unroll
                    for (int m = 0; m < 4; ++m) { float* rp = small + (size_t)(row0 + ai * 128 + m * 16) * 64 + wc * 32 + 8 * fq2;
                        *(f32x4*)rp = acc[ai][0][m][0]; *(f32x4*)(rp + 4) = acc[ai][0][m][1]; }
            }
            return;
        }
        bf16_t* base = u.kind == 0 ? U : (u.kind == 1 ? T : O2); const int ldc = u.kind == 0 ? UW : (u.kind == 1 ? MTOK : ldc2);
        const int col0 = u.pn * 256 + wc * 32 + 8 * fq;
#pragma unroll
        for (int ai = 0; ai < 2; ++ai)
#pragma unroll
            for (int m = 0; m < 4; ++m) { bf16_t* rowp = base + (size_t)(row0 + ai * 128 + m * 16) * ldc + col0;
#pragma unroll
                for (int bj = 0; bj < 2; ++bj) { const f32x4 v0 = acc[ai][bj][m][0], v1 = acc[ai][bj][m][1];
                    u32x4 w; w.x = pg8::cvt_pk_bf16(v0[0], v0[1]); w.y = pg8::cvt_pk_bf16(v0[2], v0[3]); w.z = pg8::cvt_pk_bf16(v1[0], v1[1]); w.w = pg8::cvt_pk_bf16(v1[2], v1[3]);
                    *(u32x4*)(rowp + bj * 128) = w; } }
    }
};
struct EpiZ {
    float* Z;
    __device__ __forceinline__ void operator()(const f32x4 (&acc)[2][2][4][2], const pg8::Unit& u, int wr, int wc, int fr_, int fq_) const {
        const int lane_ = opaque_tid() & 63, fr = lane_ & 15, fq = lane_ >> 4; (void)fr_; (void)fq_;
        float* base = Z + ((size_t)u.pm * 256 + wr * 64 + fr) * 512 + (u.pn & 1) * 256 + wc * 32 + 8 * fq;
#pragma unroll
        for (int ai = 0; ai < 2; ++ai)
#pragma unroll
            for (int m = 0; m < 4; ++m)
#pragma unroll
                for (int bj = 0; bj < 2; ++bj) { float* rp = base + (size_t)(ai * 128 + m * 16) * 512 + bj * 128; *(f32x4*)rp = acc[ai][bj][m][0]; *(f32x4*)(rp + 4) = acc[ai][bj][m][1]; }
    }
};
struct EpiRes {
    const float* x; bf16_t* x1b;
    __device__ __forceinline__ void operator()(const f32x4 (&acc)[2][2][4][2], const pg8::Unit& u, int wr, int wc, int fr, int fq) const {
        const int row0 = u.pm * 256 + wr * 64 + fr, col0 = u.pn * 256 + wc * 32 + 8 * fq;
#pragma unroll
        for (int ai = 0; ai < 2; ++ai) {
            f32x4 xa[4][2][2];
#pragma unroll
            for (int m = 0; m < 4; ++m) { const size_t off = (size_t)(row0 + ai * 128 + m * 16) * DM + col0;
#pragma unroll
                for (int bj = 0; bj < 2; ++bj) { xa[m][bj][0] = *(const f32x4*)(x + off + bj * 128); xa[m][bj][1] = *(const f32x4*)(x + off + bj * 128 + 4); } }
            __builtin_amdgcn_sched_barrier(0);
#pragma unroll
            for (int m = 0; m < 4; ++m) { const size_t off = (size_t)(row0 + ai * 128 + m * 16) * DM + col0;
#pragma unroll
                for (int bj = 0; bj < 2; ++bj) { const f32x4 v0 = acc[ai][bj][m][0] + xa[m][bj][0], v1 = acc[ai][bj][m][1] + xa[m][bj][1];
                    u32x4 w; w.x = pk2(v0[0], v0[1]); w.y = pk2(v0[2], v0[3]); w.z = pk2(v1[0], v1[1]); w.w = pk2(v1[2], v1[3]);
                    *(u32x4*)(x1b + off + bj * 128) = w; } }
            __builtin_amdgcn_sched_barrier(0);
        }
    }
};
struct EpiGate {
    float* out; const bf16_t* x1b; const bf16_t* pe;
    __device__ __forceinline__ void operator()(const f32x4 (&acc)[2][2][4][2], const pg8::Unit& u, int wr, int wc, int fr, int fq) const {
        const int row0 = u.pm * 256 + wr * 64 + fr, col0 = u.pn * 256 + wc * 32 + 8 * fq;
#pragma unroll
        for (int ai = 0; ai < 2; ++ai) {
            u32x4 xw[4][2], pw[4][2];
#pragma unroll
            for (int m = 0; m < 4; ++m) { const size_t off = (size_t)(row0 + ai * 128 + m * 16) * DM + col0;
#pragma unroll
                for (int bj = 0; bj < 2; ++bj) { xw[m][bj] = *(const u32x4*)(x1b + off + bj * 128); pw[m][bj] = *(const u32x4*)(pe + off + bj * 128); } }
            __builtin_amdgcn_sched_barrier(0);
#pragma unroll
            for (int m = 0; m < 4; ++m) { const size_t off = (size_t)(row0 + ai * 128 + m * 16) * DM + col0;
#pragma unroll
                for (int bj = 0; bj < 2; ++bj) { const u32x4 xv = xw[m][bj], pv = pw[m][bj];
                    const f32x4 a0 = acc[ai][bj][m][0], a1 = acc[ai][bj][m][1];
                    f32x4 v0, v1;
                    v0[0] = bflo(xv.x) + sigmoidf_(a0[0]) * bflo(pv.x); v0[1] = bfhi(xv.x) + sigmoidf_(a0[1]) * bfhi(pv.x);
                    v0[2] = bflo(xv.y) + sigmoidf_(a0[2]) * bflo(pv.y); v0[3] = bfhi(xv.y) + sigmoidf_(a0[3]) * bfhi(pv.y);
                    v1[0] = bflo(xv.z) + sigmoidf_(a1[0]) * bflo(pv.z); v1[1] = bfhi(xv.z) + sigmoidf_(a1[1]) * bfhi(pv.z);
                    v1[2] = bflo(xv.w) + sigmoidf_(a1[2]) * bflo(pv.w); v1[3] = bfhi(xv.w) + sigmoidf_(a1[3]) * bfhi(pv.w);
                    *(f32x4*)(out + off + bj * 128) = v0; *(f32x4*)(out + off + bj * 128 + 4) = v1; } }
            __builtin_amdgcn_sched_barrier(0);
        }
    }
};

constexpr size_t MiB = 1u << 20;
constexpr size_t WS_CTL = 0;
constexpr size_t WS_HB = 1 * MiB;
constexpr size_t WS_WT = WS_HB + 64 * MiB;
constexpr size_t WS_WOT = WS_WT + 122 * MiB;
constexpr size_t WS_WGT = WS_WOT + 32 * MiB;
constexpr size_t WS_WPT = WS_WGT + 32 * MiB;
constexpr size_t WS_PB = WS_WPT + 2 * MiB;
constexpr size_t WS_W1K = WS_PB + 4 * MiB;
constexpr size_t WS_W1V = WS_W1K + 2 * MiB;
constexpr size_t WS_W2 = WS_W1V + 2 * MiB;
constexpr size_t WS_U = WS_W2 + 1 * MiB;
constexpr size_t WS_T = WS_U + 192 * MiB;
constexpr size_t WS_SMALL = WS_T + 48 * MiB;
constexpr size_t WS_PE = WS_SMALL + 2 * MiB;
constexpr size_t WS_DCT = WS_PE + 64 * MiB;
constexpr size_t WS_CT = WS_DCT + 64 * MiB;
constexpr size_t WS_MLS = WS_CT + 64 * MiB;
constexpr size_t WS_NSA = WS_MLS + 2 * MiB;
constexpr size_t WS_OC = WS_NSA + 2 * MiB;
constexpr size_t WS_OW = WS_OC + 32 * MiB;
constexpr size_t WS_HB8 = WS_OW + 32 * MiB;
constexpr size_t WS_W8 = WS_HB8 + 32 * MiB;
constexpr size_t WS_Y8 = WS_W8 + 28 * MiB;
constexpr size_t WS_WO8 = WS_Y8 + 16 * MiB;
constexpr size_t WS_Z = WS_WO8 + 8 * MiB;
constexpr size_t WS_CP = WS_Z + 8 * MiB;
constexpr size_t WS_END = WS_CP + 1 * MiB;

struct Params {
    const float *x, *p, *norm_w, *w_in, *conv_w, *i_bias, *f_bias, *hnorm_w, *qnorm_w, *knorm_w, *pe_k, *pe_v, *k_w1, *k_w2, *v_w1, *v_w2, *rel_bias, *w_out, *ple_proj, *ple_gate;
    float* out;
    unsigned char* ws;
    __device__ __forceinline__ unsigned* ctl() const { return (unsigned*)(ws + (WS_CTL)); }
    __device__ __forceinline__ bf16_t* hb() const { return (bf16_t*)(ws + (WS_HB)); }
    __device__ __forceinline__ bf16_t* Wt() const { return (bf16_t*)(ws + (WS_WT)); }
    __device__ __forceinline__ bf16_t* WoT() const { return (bf16_t*)(ws + (WS_WOT)); }
    __device__ __forceinline__ bf16_t* WgT() const { return (bf16_t*)(ws + (WS_WGT)); }
    __device__ __forceinline__ bf16_t* WpT() const { return (bf16_t*)(ws + (WS_WPT)); }
    __device__ __forceinline__ bf16_t* pb() const { return (bf16_t*)(ws + (WS_PB)); }
    __device__ __forceinline__ bf16_t* w1kT() const { return (bf16_t*)(ws + (WS_W1K)); }
    __device__ __forceinline__ bf16_t* w1vT() const { return (bf16_t*)(ws + (WS_W1V)); }
    __device__ __forceinline__ bf16_t* w2kT() const { return (bf16_t*)(ws + (WS_W2)); }
    __device__ __forceinline__ bf16_t* w2vT() const { return (bf16_t*)(ws + (WS_W2 + 65536)); }
    __device__ __forceinline__ bf16_t* U() const { return (bf16_t*)(ws + (WS_U)); }
    __device__ __forceinline__ bf16_t* T() const { return (bf16_t*)(ws + (WS_T)); }
    __device__ __forceinline__ float* small() const { return (float*)(ws + (WS_SMALL)); }
    __device__ __forceinline__ bf16_t* y() const { return (bf16_t*)(ws + (WS_HB)); }
    __device__ __forceinline__ bf16_t* x1b() const { return (bf16_t*)(ws + (WS_WT)); }
    __device__ __forceinline__ bf16_t* pe() const { return (bf16_t*)(ws + (WS_PE)); }
    __device__ __forceinline__ bf16_t* dCt() const { return (bf16_t*)(ws + (WS_DCT)); }
    __device__ __forceinline__ bf16_t* Ct() const { return (bf16_t*)(ws + (WS_CT)); }
    __device__ __forceinline__ float* dn() const { return (float*)(ws + (WS_MLS)); }
    __device__ __forceinline__ float* nst() const { return (float*)(ws + (WS_MLS + 4 * 131072)); }
    __device__ __forceinline__ float* cbL() const { return (float*)(ws + (WS_MLS + 4 * 262144)); }
    __device__ __forceinline__ float* cgmax() const { return (float*)(ws + (WS_MLS + 4 * 263168)); }
    __device__ __forceinline__ float* cm() const { return (float*)(ws + (WS_MLS + 4 * 264192)); }
    __device__ __forceinline__ float* mb() const { return (float*)(ws + (WS_MLS + 4 * 265216)); }
    __device__ __forceinline__ float* mg() const { return (float*)(ws + (WS_MLS + 4 * (265216 + 65536))); }
    __device__ __forceinline__ bf16_t* kcmp() const { return (bf16_t*)(ws + (WS_NSA)); }
    __device__ __forceinline__ bf16_t* vcmpT() const { return (bf16_t*)(ws + (WS_NSA + 524288)); }
    __device__ __forceinline__ unsigned long long* sel() const { return (unsigned long long*)(ws + (WS_NSA + 1048576)); }
    __device__ __forceinline__ unsigned long long* selu() const { return (unsigned long long*)(ws + (WS_NSA + 1048576 + 262144)); }
    __device__ __forceinline__ bf16_t* oc() const { return (bf16_t*)(ws + (WS_OC)); }
    __device__ __forceinline__ bf16_t* ow() const { return (bf16_t*)(ws + (WS_OW)); }
    __device__ __forceinline__ unsigned char* hb8() const { return (unsigned char*)(ws + (WS_HB8)); }
    __device__ __forceinline__ unsigned char* W8() const { return (unsigned char*)(ws + (WS_W8)); }
    __device__ __forceinline__ unsigned char* y8() const { return (unsigned char*)(ws + (WS_Y8)); }
    __device__ __forceinline__ unsigned char* Wo8() const { return (unsigned char*)(ws + (WS_WO8)); }
    __device__ __forceinline__ float* Z() const { return (float*)(ws + (WS_Z)); }
    __device__ __forceinline__ float* cpart() const { return (float*)(ws + (WS_CP)); }
};
__host__ __device__ inline void fill_params(Params& P, void* const* d_in, void* d_out, void* d_ws) {
    const float* const* in = (const float* const*)d_in;
    P.x = in[0]; P.p = in[1]; P.norm_w = in[2]; P.w_in = in[3]; P.conv_w = in[4]; P.i_bias = in[5]; P.f_bias = in[6]; P.hnorm_w = in[7]; P.qnorm_w = in[8]; P.knorm_w = in[9];
    P.pe_k = in[10]; P.pe_v = in[11]; P.k_w1 = in[12]; P.k_w2 = in[13]; P.v_w1 = in[14]; P.v_w2 = in[15]; P.rel_bias = in[16]; P.w_out = in[17]; P.ple_proj = in[18]; P.ple_gate = in[19];
    P.out = (float*)d_out; P.ws = (unsigned char*)d_ws;
}

__device__ __forceinline__ void p0_transpose_item(const float* W, int K, int N, bf16_t* WT, LAS float* scr, int item, int lane, bool remap, unsigned char* P8, const float* pev = nullptr, float* cp = nullptr) {
    const int nblk = N / 32, kb = item / nblk, nb = item % nblk, k0 = 64 * kb, n0 = 32 * nb;
#pragma unroll 8
    for (int i = 0; i < 32; ++i) { const int kk = 2 * i + (lane >> 5); scr[kk * 33 + (lane & 31)] = W[(size_t)(k0 + kk) * N + n0 + (lane & 31)]; }
    asm volatile("s_waitcnt lgkmcnt(0)" ::: "memory");
    if (pev != nullptr) {
        const int n = lane & 31, kh = lane >> 5; float s = 0.f;
#pragma unroll 8
        for (int kk = 0; kk < 32; ++kk) s += scr[(kh * 32 + kk) * 33 + n] * pev[k0 + kh * 32 + kk];
        s += __shfl_xor(s, 32);
        if (lane < 32) cp[(size_t)kb * N + n0 + n] = s;
    }
    const int c = lane & 7;
#pragma unroll
    for (int j = 0; j < 4; ++j) { const int n = (lane >> 3) + 8 * j; const LAS float* s = scr + (8 * c) * 33 + n;
        u32x4 o; o.x = pk2(s[0 * 33], s[1 * 33]); o.y = pk2(s[2 * 33], s[3 * 33]); o.z = pk2(s[4 * 33], s[5 * 33]); o.w = pk2(s[6 * 33], s[7 * 33]);
        const int dr = remap ? wt_row(n0 + n) : (n0 + n);
        int r8 = remap ? w8_row(dr) : -1; int kk8 = k0;
        if (!remap && P8 != nullptr && k0 >= 2048) { r8 = dr; kk8 = k0 - 2048; }
        const size_t pitch8 = remap ? 4096 : 2048;
        if (r8 < 0) *(u32x4*)(WT + (size_t)dr * K + k0 + 8 * c) = o;
        else { u32x2 q8; q8.x = pk_fp8x4(64.f * s[0 * 33], 64.f * s[1 * 33], 64.f * s[2 * 33], 64.f * s[3 * 33]); q8.y = pk_fp8x4(64.f * s[4 * 33], 64.f * s[5 * 33], 64.f * s[6 * 33], 64.f * s[7 * 33]);
               *(u32x2*)(P8 + (size_t)r8 * pitch8 + kk8 + 8 * c) = q8; } }
    asm volatile("s_waitcnt lgkmcnt(0)" ::: "memory");
}
__device__ __forceinline__ void p0_norm_row(const float* xrow, const float* w, bf16_t* orow, unsigned char* orow8, int lane) {
    const f32x4* xr = (const f32x4*)xrow + lane; const f32x4* wr = (const f32x4*)w + lane;
    f32x4 v[16]; float s = 0.f;
#pragma unroll
    for (int j = 0; j < 16; ++j) { v[j] = xr[64 * j]; s += (v[j][0] * v[j][0] + v[j][1] * v[j][1]) + (v[j][2] * v[j][2] + v[j][3] * v[j][3]); }
    const float rstd = 1.f / sqrtf(wave_sum(s) * (1.f / DM) + EPS);
    u32x2* o8 = (u32x2*)orow + lane;
#pragma unroll
    for (int j = 0; j < 16; ++j) { const f32x4 ww = wr[64 * j]; const float h0 = v[j][0] * rstd * ww[0], h1 = v[j][1] * rstd * ww[1], h2 = v[j][2] * rstd * ww[2], h3 = v[j][3] * rstd * ww[3];
        u32x2 o; o.x = pk2(h0, h1); o.y = pk2(h2, h3); o8[64 * j] = o;
        ((unsigned*)orow8)[lane + 64 * j] = pk_fp8x4(h0, h1, h2, h3); }
}
__device__ __forceinline__ void phase0(const Params& P, LAS unsigned char* lds_, int bid, int nblk) {
    LAS unsigned char* lds = opq(lds_);
    const int tid = opaque_tid(), lane = tid & 63, wave = tid >> 6;
    LAS float* scr = (LAS float*)(lds + wave * 8704);
    const int gw = bid * 8 + wave, NGW = nblk * 8;
    constexpr int I_IN = (DM / 64) * (INW / 32), I_SQ = (DM / 64) * (DM / 32), I_PP = (256 / 64) * (DM / 32), I_W1 = (DM / 64) * (256 / 32), I_W2 = (256 / 64) * (128 / 32);
    constexpr int NITEMS = I_IN + 2 * I_SQ + I_PP + 2 * I_W1 + 2 * I_W2;
    for (int it = gw; it < NITEMS; it += NGW) {
        int r = it;
        if (r < I_IN) { p0_transpose_item(P.w_in, DM, INW, P.Wt(), scr, r, lane, true, P.W8()); continue; } r -= I_IN;
        if (r < I_SQ) { p0_transpose_item(P.w_out, DM, DM, P.WoT(), scr, r, lane, false, P.Wo8()); continue; } r -= I_SQ;
        if (r < I_SQ) { p0_transpose_item(P.ple_gate, DM, DM, P.WgT(), scr, r, lane, false, nullptr); continue; } r -= I_SQ;
        if (r < I_PP) { p0_transpose_item(P.ple_proj, 256, DM, P.WpT(), scr, r, lane, false, nullptr); continue; } r -= I_PP;
        if (r < I_W1) { p0_transpose_item(P.k_w1, DM, 256, P.w1kT(), scr, r, lane, false, nullptr, P.pe_k, P.cpart()); continue; } r -= I_W1;
        if (r < I_W1) { p0_transpose_item(P.v_w1, DM, 256, P.w1vT(), scr, r, lane, false, nullptr, P.pe_v, P.cpart() + 64 * 256); continue; } r -= I_W1;
        if (r < I_W2) { p0_transpose_item(P.k_w2, 256, 128, P.w2kT(), scr, r, lane, false, nullptr); continue; } r -= I_W2;
        p0_transpose_item(P.v_w2, 256, 128, P.w2vT(), scr, r, lane, false, nullptr);
    }
    for (int m = gw; m < MTOK; m += NGW) p0_norm_row(P.x + (size_t)m * DM, P.norm_w, P.hb() + (size_t)m * DM, P.hb8() + (size_t)m * DM, lane);
    for (size_t i = (size_t)bid * 512 + tid; i < (size_t)MTOK * 256 / 8; i += (size_t)nblk * 512) {
        const f32x4 a = ((const f32x4*)P.p)[2 * i], b = ((const f32x4*)P.p)[2 * i + 1];
        u32x4 o; o.x = pk2(a[0], a[1]); o.y = pk2(a[2], a[3]); o.z = pk2(b[0], b[1]); o.w = pk2(b[2], b[3]); ((u32x4*)P.pb())[i] = o; }
    { u32x4* z = (u32x4*)(P.Wt() + (size_t)(WT_SMALL + 64) * DM); const size_t n = (size_t)(WT_T - WT_SMALL - 64) * DM / 8;
      for (size_t i = (size_t)bid * 512 + tid; i < n; i += (size_t)nblk * 512) z[i] = (u32x4){0u, 0u, 0u, 0u}; }
}

__device__ __forceinline__ void phase_gemm1(const Params& P, LAS unsigned char* lds, int bid, int nblk) {
    EpiStore E{P.U(), P.small(), P.T(), nullptr, 0};
    { pg8::SchedG1B S; S.hb = (const char*)P.hb(); S.wt = (const char*)P.Wt(); S.G = nblk; S.c = bid;
      pg8::gemm_phase<EpiStore, pg8::SchedG1B, false>(lds, DM, S, E); }
    { pg8::SchedG1F S; S.hb8 = (const char*)P.hb8(); S.w8 = (const char*)P.W8(); S.G = nblk; S.c = bid;
      pg8::gemm_phase<EpiStore, pg8::SchedG1F, true>(lds, DM / 2, S, E); }
}
__device__ __forceinline__ void phase_gemm_pe(const Params& P, LAS unsigned char* lds, int bid, int nblk) {
    if (bid < 0) return;
    pg8::Sched2 S; S.K = 256; S.G = nblk; S.c = bid;
    S.a0 = (const char*)P.pb(); S.b0 = (const char*)P.WpT(); S.nM0 = MTOK / 256; S.nN0 = DM / 256; S.kind0 = 2;
    S.a1 = nullptr; S.b1 = nullptr; S.nM1 = 0; S.nN1 = 0; S.kind1 = 2;
    EpiStore E{nullptr, nullptr, nullptr, P.pe(), DM};
    pg8::gemm_phase<EpiStore, pg8::Sched2>(lds, 256, S, E);
}
__device__ __forceinline__ void phase_gemm2(const Params& P, LAS unsigned char* lds, int bid, int nblk) {
    pg8::SchedM S; S.a = (const char*)P.y(); S.b = (const char*)P.WoT(); S.a8 = (const char*)P.y8(); S.b8 = (const char*)P.Wo8(); S.nM = MTOK / 256; S.nN = DM / 256; S.G = nblk; S.c = bid;
    EpiRes E{P.x, P.x1b()};
    pg8::gemm_phase_mixed<EpiRes>(lds, S, E);
}
__device__ __forceinline__ void phase_gemm3(const Params& P, LAS unsigned char* lds, int bid, int nblk) {
    pg8::Sched2 S; S.K = DM; S.G = nblk; S.c = bid;
    S.a0 = (const char*)P.x1b(); S.b0 = (const char*)P.WgT(); S.nM0 = MTOK / 256; S.nN0 = DM / 256; S.kind0 = 0;
    S.a1 = nullptr; S.b1 = nullptr; S.nM1 = 0; S.nN1 = 0; S.kind1 = 0;
    EpiGate E{P.out, P.x1b(), P.pe()};
    pg8::gemm_phase<EpiGate, pg8::Sched2>(lds, DM, S, E);
}

#define MFMA16(a, b, c) __builtin_amdgcn_mfma_f32_16x16x32_bf16((a), (b), (c), 0, 0, 0)
__device__ __forceinline__ bf16x8 mk_frag(u32x4 w) { return __builtin_bit_cast(bf16x8, w); }
__device__ __forceinline__ bf16x8 mk_frag2(u32x2 lo, u32x2 hi) { u32x4 w; w.x = lo.x; w.y = lo.y; w.z = hi.x; w.w = hi.y; return __builtin_bit_cast(bf16x8, w); }

struct ConvW { f32x4 w0[4], w1[4]; };
__device__ __forceinline__ void conv_load_w(const Params& P, int chan0, ConvW& cw) {
#pragma unroll
    for (int j = 0; j < 4; ++j) { cw.w0[j] = *(const f32x4*)(P.conv_w + j * 2048 + chan0); cw.w1[j] = *(const f32x4*)(P.conv_w + j * 2048 + chan0 + 4); }
}
__device__ __forceinline__ void conv_load_x(const Params& P, int b, int spos, int ucol0, u32x4 (&raw)[4]) {
#pragma unroll
    for (int j = 0; j < 4; ++j) { const int ts = spos - 3 + j, tc = ts < 0 ? 0 : ts; raw[j] = *(const u32x4*)(P.U() + (size_t)(b * SEQ + tc) * UW + ucol0); }
}
__device__ __forceinline__ void conv_apply(const ConvW& cw, const u32x4 (&raw)[4], int spos, float (&o)[8]) {
#pragma unroll
    for (int e = 0; e < 8; ++e) o[e] = 0.f;
#pragma unroll
    for (int j = 0; j < 4; ++j) {
        const float z = (spos - 3 + j) < 0 ? 0.f : 1.f;
        o[0] += z * cw.w0[j][0] * bflo(raw[j].x); o[1] += z * cw.w0[j][1] * bfhi(raw[j].x); o[2] += z * cw.w0[j][2] * bflo(raw[j].y); o[3] += z * cw.w0[j][3] * bfhi(raw[j].y);
        o[4] += z * cw.w1[j][0] * bflo(raw[j].z); o[5] += z * cw.w1[j][1] * bfhi(raw[j].z); o[6] += z * cw.w1[j][2] * bflo(raw[j].w); o[7] += z * cw.w1[j][3] * bfhi(raw[j].w);
    }
#pragma unroll
    for (int e = 0; e < 8; ++e) o[e] = siluf_(o[e]);
}

__device__ __forceinline__ void ml_step1(const Params& P, LAS unsigned char* lds_, int task) {
    LAS unsigned char* lds = opq(lds_);
    const int tid = opaque_tid(), lane = tid & 63, wave = tid >> 6, q4 = lane >> 4, l15 = lane & 15, half = wave >> 2, hw = wave & 3, ht = tid & 255;
    const int ch = 2 * task + half;
    const int bh = ch >> 6, c = ch & 63, b = bh >> 3, h = bh & 7, tok0 = b * SEQ + c * 64;
    LAS bf16_t* kT = (LAS bf16_t*)(lds + half * 18944);
    LAS float* wk = (LAS float*)(lds + half * 18944 + 18432);
    if (hw == 0) {
        const float fi = P.small()[(size_t)(tok0 + lane) * 64 + h] + P.i_bias[h];
        const float ff = P.small()[(size_t)(tok0 + lane) * 64 + 8 + h] + P.f_bias[h];
        const float lf = fminf(ff, 0.f) - log1pf(expf(-fabsf(ff)));
        float bc = lf;
#pragma unroll
        for (int o = 1; o < 64; o <<= 1) { const float v = shfl_up_l(bc, o, lane); if (lane >= o) bc += v; }
        const float g = fi - bc; const float gm = wave_max(g);
        const float bL = __builtin_bit_cast(float, __builtin_amdgcn_readlane(__builtin_bit_cast(int, bc), 63));
        wk[lane] = expf(g - gm);
        P.mb()[(size_t)bh * SEQ + c * 64 + lane] = bc; P.mg()[(size_t)bh * SEQ + c * 64 + lane] = g;
        if (lane == 0) { P.cbL()[ch] = bL; P.cgmax()[ch] = gm; }
    }
    float kv[4][8];
    { ConvW cw; conv_load_w(P, 1024 + h * 128 + (ht & 15) * 8, cw);
      u32x4 raw[4][4];
#pragma unroll
      for (int i = 0; i < 4; ++i) { const int id = ht + 256 * i, s = id >> 4, d8 = id & 15; conv_load_x(P, b, c * 64 + s, UK + h * 128 + d8 * 8, raw[i]); }
#pragma unroll
      for (int i = 0; i < 4; ++i) { const int id = ht + 256 * i, s = id >> 4; conv_apply(cw, raw[i], c * 64 + s, kv[i]); } }
    __syncthreads();
#pragma unroll
    for (int i = 0; i < 4; ++i) {
        const int id = ht + 256 * i, s = id >> 4, d8 = id & 15;
        const float sc = wk[s] * 0.08838834764831845f;
#pragma unroll
        for (int e = 0; e < 8; ++e) kT[(d8 * 8 + e) * 72 + s] = (bf16_t)f2bf(kv[i][e] * sc);
    }
    __syncthreads();
    if (ht < 128) { float s = 0.f; for (int j = 0; j < 64; ++j) s += bf2f(kT[ht * 72 + j]); P.dn()[(size_t)ch * 128 + ht] = s; }
    bf16x8 af[2][2];
#pragma unroll
    for (int dt = 0; dt < 2; ++dt)
#pragma unroll
        for (int ks = 0; ks < 2; ++ks) af[dt][ks] = *(const LAS bf16x8*)(kT + (32 * hw + 16 * dt + l15) * 72 + 32 * ks + 8 * q4);
    const bf16_t* vbase = P.T() + (size_t)(TV + h * 256 + l15) * MTOK + tok0 + 8 * q4;
#pragma unroll 8
    for (int vt = 0; vt < 16; ++vt) {
        bf16x8 bfr[2];
#pragma unroll
        for (int ks = 0; ks < 2; ++ks) bfr[ks] = mk_frag(*(const u32x4*)(vbase + (size_t)(16 * vt) * MTOK + 32 * ks));
#pragma unroll
        for (int dt = 0; dt < 2; ++dt) {
            f32x4 acc = {0.f, 0.f, 0.f, 0.f};
#pragma unroll
            for (int ks = 0; ks < 2; ++ks) acc = MFMA16(af[dt][ks], bfr[ks], acc);
            u32x2 w; w.x = pk2(acc[0], acc[1]); w.y = pk2(acc[2], acc[3]);
            *(u32x2*)(P.dCt() + ((size_t)ch * 256 + 16 * vt + l15) * 128 + 32 * hw + 16 * dt + 4 * q4) = w;
        }
    }
    __syncthreads();
}

__device__ __forceinline__ void ml_step2(const Params& P, int bh, int part) {
    const int tid = opaque_tid(), lane = tid & 63; const size_t e4 = ((size_t)part * 512 + tid) * 4;
    const float bLl = P.cbL()[bh * 64 + lane], gml = P.cgmax()[bh * 64 + lane];
    float decl = 0.f, scl = 0.f, ml = 0.f;
    {
        float m = 0.f;
#pragma unroll
        for (int c = 0; c < 64; ++c) {
            const float bL = __builtin_bit_cast(float, __builtin_amdgcn_readlane(__builtin_bit_cast(int, bLl), c)), gm = __builtin_bit_cast(float, __builtin_amdgcn_readlane(__builtin_bit_cast(int, gml), c));
            const float mn = fmaxf(bL + m, bL + gm), dec = expf(bL + m - mn), sc = expf(bL + gm - mn);
            if (lane == c) { decl = dec; scl = sc; ml = m; }
            m = mn;
        }
    }
    if (part == 0 && tid < 64) P.cm()[bh * 64 + tid] = ml;
    const bool do_n = (part == 0 && tid < 128);
    f32x4 C = {0.f, 0.f, 0.f, 0.f}; float nn = 0.f;
    const bf16_t* __restrict__ dsrc = P.dCt() + (size_t)bh * 64 * 32768 + e4;
    bf16_t* __restrict__ cdst = P.Ct() + (size_t)bh * 64 * 32768 + e4;
    for (int c0 = 0; c0 < 64; c0 += 8) {
        u32x2 d[8]; float dnv[8];
#pragma unroll
        for (int i = 0; i < 8; ++i) { d[i] = *(const u32x2*)(dsrc + (size_t)(c0 + i) * 32768); dnv[i] = do_n ? P.dn()[(size_t)(bh * 64 + c0 + i) * 128 + tid] : 0.f; }
#pragma unroll
        for (int i = 0; i < 8; ++i) {
            const int c = c0 + i;
            { u32x2 w; w.x = pk2(C[0], C[1]); w.y = pk2(C[2], C[3]); *(u32x2*)(cdst + (size_t)c * 32768) = w; }
            if (do_n) P.nst()[(size_t)(bh * 64 + c) * 128 + tid] = nn;
            const float decc = __builtin_bit_cast(float, __builtin_amdgcn_readlane(__builtin_bit_cast(int, decl), c)), scc = __builtin_bit_cast(float, __builtin_amdgcn_readlane(__builtin_bit_cast(int, scl), c));
            C[0] = decc * C[0] + scc * bflo(d[i].x); C[1] = decc * C[1] + scc * bfhi(d[i].x); C[2] = decc * C[2] + scc * bflo(d[i].y); C[3] = decc * C[3] + scc * bfhi(d[i].y);
            nn = decc * nn + scc * dnv[i];
        }
    }
}

__device__ __forceinline__ void ml_step3(const Params& P, LAS unsigned char* lds_, int task) {
    LAS unsigned char* lds = opq(lds_);
    const int tid = opaque_tid(), lane = tid & 63, wave = tid >> 6, q4 = lane >> 4, l15 = lane & 15, half = wave >> 2, tq = wave & 3, ht = tid & 255;
    const int ch = 2 * task + half;
    const int bh = ch >> 6, c = ch & 63, b = bh >> 3, h = bh & 7, tok0 = b * SEQ + c * 64;
    LAS unsigned char* hl = lds + half * 36864;
    LAS bf16_t* qs = (LAS bf16_t*)hl;
    LAS bf16_t* ks_ = (LAS bf16_t*)(hl + 17408);
    LAS float* fb = (LAS float*)(hl + 34816);
    LAS float* fg = fb + 64;
    LAS float* fpm = fb + 128;
#pragma unroll
    for (int isk = 0; isk < 2; ++isk) {
        ConvW cw; conv_load_w(P, isk * 1024 + h * 128 + (ht & 15) * 8, cw);
        u32x4 raw[4][4];
#pragma unroll
        for (int i = 0; i < 4; ++i) { const int id = ht + 256 * i, s = id >> 4, d8 = id & 15; conv_load_x(P, b, c * 64 + s, (isk ? UK : UQ) + h * 128 + d8 * 8, raw[i]); }
#pragma unroll
        for (int i = 0; i < 4; ++i) { const int id = ht + 256 * i, s = id >> 4, d8 = id & 15;
            float o[8]; conv_apply(cw, raw[i], c * 64 + s, o);
            const float sc = isk ? 0.08838834764831845f : 1.f;
            u32x4 w; w.x = pk2(o[0] * sc, o[1] * sc); w.y = pk2(o[2] * sc, o[3] * sc); w.z = pk2(o[4] * sc, o[5] * sc); w.w = pk2(o[6] * sc, o[7] * sc);
            *(LAS u32x4*)((isk ? ks_ : qs) + s * 136 + d8 * 8) = w; }
    }
    if (tq == 0) {
        const float bc = P.mb()[(size_t)bh * SEQ + c * 64 + lane], g = P.mg()[(size_t)bh * SEQ + c * 64 + lane];
        float pm = g;
#pragma unroll
        for (int o = 1; o < 64; o <<= 1) { const float v = shfl_up_l(pm, o, lane); if (lane >= o) pm = fmaxf(pm, v); }
        fb[lane] = bc; fg[lane] = g; fpm[lane] = pm;
    }
    const float m_c = P.cm()[ch];
    const int t = 16 * tq + l15;
    const size_t tok = (size_t)(tok0 + t);
    __syncthreads();
    u32x4 cst[4], vst[2];
#define ML3_LOAD(B) do { \
        _Pragma("unroll") for (int i = 0; i < 4; ++i) { const int id = ht + 256 * i; cst[i] = *(const u32x4*)(P.Ct() + ((size_t)ch * 256 + 64 * (B) + (id >> 4)) * 128 + 8 * (id & 15)); } \
        _Pragma("unroll") for (int i = 0; i < 2; ++i) { const int id = ht + 256 * i; vst[i] = *(const u32x4*)(P.T() + (size_t)(TV + h * 256 + 64 * (B) + (id >> 3)) * MTOK + tok0 + 8 * (id & 7)); } } while (0)
#define ML3_SB(BUF) ((BUF) ? hl : lds + 73728 + half * 28672)
#define ML3_WRITE(BUF) do { LAS bf16_t* cts_ = (LAS bf16_t*)ML3_SB(BUF); LAS bf16_t* vts_ = (LAS bf16_t*)(ML3_SB(BUF) + 17408); \
        _Pragma("unroll") for (int i = 0; i < 4; ++i) { const int id = ht + 256 * i; *(LAS u32x4*)(cts_ + (id >> 4) * 136 + 8 * (id & 15)) = cst[i]; } \
        _Pragma("unroll") for (int i = 0; i < 2; ++i) { const int id = ht + 256 * i; *(LAS u32x4*)(vts_ + (id >> 3) * 72 + 8 * (id & 7)) = vst[i]; } } while (0)
    ML3_LOAD(0);
    bf16x8 qf[4];
#pragma unroll
    for (int ks = 0; ks < 4; ++ks) qf[ks] = *(const LAS bf16x8*)(qs + t * 136 + 32 * ks + 8 * q4);
    const float Mt = fmaxf(m_c, fpm[t]);
    float sc[4][4]; float rowsum = 0.f;
#pragma unroll
    for (int st = 0; st < 4; ++st) {
        f32x4 a = {0.f, 0.f, 0.f, 0.f};
#pragma unroll
        for (int ks = 0; ks < 4; ++ks) { const bf16x8 kf = *(const LAS bf16x8*)(ks_ + (16 * st + l15) * 136 + 32 * ks + 8 * q4); a = MFMA16(kf, qf[ks], a); }
#pragma unroll
        for (int r = 0; r < 4; ++r) { const int s = 16 * st + 4 * q4 + r; const float v = (s <= t) ? a[r] * __expf(fg[s] - Mt) : 0.f; sc[st][r] = v; rowsum += v; }
    }
    rowsum = xq_sum(rowsum);
    bf16x8 pf[2];
#pragma unroll
    for (int k2 = 0; k2 < 2; ++k2) { u32x4 w; w.x = pk2(sc[2 * k2][0], sc[2 * k2][1]); w.y = pk2(sc[2 * k2][2], sc[2 * k2][3]); w.z = pk2(sc[2 * k2 + 1][0], sc[2 * k2 + 1][1]); w.w = pk2(sc[2 * k2 + 1][2], sc[2 * k2 + 1][3]); pf[k2] = mk_frag(w); }
    float qn = 0.f;
    { const float* np = P.nst() + (size_t)ch * 128;
#pragma unroll
      for (int ks = 0; ks < 4; ++ks) { const f32x4 n0 = *(const f32x4*)(np + 32 * ks + 8 * q4), n1 = *(const f32x4*)(np + 32 * ks + 8 * q4 + 4);
          const u32x4 qw = __builtin_bit_cast(u32x4, qf[ks]);
          qn += bflo(qw.x) * n0[0] + bfhi(qw.x) * n0[1] + bflo(qw.y) * n0[2] + bfhi(qw.y) * n0[3] + bflo(qw.z) * n1[0] + bfhi(qw.z) * n1[1] + bflo(qw.w) * n1[2] + bfhi(qw.w) * n1[3]; }
      qn = xq_sum(qn); }
    const float inter = __expf(m_c - Mt);
    const float den = inter * qn + rowsum;
    const float inv = 1.f / fmaxf(fabsf(den), __expf(-(fb[t] + Mt)));
    f32x4 hv[16]; float ss = 0.f;
    __syncthreads();
#pragma unroll
    for (int vb = 0; vb < 4; ++vb) {
        ML3_WRITE(vb & 1);
        if (vb < 3) ML3_LOAD(vb + 1);
        __syncthreads();
        const LAS bf16_t* cts = (const LAS bf16_t*)ML3_SB(vb & 1) + l15 * 136 + 8 * q4;
        const LAS bf16_t* vts = (const LAS bf16_t*)(ML3_SB(vb & 1) + 17408) + l15 * 72 + 4 * q4;
#pragma unroll
        for (int v = 0; v < 4; ++v) { const int vt = 4 * vb + v;
            f32x4 a1 = {0.f, 0.f, 0.f, 0.f}, a2 = {0.f, 0.f, 0.f, 0.f};
#pragma unroll
            for (int ks = 0; ks < 4; ++ks) a1 = MFMA16(*(const LAS bf16x8*)(cts + (16 * v) * 136 + 32 * ks), qf[ks], a1);
#pragma unroll
            for (int k2 = 0; k2 < 2; ++k2) { const LAS bf16_t* vp = vts + (16 * v) * 72 + 32 * k2; a2 = MFMA16(mk_frag2(*(const LAS u32x2*)vp, *(const LAS u32x2*)(vp + 16)), pf[k2], a2); }
#pragma unroll
            for (int r = 0; r < 4; ++r) { const float hh = (inter * a1[r] + a2[r]) * inv; hv[vt][r] = hh; ss += hh * hh; } }
    }
#undef ML3_LOAD
#undef ML3_SB
#undef ML3_WRITE
    ss = xq_sum(ss);
    const float rstd = __builtin_amdgcn_rsqf(ss * (1.f / 256.f) + EPS);
    {
        u32x2 owv[16], zwv[16]; f32x4 nwv[16];
#pragma unroll
        for (int vt = 0; vt < 16; ++vt) { const int v = 16 * vt + 4 * q4;
            owv[vt] = *(const u32x2*)(P.U() + tok * UW + UO + h * 256 + v); zwv[vt] = *(const u32x2*)(P.U() + tok * UW + UZ + h * 256 + v); nwv[vt] = *(const f32x4*)(P.hnorm_w + h * 256 + v); }
        __builtin_amdgcn_sched_barrier(0);
#pragma unroll
        for (int vt = 0; vt < 16; ++vt) {
            const int v = 16 * vt + 4 * q4;
            const u32x2 ow = owv[vt], zw = zwv[vt]; const f32x4 nw = nwv[vt];
            const float o0 = bflo(ow.x), o1 = bfhi(ow.x), o2 = bflo(ow.y), o3 = bfhi(ow.y), z0 = bflo(zw.x), z1 = bfhi(zw.x), z2 = bflo(zw.y), z3 = bfhi(zw.y);
            const float y0 = hv[vt][0] * rstd * nw[0] * sigmoidf_(o0) * siluf_(z0), y1 = hv[vt][1] * rstd * nw[1] * sigmoidf_(o1) * siluf_(z1);
            const float y2 = hv[vt][2] * rstd * nw[2] * sigmoidf_(o2) * siluf_(z2), y3 = hv[vt][3] * rstd * nw[3] * sigmoidf_(o3) * siluf_(z3);
            u32x2 w; w.x = pk2(y0, y1); w.y = pk2(y2, y3);
            *(u32x2*)(P.y() + tok * DM + h * 256 + v) = w;
        }
    }
    __syncthreads();
}

constexpr float LOG2E = 1.4426950408889634f;
__device__ __forceinline__ void cmp_gemm_task(const Params& P, LAS unsigned char* lds, int unit) {
    pg8::SchedC S; S.U = (const char*)P.U(); S.w1k = (const char*)P.w1kT(); S.w1v = (const char*)P.w1vT(); S.ukc = UKC; S.uvc = UVC; S.unit = unit;
    EpiZ E{P.Z()};
    pg8::gemm_cmp<EpiZ>(lds, S, E);
    __syncthreads();
}
__device__ __forceinline__ void cmp_task(const Params& P, LAS unsigned char* lds_, int task) {
    LAS unsigned char* lds = opq(lds_);
    const int tid = opaque_tid(), lane = tid & 63, wave = tid >> 6, q4 = lane >> 4, l15 = lane & 15;
    const int kv = task & 1, bg = (task >> 1) & 7, it = task >> 4;
    LAS float* cs = (LAS float*)lds;
    LAS bf16_t* H1 = (LAS bf16_t*)(lds + 16384);
    LAS float* O2 = (LAS float*)(lds + 33280);
    const bf16_t* w2T = kv ? P.w2vT() : P.w2kT();
    if (tid < 256) { const float* cp = P.cpart() + (size_t)kv * 64 * 256 + tid; float s = 0.f;
#pragma unroll 16
        for (int kb = 0; kb < 64; ++kb) s += cp[kb * 256];
        cs[tid] = s; }
    __syncthreads();
    { const int m = tid >> 4, n0 = (tid & 15) * 16, i = 32 * it + m, i1 = i + 1 > 255 ? 255 : i + 1;
      const float* z0 = P.Z() + ((size_t)(kv * 8 + bg) * 256 + i) * 512 + n0; const float* z1 = P.Z() + ((size_t)(kv * 8 + bg) * 256 + i1) * 512 + 256 + n0;
#pragma unroll
      for (int j = 0; j < 4; ++j) { const f32x4 a = *(const f32x4*)(z0 + 4 * j), b = *(const f32x4*)(z1 + 4 * j), c = *(const LAS f32x4*)(cs + n0 + 4 * j);
          u32x2 w; w.x = pk2(siluf_(a[0] + b[0] + c[0]), siluf_(a[1] + b[1] + c[1])); w.y = pk2(siluf_(a[2] + b[2] + c[2]), siluf_(a[3] + b[3] + c[3]));
          *(LAS u32x2*)(H1 + m * 264 + n0 + 4 * j) = w; } }
    __syncthreads();
    {
        f32x4 a2[2] = {(f32x4){0.f, 0.f, 0.f, 0.f}, (f32x4){0.f, 0.f, 0.f, 0.f}};
#pragma unroll
        for (int ks = 0; ks < 8; ++ks) {
            const bf16x8 af = mk_frag(*(const u32x4*)(w2T + (size_t)(16 * wave + l15) * 256 + 32 * ks + 8 * q4));
#pragma unroll
            for (int mt = 0; mt < 2; ++mt) { const bf16x8 bf = *(const LAS bf16x8*)(H1 + (16 * mt + l15) * 264 + 32 * ks + 8 * q4); a2[mt] = MFMA16(af, bf, a2[mt]); }
        }
#pragma unroll
        for (int mt = 0; mt < 2; ++mt) *(LAS f32x4*)(O2 + (16 * mt + l15) * 132 + 16 * wave + 4 * q4) = a2[mt];
    }
    __syncthreads();
    if (kv == 0) {
        const int m = 4 * wave + q4, i = 32 * it + m;
        const LAS float* op = O2 + m * 132 + 8 * l15; float v[8]; float ss = 0.f;
#pragma unroll
        for (int e = 0; e < 8; ++e) { v[e] = op[e]; ss += v[e] * v[e]; }
        ss += __shfl_xor(ss, 1); ss += __shfl_xor(ss, 2); ss += __shfl_xor(ss, 4); ss += __shfl_xor(ss, 8);
        const float rstd = (i == 255) ? 0.f : __builtin_amdgcn_rsqf(ss * (1.f / 128.f) + EPS);
        const f32x4 w0 = *(const f32x4*)(P.knorm_w + 8 * l15), w1 = *(const f32x4*)(P.knorm_w + 8 * l15 + 4);
        u32x4 w; w.x = pk2(v[0] * rstd * w0[0], v[1] * rstd * w0[1]); w.y = pk2(v[2] * rstd * w0[2], v[3] * rstd * w0[3]);
        w.z = pk2(v[4] * rstd * w1[0], v[5] * rstd * w1[1]); w.w = pk2(v[6] * rstd * w1[2], v[7] * rstd * w1[3]);
        *(u32x4*)(P.kcmp() + ((size_t)bg * 256 + i) * 128 + 8 * l15) = w;
    } else {
        const int d = tid >> 2, ms = (tid & 3) * 8; float v[8];
#pragma unroll
        for (int e = 0; e < 8; ++e) v[e] = (32 * it + ms + e == 255) ? 0.f : O2[(ms + e) * 132 + d];
        u32x4 w; w.x = pk2(v[0], v[1]); w.y = pk2(v[2], v[3]); w.z = pk2(v[4], v[5]); w.w = pk2(v[6], v[7]);
        *(u32x4*)(P.vcmpT() + ((size_t)bg * 128 + d) * 256 + 32 * it + ms) = w;
    }
    __syncthreads();
}

__device__ __forceinline__ void ksnorm_task(const Params& P, int task) {
    const int tid = opaque_tid(), l16 = tid & 15, r0 = tid >> 4;
    const f32x4 w0 = *(const f32x4*)(P.knorm_w + 128 + 8 * l16), w1 = *(const f32x4*)(P.knorm_w + 128 + 8 * l16 + 4);
#pragma unroll 4
    for (int p = 0; p < 16; ++p) {
        const int row = 32 * p + r0, tok = 128 * task + (row >> 2), g = row & 3;
        bf16_t* ptr = P.U() + (size_t)tok * UW + UKS + g * 128 + 8 * l16;
        const u32x4 raw = *(const u32x4*)ptr;
        float v[8] = {bflo(raw.x), bfhi(raw.x), bflo(raw.y), bfhi(raw.y), bflo(raw.z), bfhi(raw.z), bflo(raw.w), bfhi(raw.w)};
        float ss = 0.f;
#pragma unroll
        for (int e = 0; e < 8; ++e) ss += v[e] * v[e];
        ss = row16_sum(ss);
        const float rstd = __builtin_amdgcn_rsqf(ss * (1.f / 128.f) + EPS);
        u32x4 o; o.x = pk2(v[0] * rstd * w0[0], v[1] * rstd * w0[1]); o.y = pk2(v[2] * rstd * w0[2], v[3] * rstd * w0[3]);
        o.z = pk2(v[4] * rstd * w1[0], v[5] * rstd * w1[1]); o.w = pk2(v[6] * rstd * w1[2], v[7] * rstd * w1[3]);
        *(u32x4*)ptr = o;
    }
}

__device__ __forceinline__ int rel_bucket(int n) {
    if (n < 16) return n;
    int v = 16 + (int)(logf((float)n * (1.f / 16.f)) / 2.0794415416798357f * 16.f);
    return v > 31 ? 31 : v;
}

__device__ __forceinline__ unsigned cvtpk(float lo, float hi) { return pk2(lo, hi); }
template <int MODE>
__device__ __forceinline__ void attn_task(const Params& P, LAS unsigned char* lds_, int bg, int qb) {
    LAS unsigned char* lds = opq(lds_);
    const int tid = opaque_tid(), lane = tid & 63, wave = tid >> 6, q4 = lane >> 4, l15 = lane & 15;
    const int b = bg >> 2, g = bg & 3, hd = wave >> 1, qhalf = wave & 1, head = g * 4 + hd;
    LAS float* tab = (LAS float*)(lds + 35840);
    LAS float* imps = (LAS float*)(lds + 38912);
    LAS unsigned* um = (LAS unsigned*)(lds + 104448);
    for (int i = tid; i < 4 * 129; i += 512) { const int hh = i / 129, dd = i % 129; tab[hh * 132 + dd] = P.rel_bias[rel_bucket(dd) * 16 + g * 4 + hh] * LOG2E; }
    bf16x8 qf[2][4];
#pragma unroll
    for (int qt = 0; qt < 2; ++qt) {
        const size_t tok = (size_t)b * SEQ + 64 * qb + 32 * qhalf + 16 * qt + l15;
        u32x4 raw[4]; float ss = 0.f;
#pragma unroll
        for (int ks = 0; ks < 4; ++ks) { raw[ks] = *(const u32x4*)(P.U() + tok * UW + UNQ + head * 128 + 32 * ks + 8 * q4);
            const float a0 = bflo(raw[ks].x), a1 = bfhi(raw[ks].x), a2 = bflo(raw[ks].y), a3 = bfhi(raw[ks].y), a4 = bflo(raw[ks].z), a5 = bfhi(raw[ks].z), a6 = bflo(raw[ks].w), a7 = bfhi(raw[ks].w);
            ss += a0 * a0 + a1 * a1 + a2 * a2 + a3 * a3 + a4 * a4 + a5 * a5 + a6 * a6 + a7 * a7; }
        ss = xq_sum(ss);
        const float sc = __builtin_amdgcn_rsqf(ss * (1.f / 128.f) + EPS) * (0.08838834764831845f * LOG2E);
#pragma unroll
        for (int ks = 0; ks < 4; ++ks) { const f32x4 w0 = *(const f32x4*)(P.qnorm_w + 32 * ks + 8 * q4), w1 = *(const f32x4*)(P.qnorm_w + 32 * ks + 8 * q4 + 4);
            u32x4 w; w.x = cvtpk(bflo(raw[ks].x) * sc * w0[0], bfhi(raw[ks].x) * sc * w0[1]); w.y = cvtpk(bflo(raw[ks].y) * sc * w0[2], bfhi(raw[ks].y) * sc * w0[3]);
            w.z = cvtpk(bflo(raw[ks].z) * sc * w1[0], bfhi(raw[ks].z) * sc * w1[1]); w.w = cvtpk(bflo(raw[ks].w) * sc * w1[2], bfhi(raw[ks].w) * sc * w1[3]);
            qf[qt][ks] = mk_frag(w); }
    }
    unsigned long long smask[2] = {0ull, 0ull};
    if (MODE == 2) {
#pragma unroll
        for (int qt = 0; qt < 2; ++qt) smask[qt] = P.sel()[(size_t)bg * SEQ + 64 * qb + 32 * qhalf + 16 * qt + l15];
    }
    f32x4 ao[8][2]; f32x4 ai[4][2];
#pragma unroll
    for (int dt = 0; dt < 8; ++dt) { ao[dt][0] = (f32x4){0.f, 0.f, 0.f, 0.f}; ao[dt][1] = (f32x4){0.f, 0.f, 0.f, 0.f}; }
#pragma unroll
    for (int nt = 0; nt < 4; ++nt) { ai[nt][0] = (f32x4){0.f, 0.f, 0.f, 0.f}; ai[nt][1] = (f32x4){0.f, 0.f, 0.f, 0.f}; }
    float mrun[2] = {-1e30f, -1e30f}, lsum[2] = {0.f, 0.f};
    unsigned long long rem;
    if (MODE == 0) { const int jl = qb - 8 < 0 ? 0 : qb - 8; rem = ((2ull << qb) - 1ull) & ~((1ull << jl) - 1ull); }
    else if (MODE == 1) { rem = (2ull << ((4 * qb + 2) >> 6)) - 1ull; }
    else { rem = P.selu()[bg * 64 + qb] & ((2ull << qb) - 1ull); }
    const int krow = tid >> 4, kc16 = tid & 15, vrow = tid >> 3, vc8 = tid & 7;
    const bf16_t* kbase = (MODE == 1) ? P.kcmp() + ((size_t)bg * 256 + krow) * 128 + 8 * kc16 : P.U() + ((size_t)b * SEQ + krow) * UW + (MODE == 0 ? UKW : UKS) + g * 128 + 8 * kc16;
    const size_t kstride = (MODE == 1) ? (size_t)32 * 128 : (size_t)32 * UW;
    const bf16_t* vbase = (MODE == 1) ? P.vcmpT() + ((size_t)bg * 128 + vrow) * 256 + 8 * vc8 : P.T() + (size_t)((MODE == 0 ? TVW : TVS) + g * 128 + vrow) * MTOK + (size_t)b * SEQ + 8 * vc8;
    const size_t vstride = (MODE == 1) ? (size_t)64 * 256 : (size_t)64 * MTOK;
    const size_t ktile = (MODE == 1) ? (size_t)64 * 128 : (size_t)64 * UW;
    f32x4 kw0 = {1.f, 1.f, 1.f, 1.f}, kw1 = {1.f, 1.f, 1.f, 1.f};
    if (MODE == 0) { const float* kw = P.knorm_w + 256 + 8 * kc16; kw0 = *(const f32x4*)kw; kw1 = *(const f32x4*)(kw + 4); }
    u32x4 kr[2], vr[2];
#define AT_LOAD(J) do { _Pragma("unroll") for (int _i = 0; _i < 2; ++_i) { kr[_i] = *(const u32x4*)(kbase + (size_t)(J) * ktile + _i * kstride); vr[_i] = *(const u32x4*)(vbase + (size_t)(J) * 64 + _i * vstride); } } while (0)
    int j = __builtin_ctzll(rem); rem &= rem - 1ull;
    AT_LOAD(j);
    int buf = 0;
    for (;;) {
        LAS bf16_t* Ks = (LAS bf16_t*)(lds + buf * 38912);
        LAS bf16_t* Vs = (LAS bf16_t*)(lds + buf * 38912 + 17408);
#pragma unroll
        for (int i = 0; i < 2; ++i) {
            u32x4 raw = kr[i];
            if (MODE == 0) {
                float v[8] = {bflo(raw.x), bfhi(raw.x), bflo(raw.y), bfhi(raw.y), bflo(raw.z), bfhi(raw.z), bflo(raw.w), bfhi(raw.w)};
                float ss = 0.f;
#pragma unroll
                for (int e = 0; e < 8; ++e) ss += v[e] * v[e];
                ss = row16_sum(ss);
                const float rstd = __builtin_amdgcn_rsqf(ss * (1.f / 128.f) + EPS);
                raw.x = cvtpk(v[0] * rstd * kw0[0], v[1] * rstd * kw0[1]); raw.y = cvtpk(v[2] * rstd * kw0[2], v[3] * rstd * kw0[3]);
                raw.z = cvtpk(v[4] * rstd * kw1[0], v[5] * rstd * kw1[1]); raw.w = cvtpk(v[6] * rstd * kw1[2], v[7] * rstd * kw1[3]);
            }
            *(LAS u32x4*)(Ks + (krow + 32 * i) * 136 + 8 * kc16) = raw;
            *(LAS u32x4*)(Vs + (vrow + 64 * i) * 72 + 8 * vc8) = vr[i];
        }
        __syncthreads();
        const bool more = rem != 0ull; int jn = j;
        if (more) { jn = __builtin_ctzll(rem); rem &= rem - 1ull; if (MODE != 1) AT_LOAD(jn); }
        f32x4 s[4][2];
        {
            const LAS bf16_t* kp = Ks + l15 * 136 + 8 * q4;
            bf16x8 ka[4], kb[4];
#define AT_LDK(dst, kt) do { _Pragma("unroll") for (int ks = 0; ks < 4; ++ks) dst[ks] = *(const LAS bf16x8*)(kp + (16 * (kt)) * 136 + 32 * ks); } while (0)
#define AT_MMS(src, kt) do { s[kt][0] = (f32x4){0.f, 0.f, 0.f, 0.f}; s[kt][1] = (f32x4){0.f, 0.f, 0.f, 0.f}; \
            _Pragma("unroll") for (int ks = 0; ks < 4; ++ks) { s[kt][0] = MFMA16(src[ks], qf[0][ks], s[kt][0]); s[kt][1] = MFMA16(src[ks], qf[1][ks], s[kt][1]); } } while (0)
            AT_LDK(ka, 0); AT_LDK(kb, 1); __builtin_amdgcn_sched_barrier(0);
            AT_MMS(ka, 0); __builtin_amdgcn_sched_barrier(0);
            AT_LDK(ka, 2); __builtin_amdgcn_sched_barrier(0);
            AT_MMS(kb, 1); __builtin_amdgcn_sched_barrier(0);
            AT_LDK(kb, 3); __builtin_amdgcn_sched_barrier(0);
            AT_MMS(ka, 2); __builtin_amdgcn_sched_barrier(0);
            AT_MMS(kb, 3); __builtin_amdgcn_sched_barrier(0);
#undef AT_LDK
#undef AT_MMS
        }
        const bool plain = (MODE == 0) ? (qb - j >= 3 && qb - j <= 7) : (MODE == 2 ? (qb - j >= 3) : false);
        const float cbias = tab[hd * 132 + 128];
        bf16x8 pf[2][2];
#pragma unroll
        for (int qt = 0; qt < 2; ++qt) {
            const int tl = 32 * qhalf + 16 * qt + l15;
            const bool selok = (MODE == 2) ? (((smask[qt] >> j) & 1ull) != 0ull) : true;
            float mx = -INFINITY;
            if (plain) {
                const float cb = selok ? cbias : -INFINITY;
#pragma unroll
                for (int kt = 0; kt < 4; ++kt)
#pragma unroll
                    for (int r = 0; r < 4; ++r) { const float v = s[kt][qt][r] + cb; s[kt][qt][r] = v; mx = fmaxf(mx, v); }
            } else if (MODE == 0) {
#pragma unroll
                for (int kt = 0; kt < 4; ++kt) {
                    float tb[4];
#pragma unroll
                    for (int r = 0; r < 4; ++r) {
                        const int dist = 64 * (qb - j) + tl - (16 * kt + 4 * q4 + r);
                        const int di = dist < 0 ? 0 : (dist > 128 ? 128 : dist);
                        tb[r] = tab[hd * 132 + di];
                    }
                    asm volatile("" : "+v"(tb[0]), "+v"(tb[1]), "+v"(tb[2]), "+v"(tb[3]));
#pragma unroll
                    for (int r = 0; r < 4; ++r) {
                        const int dist = 64 * (qb - j) + tl - (16 * kt + 4 * q4 + r);
                        const bool ok = dist >= 0 && dist < 512;
                        const float v = ok ? s[kt][qt][r] + tb[r] : -INFINITY;
                        s[kt][qt][r] = v; mx = fmaxf(mx, v);
                    }
                }
            } else {
#pragma unroll
                for (int kt = 0; kt < 4; ++kt)
#pragma unroll
                    for (int r = 0; r < 4; ++r) {
                        const int kl = 16 * kt + 4 * q4 + r;
                        int dist; bool ok;
                        if (MODE == 1) { dist = 64 * qb + tl - (16 * (64 * j + kl) + 31); ok = dist >= 0; }
                        else { dist = 64 * (qb - j) + tl - kl; ok = dist >= 0 && selok; if (MODE == 0) ok = ok && dist < 512; }
                        const int di = dist < 0 ? 0 : (dist > 128 ? 128 : dist);
                        const float v = ok ? s[kt][qt][r] + tab[hd * 132 + di] : -INFINITY;
                        s[kt][qt][r] = v; mx = fmaxf(mx, v);
                    }
            }
            mx = xq_max(mx);
            const float mn = fmaxf(mrun[qt], mx), alpha = __builtin_amdgcn_exp2f(mrun[qt] - mn); mrun[qt] = mn;
            float ps = 0.f;
#pragma unroll
            for (int kt = 0; kt < 4; ++kt)
#pragma unroll
                for (int r = 0; r < 4; ++r) { const float p = __builtin_amdgcn_exp2f(s[kt][qt][r] - mn); s[kt][qt][r] = p; ps += p; }
            lsum[qt] = lsum[qt] * alpha + ps;
            if (__ballot(alpha != 1.f) != 0ull) {
#pragma unroll
                for (int dt = 0; dt < 8; ++dt) ao[dt][qt] = ao[dt][qt] * alpha;
                if (MODE == 1) {
#pragma unroll
                    for (int nt = 0; nt < 4; ++nt) ai[nt][qt] = ai[nt][qt] * alpha;
                }
            }
#pragma unroll
            for (int k2 = 0; k2 < 2; ++k2) { u32x4 w; w.x = cvtpk(s[2 * k2][qt][0], s[2 * k2][qt][1]); w.y = cvtpk(s[2 * k2][qt][2], s[2 * k2][qt][3]);
                w.z = cvtpk(s[2 * k2 + 1][qt][0], s[2 * k2 + 1][qt][1]); w.w = cvtpk(s[2 * k2 + 1][qt][2], s[2 * k2 + 1][qt][3]); pf[qt][k2] = mk_frag(w); }
        }
        {
            const LAS bf16_t* vp0 = Vs + l15 * 72 + 4 * q4;
            bf16x8 va[2], vb[2];
#define AT_LDV(dst, dt) do { _Pragma("unroll") for (int k2 = 0; k2 < 2; ++k2) { const LAS bf16_t* vp = vp0 + (16 * (dt)) * 72 + 32 * k2; dst[k2] = mk_frag2(*(const LAS u32x2*)vp, *(const LAS u32x2*)(vp + 16)); } } while (0)
#define AT_MMO(src, dt) do { _Pragma("unroll") for (int k2 = 0; k2 < 2; ++k2) { ao[dt][0] = MFMA16(src[k2], pf[0][k2], ao[dt][0]); ao[dt][1] = MFMA16(src[k2], pf[1][k2], ao[dt][1]); } } while (0)
            AT_LDV(va, 0); AT_LDV(vb, 1); __builtin_amdgcn_sched_barrier(0);
            AT_MMO(va, 0); __builtin_amdgcn_sched_barrier(0); AT_LDV(va, 2); __builtin_amdgcn_sched_barrier(0);
            AT_MMO(vb, 1); __builtin_amdgcn_sched_barrier(0); AT_LDV(vb, 3); __builtin_amdgcn_sched_barrier(0);
            AT_MMO(va, 2); __builtin_amdgcn_sched_barrier(0); AT_LDV(va, 4); __builtin_amdgcn_sched_barrier(0);
            AT_MMO(vb, 3); __builtin_amdgcn_sched_barrier(0); AT_LDV(vb, 5); __builtin_amdgcn_sched_barrier(0);
            AT_MMO(va, 4); __builtin_amdgcn_sched_barrier(0); AT_LDV(va, 6); __builtin_amdgcn_sched_barrier(0);
            AT_MMO(vb, 5); __builtin_amdgcn_sched_barrier(0); AT_LDV(vb, 7); __builtin_amdgcn_sched_barrier(0);
            AT_MMO(va, 6); __builtin_amdgcn_sched_barrier(0);
            AT_MMO(vb, 7); __builtin_amdgcn_sched_barrier(0);
#undef AT_LDV
#undef AT_MMO
        }
        if (MODE == 1) {
#pragma unroll
            for (int nt = 0; nt < 4; ++nt)
#pragma unroll
                for (int k2 = 0; k2 < 2; ++k2) {
                    const int n = 16 * nt + l15, cb = 64 * j + 32 * k2 + 4 * q4;
                    unsigned e[8];
#pragma unroll
                    for (int jj = 0; jj < 8; ++jj) { const int c = cb + (jj < 4 ? jj : 12 + jj); e[jj] = (c >= 4 * n - 1 && c <= 4 * n + 3) ? 0x3F80u : 0u; }
                    u32x4 w; w.x = e[0] | (e[1] << 16); w.y = e[2] | (e[3] << 16); w.z = e[4] | (e[5] << 16); w.w = e[6] | (e[7] << 16);
                    const bf16x8 of = mk_frag(w);
                    ai[nt][0] = MFMA16(of, pf[0][k2], ai[nt][0]); ai[nt][1] = MFMA16(of, pf[1][k2], ai[nt][1]);
                }
        }
        if (!more) break;
        if (MODE == 1) { __syncthreads(); AT_LOAD(jn); }
        else buf ^= 1;
        j = jn;
    }
#undef AT_LOAD
    float inv[2];
#pragma unroll
    for (int qt = 0; qt < 2; ++qt) { const float l = xq_sum(lsum[qt]); inv[qt] = l > 0.f ? 1.f / l : 0.f; }
    if (MODE == 0 || MODE == 1) {
        bf16_t* ob = (MODE == 0) ? P.ow() : P.oc();
#pragma unroll
        for (int qt = 0; qt < 2; ++qt) { const size_t tok = (size_t)b * SEQ + 64 * qb + 32 * qhalf + 16 * qt + l15;
#pragma unroll
            for (int dt = 0; dt < 8; ++dt) { const f32x4 o = ao[dt][qt] * inv[qt]; u32x2 w; w.x = cvtpk(o[0], o[1]); w.y = cvtpk(o[2], o[3]);
                *(u32x2*)(ob + tok * 2048 + head * 128 + 16 * dt + 4 * q4) = w; } }
    }
    if (MODE == 1) {
        __syncthreads();
#pragma unroll
        for (int qt = 0; qt < 2; ++qt)
#pragma unroll
            for (int nt = 0; nt < 4; ++nt) *(LAS f32x4*)(imps + (hd * 64 + 32 * qhalf + 16 * qt + l15) * 64 + 16 * nt + 4 * q4) = ai[nt][qt] * inv[qt];
        __syncthreads();
        unsigned long long uni = 0ull;
        for (int qq = 0; qq < 8; ++qq) {
            const int tl = 8 * wave + qq;
            float v = imps[(0 * 64 + tl) * 64 + lane] + imps[(1 * 64 + tl) * 64 + lane] + imps[(2 * 64 + tl) * 64 + lane] + imps[(3 * 64 + tl) * 64 + lane];
            if (lane == 0 || lane == qb || lane == qb - 1) v = 1e4f;
            if (lane > qb) v = -1e30f;
            int rank = 0;
#pragma unroll
            for (int jn2 = 0; jn2 < 64; ++jn2) { const float vj = __builtin_bit_cast(float, __builtin_amdgcn_readlane(__builtin_bit_cast(int, v), jn2)); rank += (vj > v || (vj == v && jn2 < lane)) ? 1 : 0; }
            unsigned long long mk = __ballot(rank < 16 && lane <= qb);
            uni |= mk;
            if (lane == 0) P.sel()[(size_t)bg * SEQ + 64 * qb + tl] = mk;
        }
        if (lane == 0) { um[2 * wave] = (unsigned)uni; um[2 * wave + 1] = (unsigned)(uni >> 32); }
        __syncthreads();
        if (tid == 0) { unsigned lo = 0u, hi = 0u; for (int w = 0; w < 8; ++w) { lo |= um[2 * w]; hi |= um[2 * w + 1]; } P.selu()[bg * 64 + qb] = ((unsigned long long)hi << 32) | lo; }
    }
    if (MODE == 2) {
#pragma unroll
        for (int qt = 0; qt < 2; ++qt) { const size_t tok = (size_t)b * SEQ + 64 * qb + 32 * qhalf + 16 * qt + l15;
            const float* gp = P.small() + tok * 64 + 16 + head * 3;
            const float g0 = sigmoidf_(gp[0]), g1 = sigmoidf_(gp[1]), g2 = sigmoidf_(gp[2]);
#pragma unroll
            for (int dt = 0; dt < 8; ++dt) { const int col = head * 128 + 16 * dt + 4 * q4;
                const u32x2 cw = *(const u32x2*)(P.oc() + tok * 2048 + col), ww = *(const u32x2*)(P.ow() + tok * 2048 + col), zw = *(const u32x2*)(P.U() + tok * UW + UNZ + col);
                const f32x4 o = ao[dt][qt] * inv[qt];
                const float y0 = (g0 * bflo(cw.x) + g1 * o[0] + g2 * bflo(ww.x)) * siluf_(bflo(zw.x)), y1 = (g0 * bfhi(cw.x) + g1 * o[1] + g2 * bfhi(ww.x)) * siluf_(bfhi(zw.x));
                const float y2 = (g0 * bflo(cw.y) + g1 * o[2] + g2 * bflo(ww.y)) * siluf_(bflo(zw.y)), y3 = (g0 * bfhi(cw.y) + g1 * o[3] + g2 * bfhi(ww.y)) * siluf_(bfhi(zw.y));
                u32x2 w; w.x = cvtpk(y0, y1); w.y = cvtpk(y2, y3);
                *(u32x2*)(P.y() + tok * DM + 2048 + col) = w; } }
    }
    __syncthreads();
}

typedef float f32x16 __attribute__((ext_vector_type(16)));
#define MFMA32(a, b, c) __builtin_amdgcn_mfma_f32_32x32x16_bf16((a), (b), (c), 0, 0, 0)
__device__ __forceinline__ float half_swap_max(float v) { float a = v, b = v; swap32(a, b); return fmaxf(a, b); }
__device__ __forceinline__ float half_swap_sum(float v) { float a = v, b = v; swap32(a, b); return a + b; }
template <int MODE>
__device__ __forceinline__ void attn_fast(const Params& P, LAS unsigned char* lds_, int bg, int qb) {
    LAS unsigned char* lds = opq(lds_);
    const int tid = opaque_tid(), lane = tid & 63, wave = tid >> 6, r32 = lane & 31, hi = lane >> 5;
    const int b = bg >> 2, g = bg & 3, hd = wave >> 1, qhalf = wave & 1, head = g * 4 + hd, tl = 32 * qhalf + r32;
    constexpr int BUFB = 35840;
    LAS float* tab = (LAS float*)(lds + 3 * BUFB);
    for (int i = tid; i < 4 * 129; i += 512) { const int hh = i / 129, dd = i % 129; tab[hh * 132 + dd] = P.rel_bias[rel_bucket(dd) * 16 + g * 4 + hh] * LOG2E; }
    bf16x8 qf[8];
    {
        const size_t tok = (size_t)b * SEQ + 64 * qb + tl;
        u32x4 raw[8]; float ss = 0.f;
#pragma unroll
        for (int ks = 0; ks < 8; ++ks) { raw[ks] = *(const u32x4*)(P.U() + tok * UW + UNQ + head * 128 + 16 * ks + 8 * hi);
            const float a0 = bflo(raw[ks].x), a1 = bfhi(raw[ks].x), a2 = bflo(raw[ks].y), a3 = bfhi(raw[ks].y), a4 = bflo(raw[ks].z), a5 = bfhi(raw[ks].z), a6 = bflo(raw[ks].w), a7 = bfhi(raw[ks].w);
            ss += a0 * a0 + a1 * a1 + a2 * a2 + a3 * a3 + a4 * a4 + a5 * a5 + a6 * a6 + a7 * a7; }
        ss = half_swap_sum(ss);
        const float sc = __builtin_amdgcn_rsqf(ss * (1.f / 128.f) + EPS) * (0.08838834764831845f * LOG2E);
#pragma unroll
        for (int ks = 0; ks < 8; ++ks) { const f32x4 w0 = *(const f32x4*)(P.qnorm_w + 16 * ks + 8 * hi), w1 = *(const f32x4*)(P.qnorm_w + 16 * ks + 8 * hi + 4);
            u32x4 w; w.x = cvtpk(bflo(raw[ks].x) * sc * w0[0], bfhi(raw[ks].x) * sc * w0[1]); w.y = cvtpk(bflo(raw[ks].y) * sc * w0[2], bfhi(raw[ks].y) * sc * w0[3]);
            w.z = cvtpk(bflo(raw[ks].z) * sc * w1[0], bfhi(raw[ks].z) * sc * w1[1]); w.w = cvtpk(bflo(raw[ks].w) * sc * w1[2], bfhi(raw[ks].w) * sc * w1[3]);
            qf[ks] = mk_frag(w); }
    }
    unsigned long long smask = ~0ull;
    if (MODE == 2) smask = P.sel()[(size_t)bg * SEQ + 64 * qb + tl];
    f32x16 o[4];
#pragma unroll
    for (int dt = 0; dt < 4; ++dt)
#pragma unroll
        for (int r = 0; r < 16; ++r) o[dt][r] = 0.f;
    float mrun = -1e30f, lrun = 0.f;
    unsigned long long pset, sset;
    {
        const unsigned long long upto = (2ull << qb) - 1ull;
        const unsigned long long near = upto & ~((qb >= 3) ? ((1ull << (qb - 2)) - 1ull) : 0ull);
        if (MODE == 0) { const int jl = qb - 8 < 0 ? 0 : qb - 8; const unsigned long long win = upto & ~((1ull << jl) - 1ull);
            sset = near | ((qb >= 8) ? (1ull << (qb - 8)) : 0ull); pset = win & ~sset; }
        else { const unsigned long long un = P.selu()[bg * 64 + qb] & upto; sset = near & un; pset = un & ~near; }
    }
    const int krow = tid >> 4, kc16 = tid & 15, vrow = tid >> 3, vc8 = tid & 7;
    const bf16_t* kbase = P.U() + ((size_t)b * SEQ + krow) * UW + (MODE == 0 ? UKW : UKS) + g * 128 + 8 * kc16;
    const bf16_t* vbase = P.T() + (size_t)((MODE == 0 ? TVW : TVS) + g * 128 + vrow) * MTOK + (size_t)b * SEQ + 8 * vc8;
    f32x4 kw0 = {1.f, 1.f, 1.f, 1.f}, kw1 = {1.f, 1.f, 1.f, 1.f};
    if (MODE == 0) { const float* kw = P.knorm_w + 256 + 8 * kc16; kw0 = *(const f32x4*)kw; kw1 = *(const f32x4*)(kw + 4); }
    u32x4 kr[2], vr[2];
#define AF_LOAD(J) do { _Pragma("unroll") for (int _i = 0; _i < 2; ++_i) { kr[_i] = *(const u32x4*)(kbase + (size_t)(J) * 64 * UW + (size_t)_i * 32 * UW); vr[_i] = *(const u32x4*)(vbase + (size_t)(J) * 64 + (size_t)_i * 64 * MTOK); } } while (0)
#define AF_WRITE(BUF) do { LAS bf16_t* Ks_ = (LAS bf16_t*)(lds + (BUF) * BUFB); LAS bf16_t* Vs_ = (LAS bf16_t*)(lds + (BUF) * BUFB + 17408); \
        _Pragma("unroll") for (int i = 0; i < 2; ++i) { u32x4 raw = kr[i]; \
            if (MODE == 0) { float v[8] = {bflo(raw.x), bfhi(raw.x), bflo(raw.y), bfhi(raw.y), bflo(raw.z), bfhi(raw.z), bflo(raw.w), bfhi(raw.w)}; float ss = 0.f; \
                _Pragma("unroll") for (int e = 0; e < 8; ++e) ss += v[e] * v[e]; \
                ss = row16_sum(ss); const float rstd = __builtin_amdgcn_rsqf(ss * (1.f / 128.f) + EPS); \
                raw.x = cvtpk(v[0] * rstd * kw0[0], v[1] * rstd * kw0[1]); raw.y = cvtpk(v[2] * rstd * kw0[2], v[3] * rstd * kw0[3]); \
                raw.z = cvtpk(v[4] * rstd * kw1[0], v[5] * rstd * kw1[1]); raw.w = cvtpk(v[6] * rstd * kw1[2], v[7] * rstd * kw1[3]); } \
            *(LAS u32x4*)(Ks_ + (krow + 32 * i) * 136 + 8 * kc16) = raw; \
            LAS bf16_t* vp_ = Vs_ + (vrow + 64 * i) * 72 + 16 * (vc8 >> 1) + 4 * (vc8 & 1); \
            *(LAS u32x2*)vp_ = (u32x2){vr[i].x, vr[i].y}; *(LAS u32x2*)(vp_ + 8) = (u32x2){vr[i].z, vr[i].w}; } } while (0)
#define AF_LDK(DST, KP, KS2) do { DST[0] = *(const LAS bf16x8*)((KP) + 32 * (KS2)); DST[1] = *(const LAS bf16x8*)((KP) + 32 * 136 + 32 * (KS2)); \
                                  DST[2] = *(const LAS bf16x8*)((KP) + 32 * (KS2) + 16); DST[3] = *(const LAS bf16x8*)((KP) + 32 * 136 + 32 * (KS2) + 16); } while (0)
#define AF_MMK(SRC, S0, S1, KS2) do { S0 = MFMA32(SRC[0], qf[2 * (KS2)], S0); S1 = MFMA32(SRC[1], qf[2 * (KS2)], S1); S0 = MFMA32(SRC[2], qf[2 * (KS2) + 1], S0); S1 = MFMA32(SRC[3], qf[2 * (KS2) + 1], S1); } while (0)
#define AF_S(S0, S1, BUF) do { const LAS bf16_t* kp = (const LAS bf16_t*)(lds + (BUF) * BUFB) + r32 * 136 + 8 * hi; \
        bf16x8 fa[4], fb[4]; \
        _Pragma("unroll") for (int r = 0; r < 16; ++r) { S0[r] = 0.f; S1[r] = 0.f; } \
        AF_LDK(fa, kp, 0); AF_LDK(fb, kp, 1); __builtin_amdgcn_sched_barrier(0); \
        AF_MMK(fa, S0, S1, 0); __builtin_amdgcn_sched_barrier(0); AF_LDK(fa, kp, 2); __builtin_amdgcn_sched_barrier(0); \
        AF_MMK(fb, S0, S1, 1); __builtin_amdgcn_sched_barrier(0); AF_LDK(fb, kp, 3); __builtin_amdgcn_sched_barrier(0); \
        AF_MMK(fa, S0, S1, 2); __builtin_amdgcn_sched_barrier(0); \
        AF_MMK(fb, S0, S1, 3); __builtin_amdgcn_sched_barrier(0); } while (0)
#define AF_SMH(S0, S1, CB, ALPHA) do { float mx = fmaxf(S0[0], S1[0]); \
        _Pragma("unroll") for (int r = 1; r < 16; ++r) mx = fmaxf(mx, fmaxf(S0[r], S1[r])); \
        mx = half_swap_max(mx) + (CB); \
        const bool keep = __all(mx - mrun <= 11.5f); \
        const float mn = keep ? mrun : fmaxf(mrun, mx); ALPHA = __builtin_amdgcn_exp2f(mrun - mn); mrun = mn; \
        const float cc = (CB) - mn; \
        _Pragma("unroll") for (int r = 0; r < 16; ++r) { S0[r] = __builtin_amdgcn_exp2f(S0[r] + cc); S1[r] = __builtin_amdgcn_exp2f(S1[r] + cc); } } while (0)
#define AF_SMT(S0, S1, ALPHA) do { float ps = S0[0] + S1[0]; \
        _Pragma("unroll") for (int r = 1; r < 16; ++r) ps += S0[r] + S1[r]; \
        ps = half_swap_sum(ps); lrun = lrun * (ALPHA) + ps; \
        _Pragma("unroll") for (int s2 = 0; s2 < 2; ++s2) { \
            u32x4 w; w.x = cvtpk(S0[8 * s2 + 0], S0[8 * s2 + 1]); w.y = cvtpk(S0[8 * s2 + 2], S0[8 * s2 + 3]); w.z = cvtpk(S0[8 * s2 + 4], S0[8 * s2 + 5]); w.w = cvtpk(S0[8 * s2 + 6], S0[8 * s2 + 7]); pf[0][s2] = mk_frag(w); \
            u32x4 x; x.x = cvtpk(S1[8 * s2 + 0], S1[8 * s2 + 1]); x.y = cvtpk(S1[8 * s2 + 2], S1[8 * s2 + 3]); x.z = cvtpk(S1[8 * s2 + 4], S1[8 * s2 + 5]); x.w = cvtpk(S1[8 * s2 + 6], S1[8 * s2 + 7]); pf[1][s2] = mk_frag(x); } } while (0)
#define AF_RESC(ALPHA) do { if (__any((ALPHA) != 1.f)) { _Pragma("unroll") for (int dt = 0; dt < 4; ++dt) o[dt] = o[dt] * (ALPHA); } } while (0)
#define AF_LDV(DST, VP, dt) do { _Pragma("unroll") for (int kh = 0; kh < 2; ++kh) _Pragma("unroll") for (int s2 = 0; s2 < 2; ++s2) { \
            DST[2 * kh + s2] = *(const LAS bf16x8*)((VP) + (32 * (dt)) * 72 + 32 * kh + 16 * s2); } } while (0)
#define AF_MMV(SRC, dt) do { o[dt] = MFMA32(SRC[0], pf[0][0], o[dt]); o[dt] = MFMA32(SRC[1], pf[0][1], o[dt]); o[dt] = MFMA32(SRC[2], pf[1][0], o[dt]); o[dt] = MFMA32(SRC[3], pf[1][1], o[dt]); } while (0)
#define AF_VP(BUF) ((const LAS bf16_t*)(lds + (BUF) * BUFB + 17408) + r32 * 72 + 8 * hi)
#define AF_PV(BUF) do { const LAS bf16_t* vp0 = AF_VP(BUF); bf16x8 va[4], vb[4]; \
        AF_LDV(va, vp0, 0); AF_LDV(vb, vp0, 1); __builtin_amdgcn_sched_barrier(0); \
        AF_MMV(va, 0); __builtin_amdgcn_sched_barrier(0); AF_LDV(va, vp0, 2); __builtin_amdgcn_sched_barrier(0); \
        AF_MMV(vb, 1); __builtin_amdgcn_sched_barrier(0); AF_LDV(vb, vp0, 3); __builtin_amdgcn_sched_barrier(0); \
        AF_MMV(va, 2); __builtin_amdgcn_sched_barrier(0); AF_MMV(vb, 3); __builtin_amdgcn_sched_barrier(0); } while (0)
#define AF_PV_SMH(BUF, S0, S1, CB, ALPHA) do { const LAS bf16_t* vp0 = AF_VP(BUF); bf16x8 va[4], vb[4]; float mx; \
        AF_LDV(va, vp0, 0); AF_LDV(vb, vp0, 1); __builtin_amdgcn_sched_barrier(0); \
        AF_MMV(va, 0); mx = fmaxf(S0[0], S0[1]); _Pragma("unroll") for (int r = 2; r < 16; ++r) mx = fmaxf(mx, S0[r]); __builtin_amdgcn_sched_barrier(0); \
        AF_LDV(va, vp0, 2); __builtin_amdgcn_sched_barrier(0); \
        AF_MMV(vb, 1); _Pragma("unroll") for (int r = 0; r < 16; ++r) mx = fmaxf(mx, S1[r]); \
        mx = half_swap_max(mx) + (CB); \
        const bool keep = __all(mx - mrun <= 11.5f); \
        const float mn = keep ? mrun : fmaxf(mrun, mx); ALPHA = __builtin_amdgcn_exp2f(mrun - mn); mrun = mn; \
        const float cc = (CB) - mn; __builtin_amdgcn_sched_barrier(0); \
        AF_LDV(vb, vp0, 3); __builtin_amdgcn_sched_barrier(0); \
        AF_MMV(va, 2); _Pragma("unroll") for (int r = 0; r < 16; ++r) S0[r] = __builtin_amdgcn_exp2f(S0[r] + cc); __builtin_amdgcn_sched_barrier(0); \
        AF_MMV(vb, 3); _Pragma("unroll") for (int r = 0; r < 16; ++r) S1[r] = __builtin_amdgcn_exp2f(S1[r] + cc); __builtin_amdgcn_sched_barrier(0); } while (0)
    bf16x8 pf[2][2];
    const float cbias = 0.f;
    (void)cbias;
    unsigned long long srem = sset; int js = -1;
    if (srem) { js = __builtin_ctzll(srem); srem &= srem - 1ull; }
    if (pset) {
        unsigned long long rem = pset;
        f32x16 s0, s1; float al = 1.f;
        int jt0 = __builtin_ctzll(rem); rem &= rem - 1ull;
        AF_LOAD(jt0); AF_WRITE(0);
        int jn1 = -1; if (rem) { jn1 = __builtin_ctzll(rem); rem &= rem - 1ull; AF_LOAD(jn1); }
        __syncthreads();
        const float cb_all = tab[hd * 132 + 128];
#define AF_CB(J) ((MODE == 2) ? ((((smask >> (J)) & 1ull) != 0ull) ? cb_all : -INFINITY) : cb_all)
        int bufS = 0;
        if (jn1 >= 0) AF_WRITE(1);
        int jn2 = -1; if (rem) { jn2 = __builtin_ctzll(rem); rem &= rem - 1ull; AF_LOAD(jn2); }
        AF_S(s0, s1, 0);
        { const float cb = AF_CB(jt0); AF_SMH(s0, s1, cb, al); }
        AF_RESC(al);
        int jcur = jn1, jnext = jn2;
        while (jcur >= 0) {
            const int bufN = bufS == 2 ? 0 : bufS + 1;
            const int bufW = bufN == 2 ? 0 : bufN + 1;
            __syncthreads();
            if (jnext >= 0) AF_WRITE(bufW);
            int jn3 = -1; if (rem) { jn3 = __builtin_ctzll(rem); rem &= rem - 1ull; AF_LOAD(jn3); }
            AF_SMT(s0, s1, al);
            __builtin_amdgcn_sched_barrier(0);
            AF_S(s0, s1, bufN);
            { const float cb = AF_CB(jcur); AF_PV_SMH(bufS, s0, s1, cb, al); }
            AF_RESC(al);
            bufS = bufN; jcur = jnext; jnext = jn3;
        }
        if (js >= 0) AF_LOAD(js);
        AF_SMT(s0, s1, al);
        AF_PV(bufS);
    } else if (js >= 0) AF_LOAD(js);
    if (js >= 0) {
        __syncthreads();
        int sb = 0;
        while (js >= 0) {
            const int j = js;
            AF_WRITE(sb);
            __syncthreads();
            js = -1; if (srem) { js = __builtin_ctzll(srem); srem &= srem - 1ull; AF_LOAD(js); }
            f32x16 s0, s1; float al;
            AF_S(s0, s1, sb);
            const bool selok = (MODE == 2) ? (((smask >> j) & 1ull) != 0ull) : true;
#pragma unroll
            for (int kh = 0; kh < 2; ++kh)
#pragma unroll
                for (int rq = 0; rq < 4; ++rq) {
                    float tb[4];
#pragma unroll
                    for (int e = 0; e < 4; ++e) { const int kl = 32 * kh + 8 * rq + 4 * hi + e; const int dist = 64 * (qb - j) + tl - kl;
                        const int di = dist < 0 ? 0 : (dist > 128 ? 128 : dist); tb[e] = tab[hd * 132 + di]; }
                    asm volatile("" : "+v"(tb[0]), "+v"(tb[1]), "+v"(tb[2]), "+v"(tb[3]));
#pragma unroll
                    for (int e = 0; e < 4; ++e) { const int kl = 32 * kh + 8 * rq + 4 * hi + e; const int dist = 64 * (qb - j) + tl - kl;
                        bool ok = dist >= 0 && selok; if (MODE == 0) ok = ok && dist < 512;
                        if (kh == 0) s0[4 * rq + e] = ok ? s0[4 * rq + e] + tb[e] : -INFINITY; else s1[4 * rq + e] = ok ? s1[4 * rq + e] + tb[e] : -INFINITY; }
                }
            AF_SMH(s0, s1, 0.f, al);
            AF_SMT(s0, s1, al);
            AF_RESC(al);
            AF_PV(sb);
            sb ^= 1;
        }
    }
#undef AF_LOAD
#undef AF_WRITE
#undef AF_S
#undef AF_SMH
#undef AF_SMT
#undef AF_RESC
#undef AF_PV
#undef AF_PV_SMH
#undef AF_LDK
#undef AF_MMK
#undef AF_LDV
#undef AF_MMV
#undef AF_VP
#undef AF_CB
    const float inv = lrun > 0.f ? 1.f / lrun : 0.f;
    int lane2 = lane; asm volatile("" : "+v"(lane2));
    const int hi2 = lane2 >> 5, tl2 = 32 * qhalf + (lane2 & 31);
    const size_t tok = (size_t)b * SEQ + 64 * qb + tl2;
    if (MODE == 0) {
#pragma unroll
        for (int dt = 0; dt < 4; ++dt)
#pragma unroll
            for (int rq = 0; rq < 4; ++rq) { u32x2 w; w.x = cvtpk(o[dt][4 * rq] * inv, o[dt][4 * rq + 1] * inv); w.y = cvtpk(o[dt][4 * rq + 2] * inv, o[dt][4 * rq + 3] * inv);
                *(u32x2*)(P.ow() + tok * 2048 + head * 128 + 32 * dt + 8 * rq + 4 * hi2) = w; }
    } else {
        const float* gp = P.small() + tok * 64 + 16 + head * 3;
        const float g0 = sigmoidf_(gp[0]), g1 = sigmoidf_(gp[1]), g2 = sigmoidf_(gp[2]);
#pragma unroll
        for (int dt = 0; dt < 4; ++dt)
#pragma unroll
            for (int rq = 0; rq < 4; ++rq) { const int col = head * 128 + 32 * dt + 8 * rq + 4 * hi2;
                const u32x2 cw = *(const u32x2*)(P.oc() + tok * 2048 + col), ww = *(const u32x2*)(P.ow() + tok * 2048 + col), zw = *(const u32x2*)(P.U() + tok * UW + UNZ + col);
                const float o0 = o[dt][4 * rq] * inv, o1 = o[dt][4 * rq + 1] * inv, o2 = o[dt][4 * rq + 2] * inv, o3 = o[dt][4 * rq + 3] * inv;
                const float y0 = (g0 * bflo(cw.x) + g1 * o0 + g2 * bflo(ww.x)) * siluf_(bflo(zw.x)), y1 = (g0 * bfhi(cw.x) + g1 * o1 + g2 * bfhi(ww.x)) * siluf_(bfhi(zw.x));
                const float y2 = (g0 * bflo(cw.y) + g1 * o2 + g2 * bflo(ww.y)) * siluf_(bflo(zw.y)), y3 = (g0 * bfhi(cw.y) + g1 * o3 + g2 * bfhi(ww.y)) * siluf_(bfhi(zw.y));
                *(unsigned*)(P.y8() + tok * 2048 + col) = pk_fp8x4(__builtin_amdgcn_fmed3f(16.f * y0, -440.f, 440.f), __builtin_amdgcn_fmed3f(16.f * y1, -440.f, 440.f), __builtin_amdgcn_fmed3f(16.f * y2, -440.f, 440.f), __builtin_amdgcn_fmed3f(16.f * y3, -440.f, 440.f)); }
    }
    __syncthreads();
}

#ifndef R_CMP
#define R_CMP 1
#endif
#ifndef R_WIN
#define R_WIN 1
#endif
#ifndef R_ML1
#define R_ML1 1
#endif
#ifndef R_CA
#define R_CA 1
#endif
#ifndef R_ML2
#define R_ML2 1
#endif
#ifndef R_SEL
#define R_SEL 1
#endif
#ifndef R_ML3
#define R_ML3 1
#endif
#ifndef REP_P0
#define REP_P0 1
#endif
#ifndef REP_P1
#define REP_P1 1
#endif
#ifndef REP_P2
#define REP_P2 1
#endif
#ifndef REP_P3
#define REP_P3 1
#endif
#ifndef REP_P4
#define REP_P4 1
#endif
#ifndef REP_P5
#define REP_P5 1
#endif
constexpr int LDS_BYTES = 131072 + 1024;
constexpr int LDS_SLOT = 131072;
extern __shared__ __attribute__((aligned(16))) unsigned char dyn_lds[];

__device__ __forceinline__ int next_task(unsigned* ctr, LAS unsigned char* lds_) {
    LAS int* slot = (LAS int*)(opq(lds_) + LDS_SLOT);
    __syncthreads();
    if (opaque_tid() == 0) *slot = (int)atomicAdd(ctr, 1u);
    __syncthreads();
    return *slot;
}

#define XB_TMO      128
#define XB_XCNT(j)  (256  + 64 * (j))
#define XB_XSUB(j)  (1280 + 64 * (j))
#define XB_XGEN(j)  (2304 + 64 * (j))
#define XB_TOP      3328
#define XB_TOPGEN   3392
#define XCD_BAR_WORDS 3456
#define XB_SPIN_CAP (1u << 18)
__device__ __forceinline__ unsigned xb_ld(unsigned* p)              { return __hip_atomic_load(p, __ATOMIC_RELAXED, __HIP_MEMORY_SCOPE_AGENT); }
__device__ __forceinline__ unsigned xb_add(unsigned* p, unsigned v) { return __hip_atomic_fetch_add(p, v, __ATOMIC_RELAXED, __HIP_MEMORY_SCOPE_AGENT); }
__device__ __forceinline__ unsigned xb_xcc_id() { return (unsigned)__builtin_amdgcn_s_getreg((3 << 11) | 20) & 0xFu; }
#define XB_SPIN(cond, bar) do { unsigned _sp = 0; while (cond) { __builtin_amdgcn_s_sleep(1); \
    if ((++_sp & 255u) == 0u) { if (xb_ld(&(bar)[XB_TMO])) break; if (_sp > XB_SPIN_CAP) { atomicAdd(&(bar)[XB_TMO], 1u); break; } } } } while (0)
__device__ __forceinline__ void xcd_barrier_post(unsigned* bar) { if (threadIdx.x == 0) (void)xb_add(&bar[XB_XCNT(xb_xcc_id())], 1u); }
__device__ __forceinline__ void xcd_barrier_complete(unsigned* bar, unsigned x, unsigned& nloc, unsigned& nx) {
    const unsigned G = gridDim.x * gridDim.y * gridDim.z;
    unsigned sum, cnt, mine, sp = 0u;
    for (;;) {
        sum = 0u; cnt = 0u; mine = 0u;
#pragma unroll
        for (unsigned j = 0; j < 16; ++j) { const unsigned c = xb_ld(&bar[XB_XCNT(j)]); sum += c; cnt += (c > 0u) ? 1u : 0u; mine = (j == x) ? c : mine; }
        if (sum == G) break;
        __builtin_amdgcn_s_sleep(1);
        if ((++sp & 255u) == 0u) { if (xb_ld(&bar[XB_TMO])) break; if (sp > XB_SPIN_CAP) { atomicAdd(&bar[XB_TMO], 1u); break; } }
    }
    nloc = mine > 0u ? mine : 1u; nx = cnt > 0u ? cnt : 1u;
}
__device__ __forceinline__ void xcd_barrier(unsigned* bar, volatile LAS unsigned* st) {
    asm volatile("s_waitcnt vmcnt(0)" ::: "memory");
    __syncthreads();
    if (threadIdx.x == 0) {
        const unsigned x = xb_xcc_id();
        __builtin_amdgcn_s_waitcnt(0);
        unsigned nloc = st[0], nx = st[1];
        if (nloc == 0u) { xcd_barrier_complete(bar, x, nloc, nx); st[0] = nloc; st[1] = nx; }
        const unsigned old = xb_add(&bar[XB_XSUB(x)], 1u);
        const unsigned gen = old / nloc;
        if (old + 1u == (gen + 1u) * nloc) {
            __builtin_amdgcn_fence(__ATOMIC_RELEASE, "agent");
            asm volatile("s_waitcnt vmcnt(0)" ::: "memory");
            const unsigned og = xb_add(&bar[XB_TOP], 1u);
            const unsigned tg = og / nx;
            if (og + 1u == (tg + 1u) * nx) xb_add(&bar[XB_TOPGEN], 1u);
            else XB_SPIN(xb_ld(&bar[XB_TOPGEN]) == tg, bar);
            __builtin_amdgcn_fence(__ATOMIC_ACQUIRE, "agent");
            xb_add(&bar[XB_XGEN(x)], 1u);
            asm volatile("s_waitcnt vmcnt(0)" ::: "memory");
        } else {
            XB_SPIN(xb_ld(&bar[XB_XGEN(x)]) == gen, bar);
            __builtin_amdgcn_fence(__ATOMIC_ACQUIRE, "agent");
            asm volatile("s_waitcnt vmcnt(0)" ::: "memory");
        }
    }
    __syncthreads();
}

struct KArgs { const float* in[20]; float* out; unsigned char* ws; };
__global__ void __launch_bounds__(512, 2) hymba_mega(KArgs ka) {
    Params P; fill_params(P, (void* const*)ka.in, (void*)ka.out, (void*)ka.ws);
    cg::grid_group grid = cg::this_grid();
    LAS unsigned char* lds = (LAS unsigned char*)dyn_lds;
    const int bid = blockIdx.x, G = gridDim.x;
    if (threadIdx.x == 0) { *(volatile LAS unsigned*)(lds + LDS_SLOT + 64) = 0u; *(volatile LAS unsigned*)(lds + LDS_SLOT + 68) = 0u; }
    __syncthreads();
    xcd_barrier_post(P.ctl() + 4096);
    if (ka.out == nullptr) grid.sync();
#define GSYNC() xcd_barrier(P.ctl() + 4096, (volatile LAS unsigned*)(opq(lds) + LDS_SLOT + 64))
#define PH_P0 { phase0(P, lds, bid, G); GSYNC(); }
#define PH_P1 { phase_gemm1(P, lds, bid, G); phase_gemm_pe(P, lds, bid, G); GSYNC(); }
#define PH_P2(CB) { \
        for (int t = next_task(P.ctl() + (CB) + 0, lds); t < 32 * R_CMP + 512 * R_WIN + 512 * R_ML1 + 64; t = next_task(P.ctl() + (CB) + 0, lds)) { \
            if (t < 32 * R_CMP) cmp_gemm_task(P, lds, t % 32); \
            else if (t < 32 * R_CMP + 512 * R_WIN) { const int u = (t - 32 * R_CMP) % 512; attn_fast<0>(P, lds, u & 7, 63 - (u >> 3)); } \
            else if (t < 32 * R_CMP + 512 * R_WIN + 512 * R_ML1) ml_step1(P, lds, (t - 32 * R_CMP - 512 * R_WIN) % 512); \
            else ksnorm_task(P, t - (32 * R_CMP + 512 * R_WIN + 512 * R_ML1)); \
        } \
        GSYNC(); }
#define PH_P3(CB) { \
        for (int t = next_task(P.ctl() + (CB) + 64, lds); t < 256 * R_ML2 + 128 * R_CMP; t = next_task(P.ctl() + (CB) + 64, lds)) { \
            if (t < 256 * R_ML2) { const int u = t % 256; ml_step2(P, u >> 4, u & 15); } \
            else cmp_task(P, lds, (t - 256 * R_ML2) % 128); \
        } \
        GSYNC(); }
#define PH_P4(CB) { \
        for (int t = next_task(P.ctl() + (CB) + 128, lds); t < 512 * R_SEL + 512 * R_ML3; t = next_task(P.ctl() + (CB) + 128, lds)) { \
            if (t < 512 * R_SEL) { const int u = t % 512; attn_task<1>(P, lds, u & 7, 63 - (u >> 3)); __threadfence_block(); __syncthreads(); attn_fast<2>(P, lds, u & 7, 63 - (u >> 3)); } \
            else ml_step3(P, lds, (t - 512 * R_SEL) % 512); \
        } \
        GSYNC(); }
#define PH_P5 { phase_gemm2(P, lds, bid, G); GSYNC(); }
    PH_P0
#if REP_P0 > 1
    PH_P0
#endif
    PH_P1
#if REP_P1 > 1
    PH_P1
#endif
    PH_P2(0)
#if REP_P2 > 1
    PH_P2(256)
#endif
    PH_P3(0)
#if REP_P3 > 1
    PH_P3(256)
#endif
    PH_P4(0)
#if REP_P4 > 1
    PH_P4(256)
#endif
    PH_P5
#if REP_P5 > 1
    PH_P5
#endif
    phase_gemm3(P, lds, bid, G);
}

extern "C" void kernel_launch(void* const* d_in, const int* in_sizes, int n_in, void* d_out, int out_size, void* d_ws, size_t ws_size, hipStream_t stream) {
    static int grid_blocks = 0;
    if (!grid_blocks) {
        if (ws_size < WS_END) { fprintf(stderr, "kernel_launch: workspace too small: %zu < %zu\n", ws_size, (size_t)WS_END); grid_blocks = -1; return; }
        int dev = 0, cus = 0, per_cu = 0;
        (void)hipGetDevice(&dev);
        (void)hipDeviceGetAttribute(&cus, hipDeviceAttributeMultiprocessorCount, dev);
        (void)hipFuncSetAttribute((const void*)hymba_mega, hipFuncAttributeMaxDynamicSharedMemorySize, LDS_BYTES);
        (void)hipOccupancyMaxActiveBlocksPerMultiprocessor(&per_cu, (const void*)hymba_mega, 512, LDS_BYTES);
        if (per_cu < 1) { fprintf(stderr, "kernel_launch: occupancy query says %d blocks per CU\n", per_cu); per_cu = 1; }
        grid_blocks = cus * (per_cu > 1 ? 1 : per_cu);
    }
    if (grid_blocks < 0) return;
    (void)hipMemsetAsync((char*)d_ws + WS_CTL, 0, 32768, stream);
    KArgs ka{}; for (int i = 0; i < 20; ++i) ka.in[i] = (const float*)d_in[i]; ka.out = (float*)d_out; ka.ws = (unsigned char*)d_ws;
    void* args[] = {&ka};
    hipError_t e = hipLaunchCooperativeKernel((const void*)hymba_mega, dim3(grid_blocks), dim3(512), args, LDS_BYTES, stream);
    if (e != hipSuccess) fprintf(stderr, "cooperative launch failed: %s (grid %d)\n", hipGetErrorString(e), grid_blocks);
}
```

```cpp
#include <hip/hip_runtime.h>
#include <hip/hip_cooperative_groups.h>
#include <cstdio>
#include <cstdint>
namespace cg = cooperative_groups;

#define LAS __attribute__((address_space(3)))
typedef unsigned short bf16_t;
typedef short bf16x8 __attribute__((ext_vector_type(8)));
typedef short bf16x4 __attribute__((ext_vector_type(4)));
typedef float f32x4 __attribute__((ext_vector_type(4)));
typedef float f32x2 __attribute__((ext_vector_type(2)));
typedef unsigned u32x4 __attribute__((ext_vector_type(4)));
typedef unsigned u32x2 __attribute__((ext_vector_type(2)));

constexpr int DM = 4096, NB = 2, SEQ = 4096, MTOK = NB * SEQ;
constexpr int INW = 15424;
constexpr int UW = 12288;
constexpr int UQ = 0, UK = 1024, UO = 2048, UZ = 4096, UNQ = 6144, UKC = 8192, UVC = 8704, UKS = 9216, UKW = 9728, UNZ = 10240;
constexpr int WT_SMALL = 12288;
constexpr int WT_T = 12544;
constexpr int WT_ROWS = 15616;
constexpr int TV = 0, TVS = 2048, TVW = 2560, TROWS = 3072;
constexpr float EPS = 1e-6f;

__device__ __forceinline__ unsigned f2bf(float f) { unsigned u = __float_as_uint(f); return (u + 0x7fffu + ((u >> 16) & 1u)) >> 16; }
typedef __bf16 bf16x2v __attribute__((ext_vector_type(2)));
__device__ __forceinline__ unsigned pk2(float lo, float hi) { const f32x2 v = {lo, hi}; return __builtin_bit_cast(unsigned, __builtin_convertvector(v, bf16x2v)); }
__device__ __forceinline__ float bflo(unsigned w) { return __uint_as_float(w << 16); }
__device__ __forceinline__ float bfhi(unsigned w) { return __uint_as_float(w & 0xffff0000u); }
__device__ __forceinline__ float bf2f(bf16_t b) { return __uint_as_float(((unsigned)b) << 16); }
__device__ __forceinline__ float wave_sum(float v) {
#pragma unroll
    for (int o = 1; o < 64; o <<= 1) v += __shfl_xor(v, o);
    return v;
}
__device__ __forceinline__ int opaque_tid() { int t = threadIdx.x; asm volatile("" : "+v"(t)); return t; }
__device__ __forceinline__ LAS unsigned char* opq(LAS unsigned char* p) { unsigned v = (unsigned)(uintptr_t)p; asm volatile("" : "+s"(v)); return (LAS unsigned char*)(uintptr_t)v; }
#define DPP_F(v, ctrl) __builtin_bit_cast(float, __builtin_amdgcn_update_dpp(0, __builtin_bit_cast(int, (v)), (ctrl), 0xF, 0xF, true))
__device__ __forceinline__ float row16_sum(float v) { v += DPP_F(v, 0xB1); v += DPP_F(v, 0x4E); v += DPP_F(v, 0x141); v += DPP_F(v, 0x140); return v; }
__device__ __forceinline__ void swap16(float& a, float& b) { asm volatile("v_nop\n\tv_nop\n\tv_permlane16_swap_b32 %0, %1" : "+v"(a), "+v"(b)); }
__device__ __forceinline__ void swap32(float& a, float& b) { asm volatile("v_nop\n\tv_nop\n\tv_permlane32_swap_b32 %0, %1" : "+v"(a), "+v"(b)); }
__device__ __forceinline__ float xq_sum(float v) { float a = v, b = v; swap16(a, b); v = a + b; a = v; b = v; swap32(a, b); return a + b; }
__device__ __forceinline__ float xq_max(float v) { float a = v, b = v; swap16(a, b); v = fmaxf(a, b); a = v; b = v; swap32(a, b); return fmaxf(a, b); }
__device__ __forceinline__ float shfl_up_l(float v, int o, int lane_) { const int src = lane_ - o < 0 ? lane_ : lane_ - o; return __builtin_bit_cast(float, __builtin_amdgcn_ds_bpermute(src << 2, __builtin_bit_cast(int, v))); }
__device__ __forceinline__ float row16_max(float v) { v = fmaxf(v, DPP_F(v, 0xB1)); v = fmaxf(v, DPP_F(v, 0x4E)); v = fmaxf(v, DPP_F(v, 0x141)); v = fmaxf(v, DPP_F(v, 0x140)); return v; }
__device__ __forceinline__ float wave_max(float v) { return xq_max(row16_max(v)); }
__device__ __forceinline__ float sigmoidf_(float x) { return __builtin_amdgcn_rcpf(1.f + __expf(-x)); }
__device__ __forceinline__ float siluf_(float x) { return x * __builtin_amdgcn_rcpf(1.f + __expf(-x)); }

__device__ __forceinline__ unsigned pk_fp8x4(float a, float b, float c, float d) {
    int p = 0; p = __builtin_amdgcn_cvt_pk_fp8_f32(a, b, p, false); p = __builtin_amdgcn_cvt_pk_fp8_f32(c, d, p, true); return (unsigned)p;
}
__device__ __forceinline__ int w8_row(int dr) { return (dr >= 6144 && dr < 12288) ? dr - 6144 : (dr >= 14592 ? 6144 + (dr - 14592) : -1); }
__device__ __forceinline__ int wt_row(int c) {
    int r;
    if (c < 2048) r = c;
    else if (c < 4096) r = WT_T + TV + (c - 2048);
    else if (c < 6144) r = UO + (c - 4096);
    else if (c < 8192) r = UZ + (c - 6144);
    else if (c < 8208) r = WT_SMALL + (c - 8192);
    else if (c < 10256) r = UNQ + (c - 8208);
    else if (c < 11280) r = UKC + (c - 10256);
    else if (c < 11792) r = UKS + (c - 11280);
    else if (c < 12304) r = WT_T + TVS + (c - 11792);
    else if (c < 12816) r = UKW + (c - 12304);
    else if (c < 13328) r = WT_T + TVW + (c - 12816);
    else if (c < 13376) r = WT_SMALL + 16 + (c - 13328);
    else r = UNZ + (c - 13376);
    return r;
}

namespace pg8 {
constexpr int BM = 256, BK = 64, HALF = 128, HTB = HALF * BK * 2, STAGE_BYTES = 8 * HTB, NXCD = 8, WGM = 8;
__host__ __device__ __forceinline__ int lds_byte(int r, int c) { const int st = (r >> 4) * 2 + (c >> 5), rr = r & 15, cc = c & 31, ob = rr * 64 + cc * 2; return st * 1024 + (ob ^ (((ob >> 9) & 1) << 5)); }
__host__ __device__ __forceinline__ void stage_rc(int b, int& R, int& C) { const int st = b / 1024, sb = b % 1024, swz = sb ^ (((sb >> 9) & 1) << 5); R = (st >> 1) * 16 + swz / 64; C = (st & 1) * 32 + (swz % 64) / 2; }
__host__ __device__ __forceinline__ int perm32(int rho) { const int n = rho >> 4, i = rho & 15; return 8 * (i >> 2) + 4 * n + (i & 3); }

struct Unit { const char* a; const char* b; int pm, pn, kind; };

__device__ __forceinline__ void tile_order(int L, int nM, int nN, int& pm, int& pn) {
    const int nwg = nM * nN; int wgid = L;
    { const int q = nwg / NXCD, r = nwg % NXCD, xcd = wgid % NXCD, off = wgid / NXCD; wgid = (xcd < r ? xcd * (q + 1) : r * (q + 1) + (xcd - r) * q) + off; }
    const int nig = WGM * nN, gid = wgid / nig, fm = gid * WGM, gsz = (nM - fm) < WGM ? (nM - fm) : WGM;
    pm = fm + ((wgid % nig) % gsz); pn = (wgid % nig) / gsz;
}
struct Sched2 {
    const char* a0; const char* b0; int nM0, nN0, kind0;
    const char* a1; const char* b1; int nM1, nN1, kind1;
    int K, G, c;
    __device__ __forceinline__ bool next(int i, Unit& u) const {
        const long L = (long)i * G + c; const int n0 = nM0 * nN0, n1 = nM1 * nN1; const size_t tstep = (size_t)BM * K * 2;
        if (L < n0) { int pm, pn; tile_order((int)L, nM0, nN0, pm, pn); u.pm = pm; u.pn = pn; u.kind = kind0; u.a = a0 + (size_t)pm * tstep; u.b = b0 + (size_t)pn * tstep; return true; }
        if (L < n0 + n1) { int pm, pn; tile_order((int)(L - n0), nM1, nN1, pm, pn); u.pm = pm; u.pn = pn; u.kind = kind1; u.a = a1 + (size_t)pm * tstep; u.b = b1 + (size_t)pn * tstep; return true; }
        return false;
    }
};

struct SchedG1B {
    const char* hb; const char* wt; int G, c;
    __device__ __forceinline__ bool next(int i, Unit& u) const {
        const int L = i * G + c; const size_t tstep = (size_t)BM * 4096 * 2; int pm, pn;
        if (L < 768) { tile_order(L, 32, 24, pm, pn); u.kind = 0; u.pm = pm; u.pn = pn; u.a = hb + (size_t)pm * tstep; u.b = wt + (size_t)pn * tstep; return true; }
        if (L < 800) { pm = L - 768; u.kind = 0; u.pm = pm; u.pn = 48; u.a = hb + (size_t)pm * tstep; u.b = wt + (size_t)48 * tstep; return true; }
        if (L < 1056) { tile_order(L - 800, 8, 32, pm, pn); u.kind = 1; u.pm = pm; u.pn = pn; u.a = wt + (size_t)(49 + pm) * tstep; u.b = hb + (size_t)pn * tstep; return true; }
        return false;
    }
};
struct SchedG1F {
    const char* hb8; const char* w8; int G, c;
    __device__ __forceinline__ bool next(int i, Unit& u) const {
        int M;
        if (G == 256) { int h = i; if (c < 32) h += 2;
            if (h == 0) M = c - 32; else if (h == 1) M = 224 + (c - 32); else if (h == 2) M = 448 + c; else if (h == 3 && c < 192) M = 704 + c; else return false; }
        else { M = i * G + c; if (M >= 896) return false; }
        const size_t tstep = (size_t)BM * 4096; int pm, pn;
        if (M < 768) { tile_order(M, 32, 24, pm, pn); u.kind = 0; u.pm = pm; u.pn = 24 + pn; u.a = hb8 + (size_t)pm * tstep; u.b = w8 + (size_t)pn * tstep; }
        else { tile_order(M - 768, 4, 32, pm, pn); u.kind = 1; u.pm = 8 + pm; u.pn = pn; u.a = w8 + (size_t)(24 + pm) * tstep; u.b = hb8 + (size_t)pn * tstep; }
        return true;
    }
};

__device__ __forceinline__ unsigned cvt_pk_bf16(float lo, float hi) { return pk2(lo, hi); }

__device__ __forceinline__ const char* uniform_ptr(const char* p) {
    const unsigned long long v = (unsigned long long)p;
    const unsigned lo = __builtin_amdgcn_readfirstlane((unsigned)v), hi = __builtin_amdgcn_readfirstlane((unsigned)(v >> 32));
    return (const char*)(((unsigned long long)hi << 32) | lo);
}
typedef int i32x8 __attribute__((ext_vector_type(8)));
typedef int i32x4v __attribute__((ext_vector_type(4)));
__device__ __forceinline__ i32x8 cat8(bf16x8 a, bf16x8 b) { const i32x4v x = __builtin_bit_cast(i32x4v, a), y = __builtin_bit_cast(i32x4v, b); return (i32x8){x[0], x[1], x[2], x[3], y[0], y[1], y[2], y[3]}; }
template <class Epi, class Sched, bool FP8 = false>
__device__ __forceinline__ void gemm_phase(LAS unsigned char* lds, const int K, const Sched& S, const Epi& E) {
    const int tid = opaque_tid(), wid = __builtin_amdgcn_readfirstlane(tid >> 6), lane = tid & 63, wr = wid >> 2, wc = wid & 3, fr = lane & 15, fq = lane >> 4;
    const int nt = K / BK;
    unsigned voffA[2], voffB[2];
#pragma unroll
    for (int i = 0; i < 2; ++i) { int R, C; stage_rc(tid * 16 + i * 8192, R, C); const int Rb = (R & ~31) + perm32(R & 31);
        voffA[i] = (unsigned)(R * K + C) * 2u; voffB[i] = (unsigned)(Rb * K + C) * 2u; }
    const size_t kstep = (size_t)(BK * 2);
    const size_t hstep = (size_t)HALF * K * 2;
    const unsigned ldsw = (unsigned)wid * 1024u;
    const int aoff = lds_byte(wr * 64 + fr, fq * 8), boff = lds_byte(wc * 32 + fr, fq * 8);
#define PG8_SA(b, h) (((b) * 2 + (h)) * HTB)
#define PG8_SB(b, h) ((4 + (b) * 2 + (h)) * HTB)
#define PG8_VOFF(i_, isB_) ([&]() -> unsigned { int R_, C_; stage_rc((opaque_tid()) * 16 + (i_) * 8192, R_, C_); if (isB_) R_ = (R_ & ~31) + perm32(R_ & 31); return (unsigned)(R_ * K + C_) * 2u; }())
#define PG8_STAGE(bufoff, gbase, voff) do { _Pragma("unroll") for (int _i = 0; _i < 2; ++_i) { \
        unsigned vo_ = (voff)[_i]; if constexpr (FP8) { vo_ = (voff)[0]; asm volatile("" : "+v"(vo_)); vo_ += (unsigned)_i * (unsigned)(64 * K * 2); }     \
        __builtin_amdgcn_global_load_lds((const unsigned*)((const char*)(gbase) + vo_), (LAS unsigned*)(lds + (bufoff) + ldsw + _i * 8192), 16, 0, 0); } } while (0)
#define PG8_LDA(dst, b, h) do { if constexpr (FP8) { _Pragma("unroll") for (int m = 0; m < 4; ++m) { const i32x4v lo_ = *(const LAS i32x4v*)(lds + PG8_SA(b, h) + aoff + m * 2048), hi_ = *(const LAS i32x4v*)(lds + PG8_SA(b, h) + aoff + m * 2048 + 1024); \
            dst##8[m] = __builtin_shufflevector(lo_, hi_, 0, 1, 2, 3, 4, 5, 6, 7); } } \
        else { _Pragma("unroll") for (int m = 0; m < 4; ++m) _Pragma("unroll") for (int k = 0; k < 2; ++k) dst[m][k] = *(const LAS bf16x8*)(lds + PG8_SA(b, h) + aoff + m * 2048 + k * 1024); } } while (0)
#define PG8_LDB(dst, b, h) do { if constexpr (FP8) { _Pragma("unroll") for (int n = 0; n < 2; ++n) { const i32x4v lo_ = *(const LAS i32x4v*)(lds + PG8_SB(b, h) + boff + n * 2048), hi_ = *(const LAS i32x4v*)(lds + PG8_SB(b, h) + boff + n * 2048 + 1024); \
            dst##8[n] = __builtin_shufflevector(lo_, hi_, 0, 1, 2, 3, 4, 5, 6, 7); } } \
        else { _Pragma("unroll") for (int n = 0; n < 2; ++n) _Pragma("unroll") for (int k = 0; k < 2; ++k) dst[n][k] = *(const LAS bf16x8*)(lds + PG8_SB(b, h) + boff + n * 2048 + k * 1024); } } while (0)
#define PG8_MMA(ai, bj, At, Bt) do { __builtin_amdgcn_s_setprio(1); _Pragma("unroll") for (int m = 0; m < 4; ++m) _Pragma("unroll") for (int n = 0; n < 2; ++n) { \
        if constexpr (FP8) acc[ai][bj][m][n] = __builtin_amdgcn_mfma_scale_f32_16x16x128_f8f6f4(Bt##8[n], At##8[m], acc[ai][bj][m][n], 0, 0, 0, 121, 0, 127); \
        else { _Pragma("unroll") for (int k = 0; k < 2; ++k) acc[ai][bj][m][n] = __builtin_amdgcn_mfma_f32_16x16x32_bf16(Bt[n][k], At[m][k], acc[ai][bj][m][n], 0, 0, 0); } } \
        __builtin_amdgcn_s_setprio(0); } while (0)
#define PG8_WAIT_V(n) asm volatile("s_waitcnt vmcnt(" #n ")" ::: "memory")
#define PG8_WAIT_L(n) asm volatile("s_waitcnt lgkmcnt(" #n ")" ::: "memory")
#define PG8_BAR __builtin_amdgcn_s_barrier()
#define PG8_SCHED __builtin_amdgcn_sched_barrier(0)
    Unit cur, nxt; int ui = 0;
    if (!S.next(0, cur)) return;
    f32x4 acc[2][2][4][2];
#pragma unroll
    for (int a = 0; a < 2; ++a)
#pragma unroll
        for (int b = 0; b < 2; ++b)
#pragma unroll
            for (int m = 0; m < 4; ++m)
#pragma unroll
                for (int n = 0; n < 2; ++n) acc[a][b][m][n] = (f32x4){0.f, 0.f, 0.f, 0.f};
    bf16x8 At[4][2], B0[2][2], B1[2][2];
    i32x8 At8[4], B08[2], B18[2];
    const char* cA = cur.a; const char* cB = cur.b;
    PG8_STAGE(PG8_SB(0, 0), cB, voffB); PG8_STAGE(PG8_SB(0, 1), cB + hstep, voffB); PG8_STAGE(PG8_SA(0, 0), cA, voffA); PG8_STAGE(PG8_SA(0, 1), cA + hstep, voffA);
    if (wr == 1) PG8_BAR;
    PG8_WAIT_V(2); PG8_BAR;
    PG8_STAGE(PG8_SB(1, 0), cB + kstep, voffB); PG8_STAGE(PG8_SA(1, 0), cA + kstep, voffA); PG8_STAGE(PG8_SB(1, 1), cB + hstep + kstep, voffB);
    PG8_WAIT_V(6); PG8_BAR;
    for (;;) {
        const bool has_next = S.next(ui + 1, nxt);
        const char* nA = has_next ? nxt.a : cA; const char* nB = has_next ? nxt.b : cB;
        for (int t = 0; t < nt; t += 2) {
            const bool last = (t == nt - 2);
            const char* a1 = uniform_ptr(cA + (size_t)(t + 1) * kstep);
            const char* a2 = uniform_ptr(last ? nA : cA + (size_t)(t + 2) * kstep); const char* b2 = uniform_ptr(last ? nB : cB + (size_t)(t + 2) * kstep);
            const char* a3 = uniform_ptr(a2 + kstep); const char* b3 = uniform_ptr(b2 + kstep);
            PG8_LDB(B0, 0, 0); PG8_LDB(B1, 0, 1); PG8_SCHED; PG8_LDA(At, 0, 0); PG8_STAGE(PG8_SA(1, 1), a1 + hstep, voffA);
            PG8_WAIT_V(8); PG8_WAIT_L(0); PG8_BAR; PG8_MMA(0, 0, At, B0); PG8_MMA(0, 1, At, B1); PG8_BAR; PG8_SCHED;
            PG8_LDA(At, 0, 1); PG8_STAGE(PG8_SB(0, 0), b2, voffB); PG8_STAGE(PG8_SB(0, 1), b2 + hstep, voffB); PG8_STAGE(PG8_SA(0, 0), a2, voffA);
            PG8_WAIT_V(8); PG8_WAIT_L(0); PG8_BAR; PG8_MMA(1, 0, At, B0); PG8_MMA(1, 1, At, B1); PG8_BAR; PG8_SCHED;
            PG8_LDB(B0, 1, 0); PG8_LDB(B1, 1, 1); PG8_SCHED; PG8_LDA(At, 1, 0); PG8_STAGE(PG8_SA(0, 1), a2 + hstep, voffA);
            PG8_WAIT_V(8); PG8_WAIT_L(0); PG8_BAR; PG8_MMA(0, 0, At, B0); PG8_MMA(0, 1, At, B1); PG8_BAR; PG8_SCHED;
            PG8_LDA(At, 1, 1); PG8_STAGE(PG8_SB(1, 0), b3, voffB); PG8_STAGE(PG8_SB(1, 1), b3 + hstep, voffB); PG8_STAGE(PG8_SA(1, 0), a3, voffA);
            PG8_WAIT_V(8); PG8_WAIT_L(0); PG8_BAR; PG8_MMA(1, 0, At, B0); PG8_MMA(1, 1, At, B1); PG8_BAR; PG8_SCHED;
        }
        if (wr == 0) PG8_BAR;
        E(acc, cur, wr, wc, fr, fq);
        if (!has_next) break;
#pragma unroll
        for (int a = 0; a < 2; ++a)
#pragma unroll
            for (int b = 0; b < 2; ++b)
#pragma unroll
                for (int m = 0; m < 4; ++m)
#pragma unroll
                    for (int n = 0; n < 2; ++n) acc[a][b][m][n] = (f32x4){0.f, 0.f, 0.f, 0.f};
        cur = nxt; cA = nA; cB = nB; ++ui;
        if (wr == 1) PG8_BAR;
    }
    PG8_WAIT_V(0);
    PG8_BAR;
#undef PG8_SA
#undef PG8_SB
#undef PG8_STAGE
#undef PG8_LDA
#undef PG8_LDB
#undef PG8_MMA
#undef PG8_WAIT_V
#undef PG8_WAIT_L
#undef PG8_BAR
#undef PG8_SCHED
}

struct UnitM { int pm, pn; };
struct SchedM {
    const char* a; const char* b; const char* a8; const char* b8; int nM, nN, G, c;
    __device__ __forceinline__ bool next(int i, UnitM& u) const {
        const long L = (long)i * G + c; if (L >= (long)nM * nN) return false;
        int pm, pn; tile_order((int)L, nM, nN, pm, pn); u.pm = __builtin_amdgcn_readfirstlane(pm); u.pn = __builtin_amdgcn_readfirstlane(pn); return true;
    }
};
template <class Epi>
__device__ __forceinline__ void gemm_phase_mixed(LAS unsigned char* lds, const SchedM& S, const Epi& E) {
    constexpr int NT1 = 32, NT = 48;
    const int tid = opaque_tid(), wid = __builtin_amdgcn_readfirstlane(tid >> 6), lane = tid & 63, wr = wid >> 2, wc = wid & 3, fr = lane & 15, fq = lane >> 4;
    unsigned voffA0, voffB0;
    { int R, C; stage_rc(tid * 16, R, C); const int Rb = (R & ~31) + perm32(R & 31); voffA0 = (unsigned)(R * 8192 + 2 * C); voffB0 = (unsigned)(Rb * 8192 + 2 * C); }
    const unsigned ldsw = (unsigned)wid * 1024u;
    const int aoff = lds_byte(wr * 64 + fr, fq * 8), boff = lds_byte(wc * 32 + fr, fq * 8);
#define MX_SA(b, h) (((b) * 2 + (h)) * HTB)
#define MX_SB(b, h) ((4 + (b) * 2 + (h)) * HTB)
#define MX_STAGE(bufoff, ISB, PX, tt, half, VOFF0, M) do { \
        const char* gb_ = uniform_ptr((M) ? ((ISB) ? S.b8 : S.a8) + (size_t)(PX) * (256 * 2048) + (size_t)((tt) - NT1) * 128 + (size_t)(half) * 128 * 2048 \
                                          : ((ISB) ? S.b : S.a) + (size_t)(PX) * (256 * 8192) + (size_t)(tt) * 128 + (size_t)(half) * 128 * 8192); \
        unsigned v0_ = (VOFF0); asm volatile("" : "+v"(v0_)); if (M) v0_ -= (v0_ >> 13) * 6144u; \
        _Pragma("unroll") for (int _i = 0; _i < 2; ++_i) { const unsigned vo_ = v0_ + (unsigned)_i * ((M) ? 64u * 2048u : 64u * 8192u); \
            __builtin_amdgcn_global_load_lds((const unsigned*)(gb_ + vo_), (LAS unsigned*)(lds + (bufoff) + ldsw + _i * 8192), 16, 0, 0); } } while (0)
#define MX_PIN(ai, bj) do { _Pragma("unroll") for (int m = 0; m < 4; ++m) _Pragma("unroll") for (int n = 0; n < 2; ++n) asm volatile("" : "+v"(acc[ai][bj][m][n])); } while (0)
#define MX_LDA0(b, h) do { _Pragma("unroll") for (int m = 0; m < 4; ++m) _Pragma("unroll") for (int k = 0; k < 2; ++k) At[m][k] = *(const LAS bf16x8*)(lds + MX_SA(b, h) + aoff + m * 2048 + k * 1024); } while (0)
#define MX_LDB0(dst, b, h) do { _Pragma("unroll") for (int n = 0; n < 2; ++n) _Pragma("unroll") for (int k = 0; k < 2; ++k) dst[n][k] = *(const LAS bf16x8*)(lds + MX_SB(b, h) + boff + n * 2048 + k * 1024); } while (0)
#define MX_MMA0(ai, bj, Bt) do { __builtin_amdgcn_s_setprio(1); _Pragma("unroll") for (int m = 0; m < 4; ++m) _Pragma("unroll") for (int n = 0; n < 2; ++n) _Pragma("unroll") for (int k = 0; k < 2; ++k) \
        acc[ai][bj][m][n] = __builtin_amdgcn_mfma_f32_16x16x32_bf16(Bt[n][k], At[m][k], acc[ai][bj][m][n], 0, 0, 0); MX_PIN(ai, bj); __builtin_amdgcn_s_setprio(0); } while (0)
#define MX_LDA1(b, h) do { _Pragma("unroll") for (int m = 0; m < 4; ++m) { const i32x4v lo_ = *(const LAS i32x4v*)(lds + MX_SA(b, h) + aoff + m * 2048), hi_ = *(const LAS i32x4v*)(lds + MX_SA(b, h) + aoff + m * 2048 + 1024); \
        At8[m] = __builtin_shufflevector(lo_, hi_, 0, 1, 2, 3, 4, 5, 6, 7); } } while (0)
#define MX_LDB1(dst, b, h) do { _Pragma("unroll") for (int n = 0; n < 2; ++n) { const i32x4v lo_ = *(const LAS i32x4v*)(lds + MX_SB(b, h) + boff + n * 2048), hi_ = *(const LAS i32x4v*)(lds + MX_SB(b, h) + boff + n * 2048 + 1024); \
        dst##8[n] = __builtin_shufflevector(lo_, hi_, 0, 1, 2, 3, 4, 5, 6, 7); } } while (0)
#define MX_MMA1(ai, bj, Bt) do { __builtin_amdgcn_s_setprio(1); _Pragma("unroll") for (int m = 0; m < 4; ++m) _Pragma("unroll") for (int n = 0; n < 2; ++n) \
        acc[ai][bj][m][n] = __builtin_amdgcn_mfma_scale_f32_16x16x128_f8f6f4(Bt##8[n], At8[m], acc[ai][bj][m][n], 0, 0, 0, 121, 0, 123); MX_PIN(ai, bj); __builtin_amdgcn_s_setprio(0); } while (0)
#define MX_WAIT_V(n) asm volatile("s_waitcnt vmcnt(" #n ")" ::: "memory")
#define MX_WAIT_L(n) asm volatile("s_waitcnt lgkmcnt(" #n ")" ::: "memory")
#define MX_BAR __builtin_amdgcn_s_barrier()
#define MX_SCHED __builtin_amdgcn_sched_barrier(0)
#define MX_BODY(F, G) do { \
        MX_LDB##F(B0, 0, 0); MX_LDB##F(B1, 0, 1); MX_SCHED; MX_LDA##F(0, 0); MX_STAGE(MX_SA(1, 1), 0, cur.pm, t + 1, 1, voffA0, F); \
        MX_WAIT_V(8); MX_WAIT_L(0); MX_BAR; MX_MMA##F(0, 0, B0); MX_MMA##F(0, 1, B1); MX_BAR; MX_SCHED; \
        MX_LDA##F(0, 1); MX_STAGE(MX_SB(0, 0), 1, xpn, i2, 0, voffB0, G); MX_STAGE(MX_SB(0, 1), 1, xpn, i2, 1, voffB0, G); MX_STAGE(MX_SA(0, 0), 0, xpm, i2, 0, voffA0, G); \
        MX_WAIT_V(8); MX_WAIT_L(0); MX_BAR; MX_MMA##F(1, 0, B0); MX_MMA##F(1, 1, B1); MX_BAR; MX_SCHED; \
        MX_LDB##F(B0, 1, 0); MX_LDB##F(B1, 1, 1); MX_SCHED; MX_LDA##F(1, 0); MX_STAGE(MX_SA(0, 1), 0, xpm, i2, 1, voffA0, G); \
        MX_WAIT_V(8); MX_WAIT_L(0); MX_BAR; MX_MMA##F(0, 0, B0); MX_MMA##F(0, 1, B1); MX_BAR; MX_SCHED; \
        MX_LDA##F(1, 1); MX_STAGE(MX_SB(1, 0), 1, xpn, i3, 0, voffB0, G); MX_STAGE(MX_SB(1, 1), 1, xpn, i3, 1, voffB0, G); MX_STAGE(MX_SA(1, 0), 0, xpm, i3, 0, voffA0, G); \
        MX_WAIT_V(8); MX_WAIT_L(0); MX_BAR; MX_MMA##F(1, 0, B0); MX_MMA##F(1, 1, B1); MX_BAR; MX_SCHED; } while (0)
    UnitM cur, nxt; int ui = 0;
    if (!S.next(0, cur)) return;
    f32x4 acc[2][2][4][2];
#pragma unroll
    for (int a = 0; a < 2; ++a)
#pragma unroll
        for (int b = 0; b < 2; ++b)
#pragma unroll
            for (int m = 0; m < 4; ++m)
#pragma unroll
                for (int n = 0; n < 2; ++n) acc[a][b][m][n] = (f32x4){0.f, 0.f, 0.f, 0.f};
    bf16x8 At[4][2], B0[2][2], B1[2][2];
    i32x8 At8[4], B08[2], B18[2];
    MX_STAGE(MX_SB(0, 0), 1, cur.pn, 0, 0, voffB0, 0); MX_STAGE(MX_SB(0, 1), 1, cur.pn, 0, 1, voffB0, 0); MX_STAGE(MX_SA(0, 0), 0, cur.pm, 0, 0, voffA0, 0); MX_STAGE(MX_SA(0, 1), 0, cur.pm, 0, 1, voffA0, 0);
    if (wr == 1) MX_BAR;
    MX_WAIT_V(2); MX_BAR;
    MX_STAGE(MX_SB(1, 0), 1, cur.pn, 1, 0, voffB0, 0); MX_STAGE(MX_SA(1, 0), 0, cur.pm, 1, 0, voffA0, 0); MX_STAGE(MX_SB(1, 1), 1, cur.pn, 1, 1, voffB0, 0);
    MX_WAIT_V(6); MX_BAR;
    for (;;) {
        const bool has_next = S.next(ui + 1, nxt);
        if (!has_next) nxt = cur;
        { const int xpm = cur.pm, xpn = cur.pn;
          for (int t = 0; t < NT1 - 2; t += 2) { const int i2 = t + 2, i3 = t + 3; MX_BODY(0, 0); }
          { const int t = NT1 - 2, i2 = NT1, i3 = NT1 + 1; MX_BODY(0, 1); }
          for (int t = NT1; t < NT - 2; t += 2) { const int i2 = t + 2, i3 = t + 3; MX_BODY(1, 1); } }
        { const int xpm = nxt.pm, xpn = nxt.pn; const int t = NT - 2, i2 = 0, i3 = 1; MX_BODY(1, 0); }
        if (wr == 0) MX_BAR;
        { Unit eu; eu.a = nullptr; eu.b = nullptr; eu.pm = cur.pm; eu.pn = cur.pn; eu.kind = 0; E(acc, eu, wr, wc, fr, fq); }
        if (!has_next) break;
#pragma unroll
        for (int a = 0; a < 2; ++a)
#pragma unroll
            for (int b = 0; b < 2; ++b)
#pragma unroll
                for (int m = 0; m < 4; ++m)
#pragma unroll
                    for (int n = 0; n < 2; ++n) acc[a][b][m][n] = (f32x4){0.f, 0.f, 0.f, 0.f};
        cur = nxt; ++ui;
        if (wr == 1) MX_BAR;
    }
    MX_WAIT_V(0);
    MX_BAR;
#undef MX_SA
#undef MX_SB
#undef MX_STAGE
#undef MX_LDA0
#undef MX_PIN
#undef MX_LDB0
#undef MX_MMA0
#undef MX_LDA1
#undef MX_LDB1
#undef MX_MMA1
#undef MX_WAIT_V
#undef MX_WAIT_L
#undef MX_BAR
#undef MX_SCHED
#undef MX_BODY
}

struct SchedC {
    const char* U; const char* w1k; const char* w1v; int ukc, uvc; int unit;
    __device__ __forceinline__ bool next(int i, UnitM& u) const { if (i > 0) return false; const int kv = unit & 1, pnh = (unit >> 1) & 1, bg = unit >> 2;
        u.pm = __builtin_amdgcn_readfirstlane(kv * 8 + bg); u.pn = __builtin_amdgcn_readfirstlane(kv * 2 + pnh); return true; }
    __device__ __forceinline__ const char* abase(int ca) const { const int kv = ca >> 3, bg = ca & 7; return U + ((size_t)((bg >> 2) * SEQ) * UW + (kv ? uvc : ukc) + (bg & 3) * 128) * 2; }
    __device__ __forceinline__ const char* bbase(int cb) const { return ((cb >> 1) ? w1v : w1k) + (size_t)(cb & 1) * 2048 * 2; }
};
template <class Epi>
__device__ __forceinline__ void gemm_cmp(LAS unsigned char* lds, const SchedC& S, const Epi& E) {
    constexpr int NT = 32; constexpr unsigned PITCHA = 16u * UW * 2u;
    const int tid = opaque_tid(), wid = __builtin_amdgcn_readfirstlane(tid >> 6), lane = tid & 63, wr = wid >> 2, wc = wid & 3, fr = lane & 15, fq = lane >> 4;
    unsigned voffA0, voffB0;
    { int R, C; stage_rc(tid * 16, R, C); const int Rb = (R & ~31) + perm32(R & 31); voffA0 = (unsigned)R * PITCHA + 2u * C; voffB0 = (unsigned)(Rb * 8192 + 2 * C); }
    const unsigned ldsw = (unsigned)wid * 1024u;
    const int aoff = lds_byte(wr * 64 + fr, fq * 8), boff = lds_byte(wc * 32 + fr, fq * 8);
#define MX_SA(b, h) (((b) * 2 + (h)) * HTB)
#define MX_SB(b, h) ((4 + (b) * 2 + (h)) * HTB)
#define MX_STAGE(bufoff, ISB, PX, tt, half, VOFF0, M) do { \
        const char* gb_ = uniform_ptr((ISB) ? S.bbase(PX) + (size_t)(tt) * 128 + (size_t)(half) * 128 * 8192 \
                                            : S.abase(PX) + (size_t)((tt) >> 1) * (UW * 2) + (size_t)((tt) & 1) * 128 + (size_t)(half) * 128 * PITCHA); \
        unsigned v0_ = (VOFF0); asm volatile("" : "+v"(v0_)); \
        _Pragma("unroll") for (int _i = 0; _i < 2; ++_i) { const unsigned vo_ = v0_ + (unsigned)_i * ((ISB) ? 64u * 8192u : 64u * PITCHA); \
            __builtin_amdgcn_global_load_lds((const unsigned*)(gb_ + vo_), (LAS unsigned*)(lds + (bufoff) + ldsw + _i * 8192), 16, 0, 0); } } while (0)
#define MX_PIN(ai, bj) do { _Pragma("unroll") for (int m = 0; m < 4; ++m) _Pragma("unroll") for (int n = 0; n < 2; ++n) asm volatile("" : "+v"(acc[ai][bj][m][n])); } while (0)
#define MX_LDA0(b, h) do { _Pragma("unroll") for (int m = 0; m < 4; ++m) _Pragma("unroll") for (int k = 0; k < 2; ++k) At[m][k] = *(const LAS bf16x8*)(lds + MX_SA(b, h) + aoff + m * 2048 + k * 1024); } while (0)
#define MX_LDB0(dst, b, h) do { _Pragma("unroll") for (int n = 0; n < 2; ++n) _Pragma("unroll") for (int k = 0; k < 2; ++k) dst[n][k] = *(const LAS bf16x8*)(lds + MX_SB(b, h) + boff + n * 2048 + k * 1024); } while (0)
#define MX_MMA0(ai, bj, Bt) do { __builtin_amdgcn_s_setprio(1); _Pragma("unroll") for (int m = 0; m < 4; ++m) _Pragma("unroll") for (int n = 0; n < 2; ++n) _Pragma("unroll") for (int k = 0; k < 2; ++k) \
        acc[ai][bj][m][n] = __builtin_amdgcn_mfma_f32_16x16x32_bf16(Bt[n][k], At[m][k], acc[ai][bj][m][n], 0, 0, 0); MX_PIN(ai, bj); __builtin_amdgcn_s_setprio(0); } while (0)
#define MX_WAIT_V(n) asm volatile("s_waitcnt vmcnt(" #n ")" ::: "memory")
#define MX_WAIT_L(n) asm volatile("s_waitcnt lgkmcnt(" #n ")" ::: "memory")
#define MX_BAR __builtin_amdgcn_s_barrier()
#define MX_SCHED __builtin_amdgcn_sched_barrier(0)
#define MX_BODY(F, G) do { \
        MX_LDB##F(B0, 0, 0); MX_LDB##F(B1, 0, 1); MX_SCHED; MX_LDA##F(0, 0); MX_STAGE(MX_SA(1, 1), 0, cur.pm, t + 1, 1, voffA0, F); \
        MX_WAIT_V(8); MX_WAIT_L(0); MX_BAR; MX_MMA##F(0, 0, B0); MX_MMA##F(0, 1, B1); MX_BAR; MX_SCHED; \
        MX_LDA##F(0, 1); MX_STAGE(MX_SB(0, 0), 1, xpn, i2, 0, voffB0, G); MX_STAGE(MX_SB(0, 1), 1, xpn, i2, 1, voffB0, G); MX_STAGE(MX_SA(0, 0), 0, xpm, i2, 0, voffA0, G); \
        MX_WAIT_V(8); MX_WAIT_L(0); MX_BAR; MX_MMA##F(1, 0, B0); MX_MMA##F(1, 1, B1); MX_BAR; MX_SCHED; \
        MX_LDB##F(B0, 1, 0); MX_LDB##F(B1, 1, 1); MX_SCHED; MX_LDA##F(1, 0); MX_STAGE(MX_SA(0, 1), 0, xpm, i2, 1, voffA0, G); \
        MX_WAIT_V(8); MX_WAIT_L(0); MX_BAR; MX_MMA##F(0, 0, B0); MX_MMA##F(0, 1, B1); MX_BAR; MX_SCHED; \
        MX_LDA##F(1, 1); MX_STAGE(MX_SB(1, 0), 1, xpn, i3, 0, voffB0, G); MX_STAGE(MX_SB(1, 1), 1, xpn, i3, 1, voffB0, G); MX_STAGE(MX_SA(1, 0), 0, xpm, i3, 0, voffA0, G); \
        MX_WAIT_V(8); MX_WAIT_L(0); MX_BAR; MX_MMA##F(1, 0, B0); MX_MMA##F(1, 1, B1); MX_BAR; MX_SCHED; } while (0)
    UnitM cur, nxt; int ui = 0;
    if (!S.next(0, cur)) return;
    f32x4 acc[2][2][4][2];
#pragma unroll
    for (int a = 0; a < 2; ++a)
#pragma unroll
        for (int b = 0; b < 2; ++b)
#pragma unroll
            for (int m = 0; m < 4; ++m)
#pragma unroll
                for (int n = 0; n < 2; ++n) acc[a][b][m][n] = (f32x4){0.f, 0.f, 0.f, 0.f};
    bf16x8 At[4][2], B0[2][2], B1[2][2];
    MX_STAGE(MX_SB(0, 0), 1, cur.pn, 0, 0, voffB0, 0); MX_STAGE(MX_SB(0, 1), 1, cur.pn, 0, 1, voffB0, 0); MX_STAGE(MX_SA(0, 0), 0, cur.pm, 0, 0, voffA0, 0); MX_STAGE(MX_SA(0, 1), 0, cur.pm, 0, 1, voffA0, 0);
    if (wr == 1) MX_BAR;
    MX_WAIT_V(2); MX_BAR;
    MX_STAGE(MX_SB(1, 0), 1, cur.pn, 1, 0, voffB0, 0); MX_STAGE(MX_SA(1, 0), 0, cur.pm, 1, 0, voffA0, 0); MX_STAGE(MX_SB(1, 1), 1, cur.pn, 1, 1, voffB0, 0);
    MX_WAIT_V(6); MX_BAR;
    for (;;) {
        const bool has_next = S.next(ui + 1, nxt);
        if (!has_next) nxt = cur;
        { const int xpm = cur.pm, xpn = cur.pn;
          for (int t = 0; t < NT - 2; t += 2) { const int i2 = t + 2, i3 = t + 3; MX_BODY(0, 0); } }
        { const int xpm = nxt.pm, xpn = nxt.pn; const int t = NT - 2, i2 = 0, i3 = 1; MX_BODY(0, 0); }
        if (wr == 0) MX_BAR;
        { Unit eu; eu.a = nullptr; eu.b = nullptr; eu.pm = cur.pm; eu.pn = cur.pn; eu.kind = 0; E(acc, eu, wr, wc, fr, fq); }
        if (!has_next) break;
#pragma unroll
        for (int a = 0; a < 2; ++a)
#pragma unroll
            for (int b = 0; b < 2; ++b)
#pragma unroll
                for (int m = 0; m < 4; ++m)
#pragma unroll
                    for (int n = 0; n < 2; ++n) acc[a][b][m][n] = (f32x4){0.f, 0.f, 0.f, 0.f};
        cur = nxt; ++ui;
        if (wr == 1) MX_BAR;
    }
    MX_WAIT_V(0);
    MX_BAR;
#undef MX_SA
#undef MX_SB
#undef MX_STAGE
#undef MX_LDA0
#undef MX_PIN
#undef MX_LDB0
#undef MX_MMA0
#undef MX_WAIT_V
#undef MX_WAIT_L
#undef MX_BAR
#undef MX_SCHED
#undef MX_BODY
}
}

struct EpiStore {
    bf16_t* U; float* small; bf16_t* T; bf16_t* O2; int ldc2;
    __device__ __forceinline__ void operator()(const f32x4 (&acc)[2][2][4][2], const pg8::Unit& u, int wr, int wc, int fr_, int fq_) const {
        const int lane_ = opaque_tid() & 63, fr = lane_ & 15, fq = lane_ >> 4; (void)fr_; (void)fq_;
        const int row0 = u.pm * 256 + wr * 64 + fr;
        if (u.kind == 0 && u.pn == 48) {
            int fq2 = fq; asm volatile("" : "+v"(fq2));
            if (wc < 2) {
#pragma unroll
                for (int ai = 0; ai < 2; ++ai)
#pragma unroll
                    for (int m = 0; m < 4; ++m) { float* rp = small + (size_t)(row0 + ai * 128 + m * 16) * 64 + wc * 32 + 8 * fq2;
                        *(f32x4*)rp = acc[ai][0][m][0]; *(f32x4*)(rp + 4) = acc[ai][0][m][1]; }
            }
            return;
        }
        bf16_t* base = u.kind == 0 ? U : (u.kind == 1 ? T : O2); const int ldc = u.kind == 0 ? UW : (u.kind == 1 ? MTOK : ldc2);
        const int col0 = u.pn * 256 + wc * 32 + 8 * fq;
#pragma unroll
        for (int ai = 0; ai < 2; ++ai)
#pragma unroll
            for (int m = 0; m < 4; ++m) { bf16_t* rowp = base + (size_t)(row0 + ai * 128 + m * 16) * ldc + col0;
#pragma unroll
                for (int bj = 0; bj < 2; ++bj) { const f32x4 v0 = acc[ai][bj][m][0], v1 = acc[ai][bj][m][1];
                    u32x4 w; w.x = pg8::cvt_pk_bf16(v0[0], v0[1]); w.y = pg8::cvt_pk_bf16(v0[2], v0[3]); w.z = pg8::cvt_pk_bf16(v1[0], v1[1]); w.w = pg8::cvt_pk_bf16(v1[2], v1[3]);
                    *(u32x4*)(rowp + bj * 128) = w; } }
    }
};
struct EpiZ {
    float* Z;
    __device__ __forceinline__ void operator()(const f32x4 (&acc)[2][2][4][2], const pg8::Unit& u, int wr, int wc, int fr_, int fq_) const {
        const int lane_ = opaque_tid() & 63, fr = lane_ & 15, fq = lane_ >> 4; (void)fr_; (void)fq_;
        float* base = Z + ((size_t)u.pm * 256 + wr * 64 + fr) * 512 + (u.pn & 1) * 256 + wc * 32 + 8 * fq;
#pragma unroll
        for (int ai = 0; ai < 2; ++ai)
#pragma unroll
            for (int m = 0; m < 4; ++m)
#pragma unroll
                for (int bj = 0; bj < 2; ++bj) { float* rp = base + (size_t)(ai * 128 + m * 16) * 512 + bj * 128; *(f32x4*)rp = acc[ai][bj][m][0]; *(f32x4*)(rp + 4) = acc[ai][bj][m][1]; }
    }
};
struct EpiRes {
    const float* x; bf16_t* x1b;
    __device__ __forceinline__ void operator()(const f32x4 (&acc)[2][2][4][2], const pg8::Unit& u, int wr, int wc, int fr, int fq) const {
        const int row0 = u.pm * 256 + wr * 64 + fr, col0 = u.pn * 256 + wc * 32 + 8 * fq;
#pragma unroll
        for (int ai = 0; ai < 2; ++ai) {
            f32x4 xa[4][2][2];
#pragma unroll
            for (int m = 0; m < 4; ++m) { const size_t off = (size_t)(row0 + ai * 128 + m * 16) * DM + col0;
#pragma unroll
                for (int bj = 0; bj < 2; ++bj) { xa[m][bj][0] = *(const f32x4*)(x + off + bj * 128); xa[m][bj][1] = *(const f32x4*)(x + off + bj * 128 + 4); } }
            __builtin_amdgcn_sched_barrier(0);
#pragma unroll
            for (int m = 0; m < 4; ++m) { const size_t off = (size_t)(row0 + ai * 128 + m * 16) * DM + col0;
#pragma unroll
                for (int bj = 0; bj < 2; ++bj) { const f32x4 v0 = acc[ai][bj][m][0] + xa[m][bj][0], v1 = acc[ai][bj][m][1] + xa[m][bj][1];
                    u32x4 w; w.x = pk2(v0[0], v0[1]); w.y = pk2(v0[2], v0[3]); w.z = pk2(v1[0], v1[1]); w.w = pk2(v1[2], v1[3]);
                    *(u32x4*)(x1b + off + bj * 128) = w; } }
            __builtin_amdgcn_sched_barrier(0);
        }
    }
};
struct EpiGate {
    float* out; const bf16_t* x1b; const bf16_t* pe;
    __device__ __forceinline__ void operator()(const f32x4 (&acc)[2][2][4][2], const pg8::Unit& u, int wr, int wc, int fr, int fq) const {
        const int row0 = u.pm * 256 + wr * 64 + fr, col0 = u.pn * 256 + wc * 32 + 8 * fq;
#pragma unroll
        for (int ai = 0; ai < 2; ++ai) {
            u32x4 xw[4][2], pw[4][2];
#pragma unroll
            for (int m = 0; m < 4; ++m) { const size_t off = (size_t)(row0 + ai * 128 + m * 16) * DM + col0;
#pragma unroll
                for (int bj = 0; bj < 2; ++bj) { xw[m][bj] = *(const u32x4*)(x1b + off + bj * 128); pw[m][bj] = *(const u32x4*)(pe + off + bj * 128); } }
            __builtin_amdgcn_sched_barrier(0);
#pragma unroll
            for (int m = 0; m < 4; ++m) { const size_t off = (size_t)(row0 + ai * 128 + m * 16) * DM + col0;
#pragma unroll
                for (int bj = 0; bj < 2; ++bj) { const u32x4 xv = xw[m][bj], pv = pw[m][bj];
                    const f32x4 a0 = acc[ai][bj][m][0], a1 = acc[ai][bj][m][1];
                    f32x4 v0, v1;
                    v0[0] = bflo(xv.x) + sigmoidf_(a0[0]) * bflo(pv.x); v0[1] = bfhi(xv.x) + sigmoidf_(a0[1]) * bfhi(pv.x);
                    v0[2] = bflo(xv.y) + sigmoidf_(a0[2]) * bflo(pv.y); v0[3] = bfhi(xv.y) + sigmoidf_(a0[3]) * bfhi(pv.y);
                    v1[0] = bflo(xv.z) + sigmoidf_(a1[0]) * bflo(pv.z); v1[1] = bfhi(xv.z) + sigmoidf_(a1[1]) * bfhi(pv.z);
                    v1[2] = bflo(xv.w) + sigmoidf_(a1[2]) * bflo(pv.w); v1[3] = bfhi(xv.w) + sigmoidf_(a1[3]) * bfhi(pv.w);
                    *(f32x4*)(out + off + bj * 128) = v0; *(f32x4*)(out + off + bj * 128 + 4) = v1; } }
            __builtin_amdgcn_sched_barrier(0);
        }
    }
};

constexpr size_t MiB = 1u << 20;
constexpr size_t WS_CTL = 0;
constexpr size_t WS_HB = 1 * MiB;
constexpr size_t WS_WT = WS_HB + 64 * MiB;
constexpr size_t WS_WOT = WS_WT + 122 * MiB;
constexpr size_t WS_WGT = WS_WOT + 32 * MiB;
constexpr size_t WS_WPT = WS_WGT + 32 * MiB;
constexpr size_t WS_PB = WS_WPT + 2 * MiB;
constexpr size_t WS_W1K = WS_PB + 4 * MiB;
constexpr size_t WS_W1V = WS_W1K + 2 * MiB;
constexpr size_t WS_W2 = WS_W1V + 2 * MiB;
constexpr size_t WS_U = WS_W2 + 1 * MiB;
constexpr size_t WS_T = WS_U + 192 * MiB;
constexpr size_t WS_SMALL = WS_T + 48 * MiB;
constexpr size_t WS_PE = WS_SMALL + 2 * MiB;
constexpr size_t WS_DCT = WS_PE + 64 * MiB;
constexpr size_t WS_CT = WS_DCT + 64 * MiB;
constexpr size_t WS_MLS = WS_CT + 64 * MiB;
constexpr size_t WS_NSA = WS_MLS + 2 * MiB;
constexpr size_t WS_OC = WS_NSA + 2 * MiB;
constexpr size_t WS_OW = WS_OC + 32 * MiB;
constexpr size_t WS_HB8 = WS_OW + 32 * MiB;
constexpr size_t WS_W8 = WS_HB8 + 32 * MiB;
constexpr size_t WS_Y8 = WS_W8 + 28 * MiB;
constexpr size_t WS_WO8 = WS_Y8 + 16 * MiB;
constexpr size_t WS_Z = WS_WO8 + 8 * MiB;
constexpr size_t WS_CP = WS_Z + 8 * MiB;
constexpr size_t WS_END = WS_CP + 1 * MiB;

struct Params {
    const float *x, *p, *norm_w, *w_in, *conv_w, *i_bias, *f_bias, *hnorm_w, *qnorm_w, *knorm_w, *pe_k, *pe_v, *k_w1, *k_w2, *v_w1, *v_w2, *rel_bias, *w_out, *ple_proj, *ple_gate;
    float* out;
    unsigned char* ws;
    __device__ __forceinline__ unsigned* ctl() const { return (unsigned*)(ws + (WS_CTL)); }
    __device__ __forceinline__ bf16_t* hb() const { return (bf16_t*)(ws + (WS_HB)); }
    __device__ __forceinline__ bf16_t* Wt() const { return (bf16_t*)(ws + (WS_WT)); }
    __device__ __forceinline__ bf16_t* WoT() const { return (bf16_t*)(ws + (WS_WOT)); }
    __device__ __forceinline__ bf16_t* WgT() const { return (bf16_t*)(ws + (WS_WGT)); }
    __device__ __forceinline__ bf16_t* WpT() const { return (bf16_t*)(ws + (WS_WPT)); }
    __device__ __forceinline__ bf16_t* pb() const { return (bf16_t*)(ws + (WS_PB)); }
    __device__ __forceinline__ bf16_t* w1kT() const { return (bf16_t*)(ws + (WS_W1K)); }
    __device__ __forceinline__ bf16_t* w1vT() const { return (bf16_t*)(ws + (WS_W1V)); }
    __device__ __forceinline__ bf16_t* w2kT() const { return (bf16_t*)(ws + (WS_W2)); }
    __device__ __forceinline__ bf16_t* w2vT() const { return (bf16_t*)(ws + (WS_W2 + 65536)); }
    __device__ __forceinline__ bf16_t* U() const { return (bf16_t*)(ws + (WS_U)); }
    __device__ __forceinline__ bf16_t* T() const { return (bf16_t*)(ws + (WS_T)); }
    __device__ __forceinline__ float* small() const { return (float*)(ws + (WS_SMALL)); }
    __device__ __forceinline__ bf16_t* y() const { return (bf16_t*)(ws + (WS_HB)); }
    __device__ __forceinline__ bf16_t* x1b() const { return (bf16_t*)(ws + (WS_WT)); }
    __device__ __forceinline__ bf16_t* pe() const { return (bf16_t*)(ws + (WS_PE)); }
    __device__ __forceinline__ bf16_t* dCt() const { return (bf16_t*)(ws + (WS_DCT)); }
    __device__ __forceinline__ bf16_t* Ct() const { return (bf16_t*)(ws + (WS_CT)); }
    __device__ __forceinline__ float* dn() const { return (float*)(ws + (WS_MLS)); }
    __device__ __forceinline__ float* nst() const { return (float*)(ws + (WS_MLS + 4 * 131072)); }
    __device__ __forceinline__ float* cbL() const { return (float*)(ws + (WS_MLS + 4 * 262144)); }
    __device__ __forceinline__ float* cgmax() const { return (float*)(ws + (WS_MLS + 4 * 263168)); }
    __device__ __forceinline__ float* cm() const { return (float*)(ws + (WS_MLS + 4 * 264192)); }
    __device__ __forceinline__ float* mb() const { return (float*)(ws + (WS_MLS + 4 * 265216)); }
    __device__ __forceinline__ float* mg() const { return (float*)(ws + (WS_MLS + 4 * (265216 + 65536))); }
    __device__ __forceinline__ bf16_t* kcmp() const { return (bf16_t*)(ws + (WS_NSA)); }
    __device__ __forceinline__ bf16_t* vcmpT() const { return (bf16_t*)(ws + (WS_NSA + 524288)); }
    __device__ __forceinline__ unsigned long long* sel() const { return (unsigned long long*)(ws + (WS_NSA + 1048576)); }
    __device__ __forceinline__ unsigned long long* selu() const { return (unsigned long long*)(ws + (WS_NSA + 1048576 + 262144)); }
    __device__ __forceinline__ bf16_t* oc() const { return (bf16_t*)(ws + (WS_OC)); }
    __device__ __forceinline__ bf16_t* ow() const { return (bf16_t*)(ws + (WS_OW)); }
    __device__ __forceinline__ unsigned char* hb8() const { return (unsigned char*)(ws + (WS_HB8)); }
    __device__ __forceinline__ unsigned char* W8() const { return (unsigned char*)(ws + (WS_W8)); }
    __device__ __forceinline__ unsigned char* y8() const { return (unsigned char*)(ws + (WS_Y8)); }
    __device__ __forceinline__ unsigned char* Wo8() const { return (unsigned char*)(ws + (WS_WO8)); }
    __device__ __forceinline__ float* Z() const { return (float*)(ws + (WS_Z)); }
    __device__ __forceinline__ float* cpart() const { return (float*)(ws + (WS_CP)); }
};
__host__ __device__ inline void fill_params(Params& P, void* const* d_in, void* d_out, void* d_ws) {
    const float* const* in = (const float* const*)d_in;
    P.x = in[0]; P.p = in[1]; P.norm_w = in[2]; P.w_in = in[3]; P.conv_w = in[4]; P.i_bias = in[5]; P.f_bias = in[6]; P.hnorm_w = in[7]; P.qnorm_w = in[8]; P.knorm_w = in[9];
    P.pe_k = in[10]; P.pe_v = in[11]; P.k_w1 = in[12]; P.k_w2 = in[13]; P.v_w1 = in[14]; P.v_w2 = in[15]; P.rel_bias = in[16]; P.w_out = in[17]; P.ple_proj = in[18]; P.ple_gate = in[19];
    P.out = (float*)d_out; P.ws = (unsigned char*)d_ws;
}

__device__ __forceinline__ void p0_transpose_item(const float* W, int K, int N, bf16_t* WT, LAS float* scr, int item, int lane, bool remap, unsigned char* P8, const float* pev = nullptr, float* cp = nullptr) {
    const int nblk = N / 32, kb = item / nblk, nb = item % nblk, k0 = 64 * kb, n0 = 32 * nb;
#pragma unroll 8
    for (int i = 0; i < 32; ++i) { const int kk = 2 * i + (lane >> 5); scr[kk * 33 + (lane & 31)] = W[(size_t)(k0 + kk) * N + n0 + (lane & 31)]; }
    asm volatile("s_waitcnt lgkmcnt(0)" ::: "memory");
    if (pev != nullptr) {
        const int n = lane & 31, kh = lane >> 5; float s = 0.f;
#pragma unroll 8
        for (int kk = 0; kk < 32; ++kk) s += scr[(kh * 32 + kk) * 33 + n] * pev[k0 + kh * 32 + kk];
        s += __shfl_xor(s, 32);
        if (lane < 32) cp[(size_t)kb * N + n0 + n] = s;
    }
    const int c = lane & 7;
#pragma unroll
    for (int j = 0; j < 4; ++j) { const int n = (lane >> 3) + 8 * j; const LAS float* s = scr + (8 * c) * 33 + n;
        u32x4 o; o.x = pk2(s[0 * 33], s[1 * 33]); o.y = pk2(s[2 * 33], s[3 * 33]); o.z = pk2(s[4 * 33], s[5 * 33]); o.w = pk2(s[6 * 33], s[7 * 33]);
        const int dr = remap ? wt_row(n0 + n) : (n0 + n);
        int r8 = remap ? w8_row(dr) : -1; int kk8 = k0;
        if (!remap && P8 != nullptr && k0 >= 2048) { r8 = dr; kk8 = k0 - 2048; }
        const size_t pitch8 = remap ? 4096 : 2048;
        if (r8 < 0) *(u32x4*)(WT + (size_t)dr * K + k0 + 8 * c) = o;
        else { u32x2 q8; q8.x = pk_fp8x4(64.f * s[0 * 33], 64.f * s[1 * 33], 64.f * s[2 * 33], 64.f * s[3 * 33]); q8.y = pk_fp8x4(64.f * s[4 * 33], 64.f * s[5 * 33], 64.f * s[6 * 33], 64.f * s[7 * 33]);
               *(u32x2*)(P8 + (size_t)r8 * pitch8 + kk8 + 8 * c) = q8; } }
    asm volatile("s_waitcnt lgkmcnt(0)" ::: "memory");
}
__device__ __forceinline__ void p0_norm_row(const float* xrow, const float* w, bf16_t* orow, unsigned char* orow8, int lane) {
    const f32x4* xr = (const f32x4*)xrow + lane; const f32x4* wr = (const f32x4*)w + lane;
    f32x4 v[16]; float s = 0.f;
#pragma unroll
    for (int j = 0; j < 16; ++j) { v[j] = xr[64 * j]; s += (v[j][0] * v[j][0] + v[j][1] * v[j][1]) + (v[j][2] * v[j][2] + v[j][3] * v[j][3]); }
    const float rstd = 1.f / sqrtf(wave_sum(s) * (1.f / DM) + EPS);
    u32x2* o8 = (u32x2*)orow + lane;
#pragma unroll
    for (int j = 0; j < 16; ++j) { const f32x4 ww = wr[64 * j]; const float h0 = v[j][0] * rstd * ww[0], h1 = v[j][1] * rstd * ww[1], h2 = v[j][2] * rstd * ww[2], h3 = v[j][3] * rstd * ww[3];
        u32x2 o; o.x = pk2(h0, h1); o.y = pk2(h2, h3); o8[64 * j] = o;
        ((unsigned*)orow8)[lane + 64 * j] = pk_fp8x4(h0, h1, h2, h3); }
}
__device__ __forceinline__ void phase0(const Params& P, LAS unsigned char* lds_, int bid, int nblk) {
    LAS unsigned char* lds = opq(lds_);
    const int tid = opaque_tid(), lane = tid & 63, wave = tid >> 6;
    LAS float* scr = (LAS float*)(lds + wave * 8704);
    const int gw = bid * 8 + wave, NGW = nblk * 8;
    constexpr int I_IN = (DM / 64) * (INW / 32), I_SQ = (DM / 64) * (DM / 32), I_PP = (256 / 64) * (DM / 32), I_W1 = (DM / 64) * (256 / 32), I_W2 = (256 / 64) * (128 / 32);
    constexpr int NITEMS = I_IN + 2 * I_SQ + I_PP + 2 * I_W1 + 2 * I_W2;
    for (int it = gw; it < NITEMS; it += NGW) {
        int r = it;
        if (r < I_IN) { p0_transpose_item(P.w_in, DM, INW, P.Wt(), scr, r, lane, true, P.W8()); continue; } r -= I_IN;
        if (r < I_SQ) { p0_transpose_item(P.w_out, DM, DM, P.WoT(), scr, r, lane, false, P.Wo8()); continue; } r -= I_SQ;
        if (r < I_SQ) { p0_transpose_item(P.ple_gate, DM, DM, P.WgT(), scr, r, lane, false, nullptr); continue; } r -= I_SQ;
        if (r < I_PP) { p0_transpose_item(P.ple_proj, 256, DM, P.WpT(), scr, r, lane, false, nullptr); continue; } r -= I_PP;
        if (r < I_W1) { p0_transpose_item(P.k_w1, DM, 256, P.w1kT(), scr, r, lane, false, nullptr, P.pe_k, P.cpart()); continue; } r -= I_W1;
        if (r < I_W1) { p0_transpose_item(P.v_w1, DM, 256, P.w1vT(), scr, r, lane, false, nullptr, P.pe_v, P.cpart() + 64 * 256); continue; } r -= I_W1;
        if (r < I_W2) { p0_transpose_item(P.k_w2, 256, 128, P.w2kT(), scr, r, lane, false, nullptr); continue; } r -= I_W2;
        p0_transpose_item(P.v_w2, 256, 128, P.w2vT(), scr, r, lane, false, nullptr);
    }
    for (int m = gw; m < MTOK; m += NGW) p0_norm_row(P.x + (size_t)m * DM, P.norm_w, P.hb() + (size_t)m * DM, P.hb8() + (size_t)m * DM, lane);
    for (size_t i = (size_t)bid * 512 + tid; i < (size_t)MTOK * 256 / 8; i += (size_t)nblk * 512) {
        const f32x4 a = ((const f32x4*)P.p)[2 * i], b = ((const f32x4*)P.p)[2 * i + 1];
        u32x4 o; o.x = pk2(a[0], a[1]); o.y = pk2(a[2], a[3]); o.z = pk2(b[0], b[1]); o.w = pk2(b[2], b[3]); ((u32x4*)P.pb())[i] = o; }
    { u32x4* z = (u32x4*)(P.Wt() + (size_t)(WT_SMALL + 64) * DM); const size_t n = (size_t)(WT_T - WT_SMALL - 64) * DM / 8;
      for (size_t i = (size_t)bid * 512 + tid; i < n; i += (size_t)nblk * 512) z[i] = (u32x4){0u, 0u, 0u, 0u}; }
}

__device__ __forceinline__ void phase_gemm1(const Params& P, LAS unsigned char* lds, int bid, int nblk) {
    EpiStore E{P.U(), P.small(), P.T(), nullptr, 0};
    { pg8::SchedG1B S; S.hb = (const char*)P.hb(); S.wt = (const char*)P.Wt(); S.G = nblk; S.c = bid;
      pg8::gemm_phase<EpiStore, pg8::SchedG1B, false>(lds, DM, S, E); }
    { pg8::SchedG1F S; S.hb8 = (const char*)P.hb8(); S.w8 = (const char*)P.W8(); S.G = nblk; S.c = bid;
      pg8::gemm_phase<EpiStore, pg8::SchedG1F, true>(lds, DM / 2, S, E); }
}
__device__ __forceinline__ void phase_gemm_pe(const Params& P, LAS unsigned char* lds, int bid, int nblk) {
    if (bid < 0) return;
    pg8::Sched2 S; S.K = 256; S.G = nblk; S.c = bid;
    S.a0 = (const char*)P.pb(); S.b0 = (const char*)P.WpT(); S.nM0 = MTOK / 256; S.nN0 = DM / 256; S.kind0 = 2;
    S.a1 = nullptr; S.b1 = nullptr; S.nM1 = 0; S.nN1 = 0; S.kind1 = 2;
    EpiStore E{nullptr, nullptr, nullptr, P.pe(), DM};
    pg8::gemm_phase<EpiStore, pg8::Sched2>(lds, 256, S, E);
}
__device__ __forceinline__ void phase_gemm2(const Params& P, LAS unsigned char* lds, int bid, int nblk) {
    pg8::SchedM S; S.a = (const char*)P.y(); S.b = (const char*)P.WoT(); S.a8 = (const char*)P.y8(); S.b8 = (const char*)P.Wo8(); S.nM = MTOK / 256; S.nN = DM / 256; S.G = nblk; S.c = bid;
    EpiRes E{P.x, P.x1b()};
    pg8::gemm_phase_mixed<EpiRes>(lds, S, E);
}
__device__ __forceinline__ void phase_gemm3(const Params& P, LAS unsigned char* lds, int bid, int nblk) {
    pg8::Sched2 S; S.K = DM; S.G = nblk; S.c = bid;
    S.a0 = (const char*)P.x1b(); S.b0 = (const char*)P.WgT(); S.nM0 = MTOK / 256; S.nN0 = DM / 256; S.kind0 = 0;
    S.a1 = nullptr; S.b1 = nullptr; S.nM1 = 0; S.nN1 = 0; S.kind1 = 0;
    EpiGate E{P.out, P.x1b(), P.pe()};
    pg8::gemm_phase<EpiGate, pg8::Sched2>(lds, DM, S, E);
}

#define MFMA16(a, b, c) __builtin_amdgcn_mfma_f32_16x16x32_bf16((a), (b), (c), 0, 0, 0)
__device__ __forceinline__ bf16x8 mk_frag(u32x4 w) { return __builtin_bit_cast(bf16x8, w); }
__device__ __forceinline__ bf16x8 mk_frag2(u32x2 lo, u32x2 hi) { u32x4 w; w.x = lo.x; w.y = lo.y; w.z = hi.x; w.w = hi.y; return __builtin_bit_cast(bf16x8, w); }

struct ConvW { f32x4 w0[4], w1[4]; };
__device__ __forceinline__ void conv_load_w(const Params& P, int chan0, ConvW& cw) {
#pragma unroll
    for (int j = 0; j < 4; ++j) { cw.w0[j] = *(const f32x4*)(P.conv_w + j * 2048 + chan0); cw.w1[j] = *(const f32x4*)(P.conv_w + j * 2048 + chan0 + 4); }
}
__device__ __forceinline__ void conv_load_x(const Params& P, int b, int spos, int ucol0, u32x4 (&raw)[4]) {
#pragma unroll
    for (int j = 0; j < 4; ++j) { const int ts = spos - 3 + j, tc = ts < 0 ? 0 : ts; raw[j] = *(const u32x4*)(P.U() + (size_t)(b * SEQ + tc) * UW + ucol0); }
}
__device__ __forceinline__ void conv_apply(const ConvW& cw, const u32x4 (&raw)[4], int spos, float (&o)[8]) {
#pragma unroll
    for (int e = 0; e < 8; ++e) o[e] = 0.f;
#pragma unroll
    for (int j = 0; j < 4; ++j) {
        const float z = (spos - 3 + j) < 0 ? 0.f : 1.f;
        o[0] += z * cw.w0[j][0] * bflo(raw[j].x); o[1] += z * cw.w0[j][1] * bfhi(raw[j].x); o[2] += z * cw.w0[j][2] * bflo(raw[j].y); o[3] += z * cw.w0[j][3] * bfhi(raw[j].y);
        o[4] += z * cw.w1[j][0] * bflo(raw[j].z); o[5] += z * cw.w1[j][1] * bfhi(raw[j].z); o[6] += z * cw.w1[j][2] * bflo(raw[j].w); o[7] += z * cw.w1[j][3] * bfhi(raw[j].w);
    }
#pragma unroll
    for (int e = 0; e < 8; ++e) o[e] = siluf_(o[e]);
}

__device__ __forceinline__ void ml_step1(const Params& P, LAS unsigned char* lds_, int task) {
    LAS unsigned char* lds = opq(lds_);
    const int tid = opaque_tid(), lane = tid & 63, wave = tid >> 6, q4 = lane >> 4, l15 = lane & 15, half = wave >> 2, hw = wave & 3, ht = tid & 255;
    const int ch = 2 * task + half;
    const int bh = ch >> 6, c = ch & 63, b = bh >> 3, h = bh & 7, tok0 = b * SEQ + c * 64;
    LAS bf16_t* kT = (LAS bf16_t*)(lds + half * 18944);
    LAS float* wk = (LAS float*)(lds + half * 18944 + 18432);
    if (hw == 0) {
        const float fi = P.small()[(size_t)(tok0 + lane) * 64 + h] + P.i_bias[h];
        const float ff = P.small()[(size_t)(tok0 + lane) * 64 + 8 + h] + P.f_bias[h];
        const float lf = fminf(ff, 0.f) - log1pf(expf(-fabsf(ff)));
        float bc = lf;
#pragma unroll
        for (int o = 1; o < 64; o <<= 1) { const float v = shfl_up_l(bc, o, lane); if (lane >= o) bc += v; }
        const float g = fi - bc; const float gm = wave_max(g);
        const float bL = __builtin_bit_cast(float, __builtin_amdgcn_readlane(__builtin_bit_cast(int, bc), 63));
        wk[lane] = expf(g - gm);
        P.mb()[(size_t)bh * SEQ + c * 64 + lane] = bc; P.mg()[(size_t)bh * SEQ + c * 64 + lane] = g;
        if (lane == 0) { P.cbL()[ch] = bL; P.cgmax()[ch] = gm; }
    }
    float kv[4][8];
    { ConvW cw; conv_load_w(P, 1024 + h * 128 + (ht & 15) * 8, cw);
      u32x4 raw[4][4];
#pragma unroll
      for (int i = 0; i < 4; ++i) { const int id = ht + 256 * i, s = id >> 4, d8 = id & 15; conv_load_x(P, b, c * 64 + s, UK + h * 128 + d8 * 8, raw[i]); }
#pragma unroll
      for (int i = 0; i < 4; ++i) { const int id = ht + 256 * i, s = id >> 4; conv_apply(cw, raw[i], c * 64 + s, kv[i]); } }
    __syncthreads();
#pragma unroll
    for (int i = 0; i < 4; ++i) {
        const int id = ht + 256 * i, s = id >> 4, d8 = id & 15;
        const float sc = wk[s] * 0.08838834764831845f;
#pragma unroll
        for (int e = 0; e < 8; ++e) kT[(d8 * 8 + e) * 72 + s] = (bf16_t)f2bf(kv[i][e] * sc);
    }
    __syncthreads();
    if (ht < 128) { float s = 0.f; for (int j = 0; j < 64; ++j) s += bf2f(kT[ht * 72 + j]); P.dn()[(size_t)ch * 128 + ht] = s; }
    bf16x8 af[2][2];
#pragma unroll
    for (int dt = 0; dt < 2; ++dt)
#pragma unroll
        for (int ks = 0; ks < 2; ++ks) af[dt][ks] = *(const LAS bf16x8*)(kT + (32 * hw + 16 * dt + l15) * 72 + 32 * ks + 8 * q4);
    const bf16_t* vbase = P.T() + (size_t)(TV + h * 256 + l15) * MTOK + tok0 + 8 * q4;
#pragma unroll 8
    for (int vt = 0; vt < 16; ++vt) {
        bf16x8 bfr[2];
#pragma unroll
        for (int ks = 0; ks < 2; ++ks) bfr[ks] = mk_frag(*(const u32x4*)(vbase + (size_t)(16 * vt) * MTOK + 32 * ks));
#pragma unroll
        for (int dt = 0; dt < 2; ++dt) {
            f32x4 acc = {0.f, 0.f, 0.f, 0.f};
#pragma unroll
            for (int ks = 0; ks < 2; ++ks) acc = MFMA16(af[dt][ks], bfr[ks], acc);
            u32x2 w; w.x = pk2(acc[0], acc[1]); w.y = pk2(acc[2], acc[3]);
            *(u32x2*)(P.dCt() + ((size_t)ch * 256 + 16 * vt + l15) * 128 + 32 * hw + 16 * dt + 4 * q4) = w;
        }
    }
    __syncthreads();
}

__device__ __forceinline__ void ml_step2(const Params& P, int bh, int part) {
    const int tid = opaque_tid(), lane = tid & 63; const size_t e4 = ((size_t)part * 512 + tid) * 4;
    const float bLl = P.cbL()[bh * 64 + lane], gml = P.cgmax()[bh * 64 + lane];
    float decl = 0.f, scl = 0.f, ml = 0.f;
    {
        float m = 0.f;
#pragma unroll
        for (int c = 0; c < 64; ++c) {
            const float bL = __builtin_bit_cast(float, __builtin_amdgcn_readlane(__builtin_bit_cast(int, bLl), c)), gm = __builtin_bit_cast(float, __builtin_amdgcn_readlane(__builtin_bit_cast(int, gml), c));
            const float mn = fmaxf(bL + m, bL + gm), dec = expf(bL + m - mn), sc = expf(bL + gm - mn);
            if (lane == c) { decl = dec; scl = sc; ml = m; }
            m = mn;
        }
    }
    if (part == 0 && tid < 64) P.cm()[bh * 64 + tid] = ml;
    const bool do_n = (part == 0 && tid < 128);
    f32x4 C = {0.f, 0.f, 0.f, 0.f}; float nn = 0.f;
    const bf16_t* __restrict__ dsrc = P.dCt() + (size_t)bh * 64 * 32768 + e4;
    bf16_t* __restrict__ cdst = P.Ct() + (size_t)bh * 64 * 32768 + e4;
    for (int c0 = 0; c0 < 64; c0 += 8) {
        u32x2 d[8]; float dnv[8];
#pragma unroll
        for (int i = 0; i < 8; ++i) { d[i] = *(const u32x2*)(dsrc + (size_t)(c0 + i) * 32768); dnv[i] = do_n ? P.dn()[(size_t)(bh * 64 + c0 + i) * 128 + tid] : 0.f; }
#pragma unroll
        for (int i = 0; i < 8; ++i) {
            const int c = c0 + i;
            { u32x2 w; w.x = pk2(C[0], C[1]); w.y = pk2(C[2], C[3]); *(u32x2*)(cdst + (size_t)c * 32768) = w; }
            if (do_n) P.nst()[(size_t)(bh * 64 + c) * 128 + tid] = nn;
            const float decc = __builtin_bit_cast(float, __builtin_amdgcn_readlane(__builtin_bit_cast(int, decl), c)), scc = __builtin_bit_cast(float, __builtin_amdgcn_readlane(__builtin_bit_cast(int, scl), c));
            C[0] = decc * C[0] + scc * bflo(d[i].x); C[1] = decc * C[1] + scc * bfhi(d[i].x); C[2] = decc * C[2] + scc * bflo(d[i].y); C[3] = decc * C[3] + scc * bfhi(d[i].y);
            nn = decc * nn + scc * dnv[i];
        }
    }
}

__device__ __forceinline__ void ml_step3(const Params& P, LAS unsigned char* lds_, int task) {
    LAS unsigned char* lds = opq(lds_);
    const int tid = opaque_tid(), lane = tid & 63, wave = tid >> 6, q4 = lane >> 4, l15 = lane & 15, half = wave >> 2, tq = wave & 3, ht = tid & 255;
    const int ch = 2 * task + half;
    const int bh = ch >> 6, c = ch & 63, b = bh >> 3, h = bh & 7, tok0 = b * SEQ + c * 64;
    LAS unsigned char* hl = lds + half * 36864;
    LAS bf16_t* qs = (LAS bf16_t*)hl;
    LAS bf16_t* ks_ = (LAS bf16_t*)(hl + 17408);
    LAS float* fb = (LAS float*)(hl + 34816);
    LAS float* fg = fb + 64;
    LAS float* fpm = fb + 128;
#pragma unroll
    for (int isk = 0; isk < 2; ++isk) {
        ConvW cw; conv_load_w(P, isk * 1024 + h * 128 + (ht & 15) * 8, cw);
        u32x4 raw[4][4];
#pragma unroll
        for (int i = 0; i < 4; ++i) { const int id = ht + 256 * i, s = id >> 4, d8 = id & 15; conv_load_x(P, b, c * 64 + s, (isk ? UK : UQ) + h * 128 + d8 * 8, raw[i]); }
#pragma unroll
        for (int i = 0; i < 4; ++i) { const int id = ht + 256 * i, s = id >> 4, d8 = id & 15;
            float o[8]; conv_apply(cw, raw[i], c * 64 + s, o);
            const float sc = isk ? 0.08838834764831845f : 1.f;
            u32x4 w; w.x = pk2(o[0] * sc, o[1] * sc); w.y = pk2(o[2] * sc, o[3] * sc); w.z = pk2(o[4] * sc, o[5] * sc); w.w = pk2(o[6] * sc, o[7] * sc);
            *(LAS u32x4*)((isk ? ks_ : qs) + s * 136 + d8 * 8) = w; }
    }
    if (tq == 0) {
        const float bc = P.mb()[(size_t)bh * SEQ + c * 64 + lane], g = P.mg()[(size_t)bh * SEQ + c * 64 + lane];
        float pm = g;
#pragma unroll
        for (int o = 1; o < 64; o <<= 1) { const float v = shfl_up_l(pm, o, lane); if (lane >= o) pm = fmaxf(pm, v); }
        fb[lane] = bc; fg[lane] = g; fpm[lane] = pm;
    }
    const float m_c = P.cm()[ch];
    const int t = 16 * tq + l15;
    const size_t tok = (size_t)(tok0 + t);
    __syncthreads();
    u32x4 cst[4], vst[2];
#define ML3_LOAD(B) do { \
        _Pragma("unroll") for (int i = 0; i < 4; ++i) { const int id = ht + 256 * i; cst[i] = *(const u32x4*)(P.Ct() + ((size_t)ch * 256 + 64 * (B) + (id >> 4)) * 128 + 8 * (id & 15)); } \
        _Pragma("unroll") for (int i = 0; i < 2; ++i) { const int id = ht + 256 * i; vst[i] = *(const u32x4*)(P.T() + (size_t)(TV + h * 256 + 64 * (B) + (id >> 3)) * MTOK + tok0 + 8 * (id & 7)); } } while (0)
#define ML3_SB(BUF) ((BUF) ? hl : lds + 73728 + half * 28672)
#define ML3_WRITE(BUF) do { LAS bf16_t* cts_ = (LAS bf16_t*)ML3_SB(BUF); LAS bf16_t* vts_ = (LAS bf16_t*)(ML3_SB(BUF) + 17408); \
        _Pragma("unroll") for (int i = 0; i < 4; ++i) { const int id = ht + 256 * i; *(LAS u32x4*)(cts_ + (id >> 4) * 136 + 8 * (id & 15)) = cst[i]; } \
        _Pragma("unroll") for (int i = 0; i < 2; ++i) { const int id = ht + 256 * i; *(LAS u32x4*)(vts_ + (id >> 3) * 72 + 8 * (id & 7)) = vst[i]; } } while (0)
    ML3_LOAD(0);
    bf16x8 qf[4];
#pragma unroll
    for (int ks = 0; ks < 4; ++ks) qf[ks] = *(const LAS bf16x8*)(qs + t * 136 + 32 * ks + 8 * q4);
    const float Mt = fmaxf(m_c, fpm[t]);
    float sc[4][4]; float rowsum = 0.f;
#pragma unroll
    for (int st = 0; st < 4; ++st) {
        f32x4 a = {0.f, 0.f, 0.f, 0.f};
#pragma unroll
        for (int ks = 0; ks < 4; ++ks) { const bf16x8 kf = *(const LAS bf16x8*)(ks_ + (16 * st + l15) * 136 + 32 * ks + 8 * q4); a = MFMA16(kf, qf[ks], a); }
#pragma unroll
        for (int r = 0; r < 4; ++r) { const int s = 16 * st + 4 * q4 + r; const float v = (s <= t) ? a[r] * __expf(fg[s] - Mt) : 0.f; sc[st][r] = v; rowsum += v; }
    }
    rowsum = xq_sum(rowsum);
    bf16x8 pf[2];
#pragma unroll
    for (int k2 = 0; k2 < 2; ++k2) { u32x4 w; w.x = pk2(sc[2 * k2][0], sc[2 * k2][1]); w.y = pk2(sc[2 * k2][2], sc[2 * k2][3]); w.z = pk2(sc[2 * k2 + 1][0], sc[2 * k2 + 1][1]); w.w = pk2(sc[2 * k2 + 1][2], sc[2 * k2 + 1][3]); pf[k2] = mk_frag(w); }
    float qn = 0.f;
    { const float* np = P.nst() + (size_t)ch * 128;
#pragma unroll
      for (int ks = 0; ks < 4; ++ks) { const f32x4 n0 = *(const f32x4*)(np + 32 * ks + 8 * q4), n1 = *(const f32x4*)(np + 32 * ks + 8 * q4 + 4);
          const u32x4 qw = __builtin_bit_cast(u32x4, qf[ks]);
          qn += bflo(qw.x) * n0[0] + bfhi(qw.x) * n0[1] + bflo(qw.y) * n0[2] + bfhi(qw.y) * n0[3] + bflo(qw.z) * n1[0] + bfhi(qw.z) * n1[1] + bflo(qw.w) * n1[2] + bfhi(qw.w) * n1[3]; }
      qn = xq_sum(qn); }
    const float inter = __expf(m_c - Mt);
    const float den = inter * qn + rowsum;
    const float inv = 1.f / fmaxf(fabsf(den), __expf(-(fb[t] + Mt)));
    f32x4 hv[16]; float ss = 0.f;
    __syncthreads();
#pragma unroll
    for (int vb = 0; vb < 4; ++vb) {
        ML3_WRITE(vb & 1);
        if (vb < 3) ML3_LOAD(vb + 1);
        __syncthreads();
        const LAS bf16_t* cts = (const LAS bf16_t*)ML3_SB(vb & 1) + l15 * 136 + 8 * q4;
        const LAS bf16_t* vts = (const LAS bf16_t*)(ML3_SB(vb & 1) + 17408) + l15 * 72 + 4 * q4;
#pragma unroll
        for (int v = 0; v < 4; ++v) { const int vt = 4 * vb + v;
            f32x4 a1 = {0.f, 0.f, 0.f, 0.f}, a2 = {0.f, 0.f, 0.f, 0.f};
#pragma unroll
            for (int ks = 0; ks < 4; ++ks) a1 = MFMA16(*(const LAS bf16x8*)(cts + (16 * v) * 136 + 32 * ks), qf[ks], a1);
#pragma unroll
            for (int k2 = 0; k2 < 2; ++k2) { const LAS bf16_t* vp = vts + (16 * v) * 72 + 32 * k2; a2 = MFMA16(mk_frag2(*(const LAS u32x2*)vp, *(const LAS u32x2*)(vp + 16)), pf[k2], a2); }
#pragma unroll
            for (int r = 0; r < 4; ++r) { const float hh = (inter * a1[r] + a2[r]) * inv; hv[vt][r] = hh; ss += hh * hh; } }
    }
#undef ML3_LOAD
#undef ML3_SB
#undef ML3_WRITE
    ss = xq_sum(ss);
    const float rstd = __builtin_amdgcn_rsqf(ss * (1.f / 256.f) + EPS);
    {
        u32x2 owv[16], zwv[16]; f32x4 nwv[16];
#pragma unroll
        for (int vt = 0; vt < 16; ++vt) { const int v = 16 * vt + 4 * q4;
            owv[vt] = *(const u32x2*)(P.U() + tok * UW + UO + h * 256 + v); zwv[vt] = *(const u32x2*)(P.U() + tok * UW + UZ + h * 256 + v); nwv[vt] = *(const f32x4*)(P.hnorm_w + h * 256 + v); }
        __builtin_amdgcn_sched_barrier(0);
#pragma unroll
        for (int vt = 0; vt < 16; ++vt) {
            const int v = 16 * vt + 4 * q4;
            const u32x2 ow = owv[vt], zw = zwv[vt]; const f32x4 nw = nwv[vt];
            const float o0 = bflo(ow.x), o1 = bfhi(ow.x), o2 = bflo(ow.y), o3 = bfhi(ow.y), z0 = bflo(zw.x), z1 = bfhi(zw.x), z2 = bflo(zw.y), z3 = bfhi(zw.y);
            const float y0 = hv[vt][0] * rstd * nw[0] * sigmoidf_(o0) * siluf_(z0), y1 = hv[vt][1] * rstd * nw[1] * sigmoidf_(o1) * siluf_(z1);
            const float y2 = hv[vt][2] * rstd * nw[2] * sigmoidf_(o2) * siluf_(z2), y3 = hv[vt][3] * rstd * nw[3] * sigmoidf_(o3) * siluf_(z3);
            u32x2 w; w.x = pk2(y0, y1); w.y = pk2(y2, y3);
            *(u32x2*)(P.y() + tok * DM + h * 256 + v) = w;
        }
    }
    __syncthreads();
}

constexpr float LOG2E = 1.4426950408889634f;
__device__ __forceinline__ void cmp_gemm_task(const Params& P, LAS unsigned char* lds, int unit) {
    pg8::SchedC S; S.U = (const char*)P.U(); S.w1k = (const char*)P.w1kT(); S.w1v = (const char*)P.w1vT(); S.ukc = UKC; S.uvc = UVC; S.unit = unit;
    EpiZ E{P.Z()};
    pg8::gemm_cmp<EpiZ>(lds, S, E);
    __syncthreads();
}
__device__ __forceinline__ void cmp_task(const Params& P, LAS unsigned char* lds_, int task) {
    LAS unsigned char* lds = opq(lds_);
    const int tid = opaque_tid(), lane = tid & 63, wave = tid >> 6, q4 = lane >> 4, l15 = lane & 15;
    const int kv = task & 1, bg = (task >> 1) & 7, it = task >> 4;
    LAS float* cs = (LAS float*)lds;
    LAS bf16_t* H1 = (LAS bf16_t*)(lds + 16384);
    LAS float* O2 = (LAS float*)(lds + 33280);
    const bf16_t* w2T = kv ? P.w2vT() : P.w2kT();
    if (tid < 256) { const float* cp = P.cpart() + (size_t)kv * 64 * 256 + tid; float s = 0.f;
#pragma unroll 16
        for (int kb = 0; kb < 64; ++kb) s += cp[kb * 256];
        cs[tid] = s; }
    __syncthreads();
    { const int m = tid >> 4, n0 = (tid & 15) * 16, i = 32 * it + m, i1 = i + 1 > 255 ? 255 : i + 1;
      const float* z0 = P.Z() + ((size_t)(kv * 8 + bg) * 256 + i) * 512 + n0; const float* z1 = P.Z() + ((size_t)(kv * 8 + bg) * 256 + i1) * 512 + 256 + n0;
#pragma unroll
      for (int j = 0; j < 4; ++j) { const f32x4 a = *(const f32x4*)(z0 + 4 * j), b = *(const f32x4*)(z1 + 4 * j), c = *(const LAS f32x4*)(cs + n0 + 4 * j);
          u32x2 w; w.x = pk2(siluf_(a[0] + b[0] + c[0]), siluf_(a[1] + b[1] + c[1])); w.y = pk2(siluf_(a[2] + b[2] + c[2]), siluf_(a[3] + b[3] + c[3]));
          *(LAS u32x2*)(H1 + m * 264 + n0 + 4 * j) = w; } }
    __syncthreads();
    {
        f32x4 a2[2] = {(f32x4){0.f, 0.f, 0.f, 0.f}, (f32x4){0.f, 0.f, 0.f, 0.f}};
#pragma unroll
        for (int ks = 0; ks < 8; ++ks) {
            const bf16x8 af = mk_frag(*(const u32x4*)(w2T + (size_t)(16 * wave + l15) * 256 + 32 * ks + 8 * q4));
#pragma unroll
            for (int mt = 0; mt < 2; ++mt) { const bf16x8 bf = *(const LAS bf16x8*)(H1 + (16 * mt + l15) * 264 + 32 * ks + 8 * q4); a2[mt] = MFMA16(af, bf, a2[mt]); }
        }
#pragma unroll
        for (int mt = 0; mt < 2; ++mt) *(LAS f32x4*)(O2 + (16 * mt + l15) * 132 + 16 * wave + 4 * q4) = a2[mt];
    }
    __syncthreads();
    if (kv == 0) {
        const int m = 4 * wave + q4, i = 32 * it + m;
        const LAS float* op = O2 + m * 132 + 8 * l15; float v[8]; float ss = 0.f;
#pragma unroll
        for (int e = 0; e < 8; ++e) { v[e] = op[e]; ss += v[e] * v[e]; }
        ss += __shfl_xor(ss, 1); ss += __shfl_xor(ss, 2); ss += __shfl_xor(ss, 4); ss += __shfl_xor(ss, 8);
        const float rstd = (i == 255) ? 0.f : __builtin_amdgcn_rsqf(ss * (1.f / 128.f) + EPS);
        const f32x4 w0 = *(const f32x4*)(P.knorm_w + 8 * l15), w1 = *(const f32x4*)(P.knorm_w + 8 * l15 + 4);
        u32x4 w; w.x = pk2(v[0] * rstd * w0[0], v[1] * rstd * w0[1]); w.y = pk2(v[2] * rstd * w0[2], v[3] * rstd * w0[3]);
        w.z = pk2(v[4] * rstd * w1[0], v[5] * rstd * w1[1]); w.w = pk2(v[6] * rstd * w1[2], v[7] * rstd * w1[3]);
        *(u32x4*)(P.kcmp() + ((size_t)bg * 256 + i) * 128 + 8 * l15) = w;
    } else {
        const int d = tid >> 2, ms = (tid & 3) * 8; float v[8];
#pragma unroll
        for (int e = 0; e < 8; ++e) v[e] = (32 * it + ms + e == 255) ? 0.f : O2[(ms + e) * 132 + d];
        u32x4 w; w.x = pk2(v[0], v[1]); w.y = pk2(v[2], v[3]); w.z = pk2(v[4], v[5]); w.w = pk2(v[6], v[7]);
        *(u32x4*)(P.vcmpT() + ((size_t)bg * 128 + d) * 256 + 32 * it + ms) = w;
    }
    __syncthreads();
}

__device__ __forceinline__ void ksnorm_task(const Params& P, int task) {
    const int tid = opaque_tid(), l16 = tid & 15, r0 = tid >> 4;
    const f32x4 w0 = *(const f32x4*)(P.knorm_w + 128 + 8 * l16), w1 = *(const f32x4*)(P.knorm_w + 128 + 8 * l16 + 4);
#pragma unroll 4
    for (int p = 0; p < 16; ++p) {
        const int row = 32 * p + r0, tok = 128 * task + (row >> 2), g = row & 3;
        bf16_t* ptr = P.U() + (size_t)tok * UW + UKS + g * 128 + 8 * l16;
        const u32x4 raw = *(const u32x4*)ptr;
        float v[8] = {bflo(raw.x), bfhi(raw.x), bflo(raw.y), bfhi(raw.y), bflo(raw.z), bfhi(raw.z), bflo(raw.w), bfhi(raw.w)};
        float ss = 0.f;
#pragma unroll
        for (int e = 0; e < 8; ++e) ss += v[e] * v[e];
        ss = row16_sum(ss);
        const float rstd = __builtin_amdgcn_rsqf(ss * (1.f / 128.f) + EPS);
        u32x4 o; o.x = pk2(v[0] * rstd * w0[0], v[1] * rstd * w0[1]); o.y = pk2(v[2] * rstd * w0[2], v[3] * rstd * w0[3]);
        o.z = pk2(v[4] * rstd * w1[0], v[5] * rstd * w1[1]); o.w = pk2(v[6] * rstd * w1[2], v[7] * rstd * w1[3]);
        *(u32x4*)ptr = o;
    }
}

__device__ __forceinline__ int rel_bucket(int n) {
    if (n < 16) return n;
    int v = 16 + (int)(logf((float)n * (1.f / 16.f)) / 2.0794415416798357f * 16.f);
    return v > 31 ? 31 : v;
}

__device__ __forceinline__ unsigned cvtpk(float lo, float hi) { return pk2(lo, hi); }
template <int MODE>
__device__ __forceinline__ void attn_task(const Params& P, LAS unsigned char* lds_, int bg, int qb) {
    LAS unsigned char* lds = opq(lds_);
    const int tid = opaque_tid(), lane = tid & 63, wave = tid >> 6, q4 = lane >> 4, l15 = lane & 15;
    const int b = bg >> 2, g = bg & 3, hd = wave >> 1, qhalf = wave & 1, head = g * 4 + hd;
    LAS float* tab = (LAS float*)(lds + 35840);
    LAS float* imps = (LAS float*)(lds + 38912);
    LAS unsigned* um = (LAS unsigned*)(lds + 104448);
    for (int i = tid; i < 4 * 129; i += 512) { const int hh = i / 129, dd = i % 129; tab[hh * 132 + dd] = P.rel_bias[rel_bucket(dd) * 16 + g * 4 + hh] * LOG2E; }
    bf16x8 qf[2][4];
#pragma unroll
    for (int qt = 0; qt < 2; ++qt) {
        const size_t tok = (size_t)b * SEQ + 64 * qb + 32 * qhalf + 16 * qt + l15;
        u32x4 raw[4]; float ss = 0.f;
#pragma unroll
        for (int ks = 0; ks < 4; ++ks) { raw[ks] = *(const u32x4*)(P.U() + tok * UW + UNQ + head * 128 + 32 * ks + 8 * q4);
            const float a0 = bflo(raw[ks].x), a1 = bfhi(raw[ks].x), a2 = bflo(raw[ks].y), a3 = bfhi(raw[ks].y), a4 = bflo(raw[ks].z), a5 = bfhi(raw[ks].z), a6 = bflo(raw[ks].w), a7 = bfhi(raw[ks].w);
            ss += a0 * a0 + a1 * a1 + a2 * a2 + a3 * a3 + a4 * a4 + a5 * a5 + a6 * a6 + a7 * a7; }
        ss = xq_sum(ss);
        const float sc = __builtin_amdgcn_rsqf(ss * (1.f / 128.f) + EPS) * (0.08838834764831845f * LOG2E);
#pragma unroll
        for (int ks = 0; ks < 4; ++ks) { const f32x4 w0 = *(const f32x4*)(P.qnorm_w + 32 * ks + 8 * q4), w1 = *(const f32x4*)(P.qnorm_w + 32 * ks + 8 * q4 + 4);
            u32x4 w; w.x = cvtpk(bflo(raw[ks].x) * sc * w0[0], bfhi(raw[ks].x) * sc * w0[1]); w.y = cvtpk(bflo(raw[ks].y) * sc * w0[2], bfhi(raw[ks].y) * sc * w0[3]);
            w.z = cvtpk(bflo(raw[ks].z) * sc * w1[0], bfhi(raw[ks].z) * sc * w1[1]); w.w = cvtpk(bflo(raw[ks].w) * sc * w1[2], bfhi(raw[ks].w) * sc * w1[3]);
            qf[qt][ks] = mk_frag(w); }
    }
    unsigned long long smask[2] = {0ull, 0ull};
    if (MODE == 2) {
#pragma unroll
        for (int qt = 0; qt < 2; ++qt) smask[qt] = P.sel()[(size_t)bg * SEQ + 64 * qb + 32 * qhalf + 16 * qt + l15];
    }
    f32x4 ao[8][2]; f32x4 ai[4][2];
#pragma unroll
    for (int dt = 0; dt < 8; ++dt) { ao[dt][0] = (f32x4){0.f, 0.f, 0.f, 0.f}; ao[dt][1] = (f32x4){0.f, 0.f, 0.f, 0.f}; }
#pragma unroll
    for (int nt = 0; nt < 4; ++nt) { ai[nt][0] = (f32x4){0.f, 0.f, 0.f, 0.f}; ai[nt][1] = (f32x4){0.f, 0.f, 0.f, 0.f}; }
    float mrun[2] = {-1e30f, -1e30f}, lsum[2] = {0.f, 0.f};
    unsigned long long rem;
    if (MODE == 0) { const int jl = qb - 8 < 0 ? 0 : qb - 8; rem = ((2ull << qb) - 1ull) & ~((1ull << jl) - 1ull); }
    else if (MODE == 1) { rem = (2ull << ((4 * qb + 2) >> 6)) - 1ull; }
    else { rem = P.selu()[bg * 64 + qb] & ((2ull << qb) - 1ull); }
    const int krow = tid >> 4, kc16 = tid & 15, vrow = tid >> 3, vc8 = tid & 7;
    const bf16_t* kbase = (MODE == 1) ? P.kcmp() + ((size_t)bg * 256 + krow) * 128 + 8 * kc16 : P.U() + ((size_t)b * SEQ + krow) * UW + (MODE == 0 ? UKW : UKS) + g * 128 + 8 * kc16;
    const size_t kstride = (MODE == 1) ? (size_t)32 * 128 : (size_t)32 * UW;
    const bf16_t* vbase = (MODE == 1) ? P.vcmpT() + ((size_t)bg * 128 + vrow) * 256 + 8 * vc8 : P.T() + (size_t)((MODE == 0 ? TVW : TVS) + g * 128 + vrow) * MTOK + (size_t)b * SEQ + 8 * vc8;
    const size_t vstride = (MODE == 1) ? (size_t)64 * 256 : (size_t)64 * MTOK;
    const size_t ktile = (MODE == 1) ? (size_t)64 * 128 : (size_t)64 * UW;
    f32x4 kw0 = {1.f, 1.f, 1.f, 1.f}, kw1 = {1.f, 1.f, 1.f, 1.f};
    if (MODE == 0) { const float* kw = P.knorm_w + 256 + 8 * kc16; kw0 = *(const f32x4*)kw; kw1 = *(const f32x4*)(kw + 4); }
    u32x4 kr[2], vr[2];
#define AT_LOAD(J) do { _Pragma("unroll") for (int _i = 0; _i < 2; ++_i) { kr[_i] = *(const u32x4*)(kbase + (size_t)(J) * ktile + _i * kstride); vr[_i] = *(const u32x4*)(vbase + (size_t)(J) * 64 + _i * vstride); } } while (0)
    int j = __builtin_ctzll(rem); rem &= rem - 1ull;
    AT_LOAD(j);
    int buf = 0;
    for (;;) {
        LAS bf16_t* Ks = (LAS bf16_t*)(lds + buf * 38912);
        LAS bf16_t* Vs = (LAS bf16_t*)(lds + buf * 38912 + 17408);
#pragma unroll
        for (int i = 0; i < 2; ++i) {
            u32x4 raw = kr[i];
            if (MODE == 0) {
                float v[8] = {bflo(raw.x), bfhi(raw.x), bflo(raw.y), bfhi(raw.y), bflo(raw.z), bfhi(raw.z), bflo(raw.w), bfhi(raw.w)};
                float ss = 0.f;
#pragma unroll
                for (int e = 0; e < 8; ++e) ss += v[e] * v[e];
                ss = row16_sum(ss);
                const float rstd = __builtin_amdgcn_rsqf(ss * (1.f / 128.f) + EPS);
                raw.x = cvtpk(v[0] * rstd * kw0[0], v[1] * rstd * kw0[1]); raw.y = cvtpk(v[2] * rstd * kw0[2], v[3] * rstd * kw0[3]);
                raw.z = cvtpk(v[4] * rstd * kw1[0], v[5] * rstd * kw1[1]); raw.w = cvtpk(v[6] * rstd * kw1[2], v[7] * rstd * kw1[3]);
            }
            *(LAS u32x4*)(Ks + (krow + 32 * i) * 136 + 8 * kc16) = raw;
            *(LAS u32x4*)(Vs + (vrow + 64 * i) * 72 + 8 * vc8) = vr[i];
        }
        __syncthreads();
        const bool more = rem != 0ull; int jn = j;
        if (more) { jn = __builtin_ctzll(rem); rem &= rem - 1ull; if (MODE != 1) AT_LOAD(jn); }
        f32x4 s[4][2];
        {
            const LAS bf16_t* kp = Ks + l15 * 136 + 8 * q4;
            bf16x8 ka[4], kb[4];
#define AT_LDK(dst, kt) do { _Pragma("unroll") for (int ks = 0; ks < 4; ++ks) dst[ks] = *(const LAS bf16x8*)(kp + (16 * (kt)) * 136 + 32 * ks); } while (0)
#define AT_MMS(src, kt) do { s[kt][0] = (f32x4){0.f, 0.f, 0.f, 0.f}; s[kt][1] = (f32x4){0.f, 0.f, 0.f, 0.f}; \
            _Pragma("unroll") for (int ks = 0; ks < 4; ++ks) { s[kt][0] = MFMA16(src[ks], qf[0][ks], s[kt][0]); s[kt][1] = MFMA16(src[ks], qf[1][ks], s[kt][1]); } } while (0)
            AT_LDK(ka, 0); AT_LDK(kb, 1); __builtin_amdgcn_sched_barrier(0);
            AT_MMS(ka, 0); __builtin_amdgcn_sched_barrier(0);
            AT_LDK(ka, 2); __builtin_amdgcn_sched_barrier(0);
            AT_MMS(kb, 1); __builtin_amdgcn_sched_barrier(0);
            AT_LDK(kb, 3); __builtin_amdgcn_sched_barrier(0);
            AT_MMS(ka, 2); __builtin_amdgcn_sched_barrier(0);
            AT_MMS(kb, 3); __builtin_amdgcn_sched_barrier(0);
#undef AT_LDK
#undef AT_MMS
        }
        const bool plain = (MODE == 0) ? (qb - j >= 3 && qb - j <= 7) : (MODE == 2 ? (qb - j >= 3) : false);
        const float cbias = tab[hd * 132 + 128];
        bf16x8 pf[2][2];
#pragma unroll
        for (int qt = 0; qt < 2; ++qt) {
            const int tl = 32 * qhalf + 16 * qt + l15;
            const bool selok = (MODE == 2) ? (((smask[qt] >> j) & 1ull) != 0ull) : true;
            float mx = -INFINITY;
            if (plain) {
                const float cb = selok ? cbias : -INFINITY;
#pragma unroll
                for (int kt = 0; kt < 4; ++kt)
#pragma unroll
                    for (int r = 0; r < 4; ++r) { const float v = s[kt][qt][r] + cb; s[kt][qt][r] = v; mx = fmaxf(mx, v); }
            } else if (MODE == 0) {
#pragma unroll
                for (int kt = 0; kt < 4; ++kt) {
                    float tb[4];
#pragma unroll
                    for (int r = 0; r < 4; ++r) {
                        const int dist = 64 * (qb - j) + tl - (16 * kt + 4 * q4 + r);
                        const int di = dist < 0 ? 0 : (dist > 128 ? 128 : dist);
                        tb[r] = tab[hd * 132 + di];
                    }
                    asm volatile("" : "+v"(tb[0]), "+v"(tb[1]), "+v"(tb[2]), "+v"(tb[3]));
#pragma unroll
                    for (int r = 0; r < 4; ++r) {
                        const int dist = 64 * (qb - j) + tl - (16 * kt + 4 * q4 + r);
                        const bool ok = dist >= 0 && dist < 512;
                        const float v = ok ? s[kt][qt][r] + tb[r] : -INFINITY;
                        s[kt][qt][r] = v; mx = fmaxf(mx, v);
                    }
                }
            } else {
#pragma unroll
                for (int kt = 0; kt < 4; ++kt)
#pragma unroll
                    for (int r = 0; r < 4; ++r) {
                        const int kl = 16 * kt + 4 * q4 + r;
                        int dist; bool ok;
                        if (MODE == 1) { dist = 64 * qb + tl - (16 * (64 * j + kl) + 31); ok = dist >= 0; }
                        else { dist = 64 * (qb - j) + tl - kl; ok = dist >= 0 && selok; if (MODE == 0) ok = ok && dist < 512; }
                        const int di = dist < 0 ? 0 : (dist > 128 ? 128 : dist);
                        const float v = ok ? s[kt][qt][r] + tab[hd * 132 + di] : -INFINITY;
                        s[kt][qt][r] = v; mx = fmaxf(mx, v);
                    }
            }
            mx = xq_max(mx);
            const float mn = fmaxf(mrun[qt], mx), alpha = __builtin_amdgcn_exp2f(mrun[qt] - mn); mrun[qt] = mn;
            float ps = 0.f;
#pragma unroll
            for (int kt = 0; kt < 4; ++kt)
#pragma unroll
                for (int r = 0; r < 4; ++r) { const float p = __builtin_amdgcn_exp2f(s[kt][qt][r] - mn); s[kt][qt][r] = p; ps += p; }
            lsum[qt] = lsum[qt] * alpha + ps;
            if (__ballot(alpha != 1.f) != 0ull) {
#pragma unroll
                for (int dt = 0; dt < 8; ++dt) ao[dt][qt] = ao[dt][qt] * alpha;
                if (MODE == 1) {
#pragma unroll
                    for (int nt = 0; nt < 4; ++nt) ai[nt][qt] = ai[nt][qt] * alpha;
                }
            }
#pragma unroll
            for (int k2 = 0; k2 < 2; ++k2) { u32x4 w; w.x = cvtpk(s[2 * k2][qt][0], s[2 * k2][qt][1]); w.y = cvtpk(s[2 * k2][qt][2], s[2 * k2][qt][3]);
                w.z = cvtpk(s[2 * k2 + 1][qt][0], s[2 * k2 + 1][qt][1]); w.w = cvtpk(s[2 * k2 + 1][qt][2], s[2 * k2 + 1][qt][3]); pf[qt][k2] = mk_frag(w); }
        }
        {
            const LAS bf16_t* vp0 = Vs + l15 * 72 + 4 * q4;
            bf16x8 va[2], vb[2];
#define AT_LDV(dst, dt) do { _Pragma("unroll") for (int k2 = 0; k2 < 2; ++k2) { const LAS bf16_t* vp = vp0 + (16 * (dt)) * 72 + 32 * k2; dst[k2] = mk_frag2(*(const LAS u32x2*)vp, *(const LAS u32x2*)(vp + 16)); } } while (0)
#define AT_MMO(src, dt) do { _Pragma("unroll") for (int k2 = 0; k2 < 2; ++k2) { ao[dt][0] = MFMA16(src[k2], pf[0][k2], ao[dt][0]); ao[dt][1] = MFMA16(src[k2], pf[1][k2], ao[dt][1]); } } while (0)
            AT_LDV(va, 0); AT_LDV(vb, 1); __builtin_amdgcn_sched_barrier(0);
            AT_MMO(va, 0); __builtin_amdgcn_sched_barrier(0); AT_LDV(va, 2); __builtin_amdgcn_sched_barrier(0);
            AT_MMO(vb, 1); __builtin_amdgcn_sched_barrier(0); AT_LDV(vb, 3); __builtin_amdgcn_sched_barrier(0);
            AT_MMO(va, 2); __builtin_amdgcn_sched_barrier(0); AT_LDV(va, 4); __builtin_amdgcn_sched_barrier(0);
            AT_MMO(vb, 3); __builtin_amdgcn_sched_barrier(0); AT_LDV(vb, 5); __builtin_amdgcn_sched_barrier(0);
            AT_MMO(va, 4); __builtin_amdgcn_sched_barrier(0); AT_LDV(va, 6); __builtin_amdgcn_sched_barrier(0);
            AT_MMO(vb, 5); __builtin_amdgcn_sched_barrier(0); AT_LDV(vb, 7); __builtin_amdgcn_sched_barrier(0);
            AT_MMO(va, 6); __builtin_amdgcn_sched_barrier(0);
            AT_MMO(vb, 7); __builtin_amdgcn_sched_barrier(0);
#undef AT_LDV
#undef AT_MMO
        }
        if (MODE == 1) {
#pragma unroll
            for (int nt = 0; nt < 4; ++nt)
#pragma unroll
                for (int k2 = 0; k2 < 2; ++k2) {
                    const int n = 16 * nt + l15, cb = 64 * j + 32 * k2 + 4 * q4;
                    unsigned e[8];
#pragma unroll
                    for (int jj = 0; jj < 8; ++jj) { const int c = cb + (jj < 4 ? jj : 12 + jj); e[jj] = (c >= 4 * n - 1 && c <= 4 * n + 3) ? 0x3F80u : 0u; }
                    u32x4 w; w.x = e[0] | (e[1] << 16); w.y = e[2] | (e[3] << 16); w.z = e[4] | (e[5] << 16); w.w = e[6] | (e[7] << 16);
                    const bf16x8 of = mk_frag(w);
                    ai[nt][0] = MFMA16(of, pf[0][k2], ai[nt][0]); ai[nt][1] = MFMA16(of, pf[1][k2], ai[nt][1]);
                }
        }
        if (!more) break;
        if (MODE == 1) { __syncthreads(); AT_LOAD(jn); }
        else buf ^= 1;
        j = jn;
    }
#undef AT_LOAD
    float inv[2];
#pragma unroll
    for (int qt = 0; qt < 2; ++qt) { const float l = xq_sum(lsum[qt]); inv[qt] = l > 0.f ? 1.f / l : 0.f; }
    if (MODE == 0 || MODE == 1) {
        bf16_t* ob = (MODE == 0) ? P.ow() : P.oc();
#pragma unroll
        for (int qt = 0; qt < 2; ++qt) { const size_t tok = (size_t)b * SEQ + 64 * qb + 32 * qhalf + 16 * qt + l15;
#pragma unroll
            for (int dt = 0; dt < 8; ++dt) { const f32x4 o = ao[dt][qt] * inv[qt]; u32x2 w; w.x = cvtpk(o[0], o[1]); w.y = cvtpk(o[2], o[3]);
                *(u32x2*)(ob + tok * 2048 + head * 128 + 16 * dt + 4 * q4) = w; } }
    }
    if (MODE == 1) {
        __syncthreads();
#pragma unroll
        for (int qt = 0; qt < 2; ++qt)
#pragma unroll
            for (int nt = 0; nt < 4; ++nt) *(LAS f32x4*)(imps + (hd * 64 + 32 * qhalf + 16 * qt + l15) * 64 + 16 * nt + 4 * q4) = ai[nt][qt] * inv[qt];
        __syncthreads();
        unsigned long long uni = 0ull;
        const unsigned long long validm = (qb >= 63) ? ~0ull : ((2ull << qb) - 1ull);
        for (int qq0 = 0; qq0 < 8; qq0 += 4) {
            unsigned key[4]; unsigned long long mk[4];
#pragma unroll
            for (int u = 0; u < 4; ++u) { const int tl = 8 * wave + qq0 + u;
                float v = imps[(0 * 64 + tl) * 64 + lane] + imps[(1 * 64 + tl) * 64 + lane] + imps[(2 * 64 + tl) * 64 + lane] + imps[(3 * 64 + tl) * 64 + lane];
                if (lane == 0 || lane == qb || lane == qb - 1) v = 1e4f;
                key[u] = (lane <= qb) ? __builtin_bit_cast(unsigned, fmaxf(v, 0.f)) : 0u; }
            if (qb < 16) {
#pragma unroll
                for (int u = 0; u < 4; ++u) mk[u] = validm;
            } else {
                unsigned T[4] = {0u, 0u, 0u, 0u};
                for (int bit = 30; bit >= 0; --bit) {
#pragma unroll
                    for (int u = 0; u < 4; ++u) { const unsigned cand = T[u] | (1u << bit); const int cnt = __builtin_popcountll(__ballot(key[u] >= cand));
                        T[u] = cnt >= 16 ? cand : T[u]; }
                }
#pragma unroll
                for (int u = 0; u < 4; ++u) { const unsigned long long gt = __ballot(key[u] > T[u]), eq = __ballot(key[u] == T[u]) & validm;
                    const int r = 16 - __builtin_popcountll(gt);
                    const int below = (int)__builtin_amdgcn_mbcnt_hi((unsigned)(eq >> 32), __builtin_amdgcn_mbcnt_lo((unsigned)eq, 0u));
                    mk[u] = gt | __ballot(key[u] == T[u] && lane <= qb && below < r); }
            }
#pragma unroll
            for (int u = 0; u < 4; ++u) { uni |= mk[u]; if (lane == 0) P.sel()[(size_t)bg * SEQ + 64 * qb + 8 * wave + qq0 + u] = mk[u]; }
        }
        if (lane == 0) { um[2 * wave] = (unsigned)uni; um[2 * wave + 1] = (unsigned)(uni >> 32); }
        __syncthreads();
        if (tid == 0) { unsigned lo = 0u, hi = 0u; for (int w = 0; w < 8; ++w) { lo |= um[2 * w]; hi |= um[2 * w + 1]; } P.selu()[bg * 64 + qb] = ((unsigned long long)hi << 32) | lo; }
    }
    if (MODE == 2) {
#pragma unroll
        for (int qt = 0; qt < 2; ++qt) { const size_t tok = (size_t)b * SEQ + 64 * qb + 32 * qhalf + 16 * qt + l15;
            const float* gp = P.small() + tok * 64 + 16 + head * 3;
            const float g0 = sigmoidf_(gp[0]), g1 = sigmoidf_(gp[1]), g2 = sigmoidf_(gp[2]);
#pragma unroll
            for (int dt = 0; dt < 8; ++dt) { const int col = head * 128 + 16 * dt + 4 * q4;
                const u32x2 cw = *(const u32x2*)(P.oc() + tok * 2048 + col), ww = *(const u32x2*)(P.ow() + tok * 2048 + col), zw = *(const u32x2*)(P.U() + tok * UW + UNZ + col);
                const f32x4 o = ao[dt][qt] * inv[qt];
                const float y0 = (g0 * bflo(cw.x) + g1 * o[0] + g2 * bflo(ww.x)) * siluf_(bflo(zw.x)), y1 = (g0 * bfhi(cw.x) + g1 * o[1] + g2 * bfhi(ww.x)) * siluf_(bfhi(zw.x));
                const float y2 = (g0 * bflo(cw.y) + g1 * o[2] + g2 * bflo(ww.y)) * siluf_(bflo(zw.y)), y3 = (g0 * bfhi(cw.y) + g1 * o[3] + g2 * bfhi(ww.y)) * siluf_(bfhi(zw.y));
                u32x2 w; w.x = cvtpk(y0, y1); w.y = cvtpk(y2, y3);
                *(u32x2*)(P.y() + tok * DM + 2048 + col) = w; } }
    }
    __syncthreads();
}

typedef float f32x16 __attribute__((ext_vector_type(16)));
#define MFMA32(a, b, c) __builtin_amdgcn_mfma_f32_32x32x16_bf16((a), (b), (c), 0, 0, 0)
__device__ __forceinline__ float half_swap_max(float v) { float a = v, b = v; swap32(a, b); return fmaxf(a, b); }
__device__ __forceinline__ float half_swap_sum(float v) { float a = v, b = v; swap32(a, b); return a + b; }
template <int MODE>
__device__ __forceinline__ void attn_fast(const Params& P, LAS unsigned char* lds_, int bg, int qb) {
    LAS unsigned char* lds = opq(lds_);
    const int tid = opaque_tid(), lane = tid & 63, wave = tid >> 6, r32 = lane & 31, hi = lane >> 5;
    const int b = bg >> 2, g = bg & 3, hd = wave >> 1, qhalf = wave & 1, head = g * 4 + hd, tl = 32 * qhalf + r32;
    constexpr int BUFB = 35840;
    LAS float* tab = (LAS float*)(lds + 3 * BUFB);
    for (int i = tid; i < 4 * 129; i += 512) { const int hh = i / 129, dd = i % 129; tab[hh * 132 + dd] = P.rel_bias[rel_bucket(dd) * 16 + g * 4 + hh] * LOG2E; }
    bf16x8 qf[8];
    {
        const size_t tok = (size_t)b * SEQ + 64 * qb + tl;
        u32x4 raw[8]; float ss = 0.f;
#pragma unroll
        for (int ks = 0; ks < 8; ++ks) { raw[ks] = *(const u32x4*)(P.U() + tok * UW + UNQ + head * 128 + 16 * ks + 8 * hi);
            const float a0 = bflo(raw[ks].x), a1 = bfhi(raw[ks].x), a2 = bflo(raw[ks].y), a3 = bfhi(raw[ks].y), a4 = bflo(raw[ks].z), a5 = bfhi(raw[ks].z), a6 = bflo(raw[ks].w), a7 = bfhi(raw[ks].w);
            ss += a0 * a0 + a1 * a1 + a2 * a2 + a3 * a3 + a4 * a4 + a5 * a5 + a6 * a6 + a7 * a7; }
        ss = half_swap_sum(ss);
        const float sc = __builtin_amdgcn_rsqf(ss * (1.f / 128.f) + EPS) * (0.08838834764831845f * LOG2E);
#pragma unroll
        for (int ks = 0; ks < 8; ++ks) { const f32x4 w0 = *(const f32x4*)(P.qnorm_w + 16 * ks + 8 * hi), w1 = *(const f32x4*)(P.qnorm_w + 16 * ks + 8 * hi + 4);
            u32x4 w; w.x = cvtpk(bflo(raw[ks].x) * sc * w0[0], bfhi(raw[ks].x) * sc * w0[1]); w.y = cvtpk(bflo(raw[ks].y) * sc * w0[2], bfhi(raw[ks].y) * sc * w0[3]);
            w.z = cvtpk(bflo(raw[ks].z) * sc * w1[0], bfhi(raw[ks].z) * sc * w1[1]); w.w = cvtpk(bflo(raw[ks].w) * sc * w1[2], bfhi(raw[ks].w) * sc * w1[3]);
            qf[ks] = mk_frag(w); }
    }
    unsigned long long smask = ~0ull;
    if (MODE == 2) smask = P.sel()[(size_t)bg * SEQ + 64 * qb + tl];
    f32x16 o[4];
#pragma unroll
    for (int dt = 0; dt < 4; ++dt)
#pragma unroll
        for (int r = 0; r < 16; ++r) o[dt][r] = 0.f;
    float mrun = -1e30f, lrun = 0.f;
    unsigned long long pset, sset;
    {
        const unsigned long long upto = (2ull << qb) - 1ull;
        const unsigned long long near = upto & ~((qb >= 3) ? ((1ull << (qb - 2)) - 1ull) : 0ull);
        if (MODE == 0) { const int jl = qb - 8 < 0 ? 0 : qb - 8; const unsigned long long win = upto & ~((1ull << jl) - 1ull);
            sset = near | ((qb >= 8) ? (1ull << (qb - 8)) : 0ull); pset = win & ~sset; }
        else { const unsigned long long un = P.selu()[bg * 64 + qb] & upto; sset = near & un; pset = un & ~near; }
    }
    const int krow = tid >> 4, kc16 = tid & 15, vrow = tid >> 3, vc8 = tid & 7;
    const bf16_t* kbase = P.U() + ((size_t)b * SEQ + krow) * UW + (MODE == 0 ? UKW : UKS) + g * 128 + 8 * kc16;
    const bf16_t* vbase = P.T() + (size_t)((MODE == 0 ? TVW : TVS) + g * 128 + vrow) * MTOK + (size_t)b * SEQ + 8 * vc8;
    f32x4 kw0 = {1.f, 1.f, 1.f, 1.f}, kw1 = {1.f, 1.f, 1.f, 1.f};
    if (MODE == 0) { const float* kw = P.knorm_w + 256 + 8 * kc16; kw0 = *(const f32x4*)kw; kw1 = *(const f32x4*)(kw + 4); }
    u32x4 kr[2], vr[2];
#define AF_LOAD(J) do { _Pragma("unroll") for (int _i = 0; _i < 2; ++_i) { kr[_i] = *(const u32x4*)(kbase + (size_t)(J) * 64 * UW + (size_t)_i * 32 * UW); vr[_i] = *(const u32x4*)(vbase + (size_t)(J) * 64 + (size_t)_i * 64 * MTOK); } } while (0)
#define AF_WRITE(BUF) do { LAS bf16_t* Ks_ = (LAS bf16_t*)(lds + (BUF) * BUFB); LAS bf16_t* Vs_ = (LAS bf16_t*)(lds + (BUF) * BUFB + 17408); \
        _Pragma("unroll") for (int i = 0; i < 2; ++i) { u32x4 raw = kr[i]; \
            if (MODE == 0) { float v[8] = {bflo(raw.x), bfhi(raw.x), bflo(raw.y), bfhi(raw.y), bflo(raw.z), bfhi(raw.z), bflo(raw.w), bfhi(raw.w)}; float ss = 0.f; \
                _Pragma("unroll") for (int e = 0; e < 8; ++e) ss += v[e] * v[e]; \
                ss = row16_sum(ss); const float rstd = __builtin_amdgcn_rsqf(ss * (1.f / 128.f) + EPS); \
                raw.x = cvtpk(v[0] * rstd * kw0[0], v[1] * rstd * kw0[1]); raw.y = cvtpk(v[2] * rstd * kw0[2], v[3] * rstd * kw0[3]); \
                raw.z = cvtpk(v[4] * rstd * kw1[0], v[5] * rstd * kw1[1]); raw.w = cvtpk(v[6] * rstd * kw1[2], v[7] * rstd * kw1[3]); } \
            *(LAS u32x4*)(Ks_ + (krow + 32 * i) * 136 + 8 * kc16) = raw; \
            LAS bf16_t* vp_ = Vs_ + (vrow + 64 * i) * 72 + 16 * (vc8 >> 1) + 4 * (vc8 & 1); \
            *(LAS u32x2*)vp_ = (u32x2){vr[i].x, vr[i].y}; *(LAS u32x2*)(vp_ + 8) = (u32x2){vr[i].z, vr[i].w}; } } while (0)
#define AF_LDK(DST, KP, KS2) do { DST[0] = *(const LAS bf16x8*)((KP) + 32 * (KS2)); DST[1] = *(const LAS bf16x8*)((KP) + 32 * 136 + 32 * (KS2)); \
                                  DST[2] = *(const LAS bf16x8*)((KP) + 32 * (KS2) + 16); DST[3] = *(const LAS bf16x8*)((KP) + 32 * 136 + 32 * (KS2) + 16); } while (0)
#define AF_MMK(SRC, S0, S1, KS2) do { S0 = MFMA32(SRC[0], qf[2 * (KS2)], S0); S1 = MFMA32(SRC[1], qf[2 * (KS2)], S1); S0 = MFMA32(SRC[2], qf[2 * (KS2) + 1], S0); S1 = MFMA32(SRC[3], qf[2 * (KS2) + 1], S1); } while (0)
#define AF_S(S0, S1, BUF) do { const LAS bf16_t* kp = (const LAS bf16_t*)(lds + (BUF) * BUFB) + r32 * 136 + 8 * hi; \
        bf16x8 fa[4], fb[4]; \
        _Pragma("unroll") for (int r = 0; r < 16; ++r) { S0[r] = 0.f; S1[r] = 0.f; } \
        AF_LDK(fa, kp, 0); AF_LDK(fb, kp, 1); __builtin_amdgcn_sched_barrier(0); \
        AF_MMK(fa, S0, S1, 0); __builtin_amdgcn_sched_barrier(0); AF_LDK(fa, kp, 2); __builtin_amdgcn_sched_barrier(0); \
        AF_MMK(fb, S0, S1, 1); __builtin_amdgcn_sched_barrier(0); AF_LDK(fb, kp, 3); __builtin_amdgcn_sched_barrier(0); \
        AF_MMK(fa, S0, S1, 2); __builtin_amdgcn_sched_barrier(0); \
        AF_MMK(fb, S0, S1, 3); __builtin_amdgcn_sched_barrier(0); } while (0)
#define AF_SMH(S0, S1, CB, ALPHA) do { float mx = fmaxf(S0[0], S1[0]); \
        _Pragma("unroll") for (int r = 1; r < 16; ++r) mx = fmaxf(mx, fmaxf(S0[r], S1[r])); \
        mx = half_swap_max(mx) + (CB); \
        const bool keep = __all(mx - mrun <= 11.5f); \
        const float mn = keep ? mrun : fmaxf(mrun, mx); ALPHA = __builtin_amdgcn_exp2f(mrun - mn); mrun = mn; \
        const float cc = (CB) - mn; \
        _Pragma("unroll") for (int r = 0; r < 16; ++r) { S0[r] = __builtin_amdgcn_exp2f(S0[r] + cc); S1[r] = __builtin_amdgcn_exp2f(S1[r] + cc); } } while (0)
#define AF_SMT(S0, S1, ALPHA) do { float ps = S0[0] + S1[0]; \
        _Pragma("unroll") for (int r = 1; r < 16; ++r) ps += S0[r] + S1[r]; \
        ps = half_swap_sum(ps); lrun = lrun * (ALPHA) + ps; \
        _Pragma("unroll") for (int s2 = 0; s2 < 2; ++s2) { \
            u32x4 w; w.x = cvtpk(S0[8 * s2 + 0], S0[8 * s2 + 1]); w.y = cvtpk(S0[8 * s2 + 2], S0[8 * s2 + 3]); w.z = cvtpk(S0[8 * s2 + 4], S0[8 * s2 + 5]); w.w = cvtpk(S0[8 * s2 + 6], S0[8 * s2 + 7]); pf[0][s2] = mk_frag(w); \
            u32x4 x; x.x = cvtpk(S1[8 * s2 + 0], S1[8 * s2 + 1]); x.y = cvtpk(S1[8 * s2 + 2], S1[8 * s2 + 3]); x.z = cvtpk(S1[8 * s2 + 4], S1[8 * s2 + 5]); x.w = cvtpk(S1[8 * s2 + 6], S1[8 * s2 + 7]); pf[1][s2] = mk_frag(x); } } while (0)
#define AF_RESC(ALPHA) do { if (__any((ALPHA) != 1.f)) { _Pragma("unroll") for (int dt = 0; dt < 4; ++dt) o[dt] = o[dt] * (ALPHA); } } while (0)
#define AF_LDV(DST, VP, dt) do { _Pragma("unroll") for (int kh = 0; kh < 2; ++kh) _Pragma("unroll") for (int s2 = 0; s2 < 2; ++s2) { \
            DST[2 * kh + s2] = *(const LAS bf16x8*)((VP) + (32 * (dt)) * 72 + 32 * kh + 16 * s2); } } while (0)
#define AF_MMV(SRC, dt) do { o[dt] = MFMA32(SRC[0], pf[0][0], o[dt]); o[dt] = MFMA32(SRC[1], pf[0][1], o[dt]); o[dt] = MFMA32(SRC[2], pf[1][0], o[dt]); o[dt] = MFMA32(SRC[3], pf[1][1], o[dt]); } while (0)
#define AF_VP(BUF) ((const LAS bf16_t*)(lds + (BUF) * BUFB + 17408) + r32 * 72 + 8 * hi)
#define AF_PV(BUF) do { const LAS bf16_t* vp0 = AF_VP(BUF); bf16x8 va[4], vb[4]; \
        AF_LDV(va, vp0, 0); AF_LDV(vb, vp0, 1); __builtin_amdgcn_sched_barrier(0); \
        AF_MMV(va, 0); __builtin_amdgcn_sched_barrier(0); AF_LDV(va, vp0, 2); __builtin_amdgcn_sched_barrier(0); \
        AF_MMV(vb, 1); __builtin_amdgcn_sched_barrier(0); AF_LDV(vb, vp0, 3); __builtin_amdgcn_sched_barrier(0); \
        AF_MMV(va, 2); __builtin_amdgcn_sched_barrier(0); AF_MMV(vb, 3); __builtin_amdgcn_sched_barrier(0); } while (0)
#define AF_PV_SMH(BUF, S0, S1, CB, ALPHA) do { const LAS bf16_t* vp0 = AF_VP(BUF); bf16x8 va[4], vb[4]; float mx; \
        AF_LDV(va, vp0, 0); AF_LDV(vb, vp0, 1); __builtin_amdgcn_sched_barrier(0); \
        AF_MMV(va, 0); mx = fmaxf(S0[0], S0[1]); _Pragma("unroll") for (int r = 2; r < 16; ++r) mx = fmaxf(mx, S0[r]); __builtin_amdgcn_sched_barrier(0); \
        AF_LDV(va, vp0, 2); __builtin_amdgcn_sched_barrier(0); \
        AF_MMV(vb, 1); _Pragma("unroll") for (int r = 0; r < 16; ++r) mx = fmaxf(mx, S1[r]); \
        mx = half_swap_max(mx) + (CB); \
        const bool keep = __all(mx - mrun <= 11.5f); \
        const float mn = keep ? mrun : fmaxf(mrun, mx); ALPHA = __builtin_amdgcn_exp2f(mrun - mn); mrun = mn; \
        const float cc = (CB) - mn; __builtin_amdgcn_sched_barrier(0); \
        AF_LDV(vb, vp0, 3); __builtin_amdgcn_sched_barrier(0); \
        AF_MMV(va, 2); _Pragma("unroll") for (int r = 0; r < 16; ++r) S0[r] = __builtin_amdgcn_exp2f(S0[r] + cc); __builtin_amdgcn_sched_barrier(0); \
        AF_MMV(vb, 3); _Pragma("unroll") for (int r = 0; r < 16; ++r) S1[r] = __builtin_amdgcn_exp2f(S1[r] + cc); __builtin_amdgcn_sched_barrier(0); } while (0)
    bf16x8 pf[2][2];
    const float cbias = 0.f;
    (void)cbias;
    unsigned long long srem = sset; int js = -1;
    if (srem) { js = __builtin_ctzll(srem); srem &= srem - 1ull; }
    if (pset) {
        unsigned long long rem = pset;
        f32x16 s0, s1; float al = 1.f;
        int jt0 = __builtin_ctzll(rem); rem &= rem - 1ull;
        AF_LOAD(jt0); AF_WRITE(0);
        int jn1 = -1; if (rem) { jn1 = __builtin_ctzll(rem); rem &= rem - 1ull; AF_LOAD(jn1); }
        __syncthreads();
        const float cb_all = tab[hd * 132 + 128];
#define AF_CB(J) ((MODE == 2) ? ((((smask >> (J)) & 1ull) != 0ull) ? cb_all : -INFINITY) : cb_all)
        int bufS = 0;
        if (jn1 >= 0) AF_WRITE(1);
        int jn2 = -1; if (rem) { jn2 = __builtin_ctzll(rem); rem &= rem - 1ull; AF_LOAD(jn2); }
        AF_S(s0, s1, 0);
        { const float cb = AF_CB(jt0); AF_SMH(s0, s1, cb, al); }
        AF_RESC(al);
        int jcur = jn1, jnext = jn2;
        while (jcur >= 0) {
            const int bufN = bufS == 2 ? 0 : bufS + 1;
            const int bufW = bufN == 2 ? 0 : bufN + 1;
            __syncthreads();
            if (jnext >= 0) AF_WRITE(bufW);
            int jn3 = -1; if (rem) { jn3 = __builtin_ctzll(rem); rem &= rem - 1ull; AF_LOAD(jn3); }
            AF_SMT(s0, s1, al);
            __builtin_amdgcn_sched_barrier(0);
            AF_S(s0, s1, bufN);
            { const float cb = AF_CB(jcur); AF_PV_SMH(bufS, s0, s1, cb, al); }
            AF_RESC(al);
            bufS = bufN; jcur = jnext; jnext = jn3;
        }
        if (js >= 0) AF_LOAD(js);
        AF_SMT(s0, s1, al);
        AF_PV(bufS);
    } else if (js >= 0) AF_LOAD(js);
    if (js >= 0) {
        __syncthreads();
        int sb = 0;
        while (js >= 0) {
            const int j = js;
            AF_WRITE(sb);
            __syncthreads();
            js = -1; if (srem) { js = __builtin_ctzll(srem); srem &= srem - 1ull; AF_LOAD(js); }
            f32x16 s0, s1; float al;
            AF_S(s0, s1, sb);
            const bool selok = (MODE == 2) ? (((smask >> j) & 1ull) != 0ull) : true;
#pragma unroll
            for (int kh = 0; kh < 2; ++kh)
#pragma unroll
                for (int rq = 0; rq < 4; ++rq) {
                    float tb[4];
#pragma unroll
                    for (int e = 0; e < 4; ++e) { const int kl = 32 * kh + 8 * rq + 4 * hi + e; const int dist = 64 * (qb - j) + tl - kl;
                        const int di = dist < 0 ? 0 : (dist > 128 ? 128 : dist); tb[e] = tab[hd * 132 + di]; }
                    asm volatile("" : "+v"(tb[0]), "+v"(tb[1]), "+v"(tb[2]), "+v"(tb[3]));
#pragma unroll
                    for (int e = 0; e < 4; ++e) { const int kl = 32 * kh + 8 * rq + 4 * hi + e; const int dist = 64 * (qb - j) + tl - kl;
                        bool ok = dist >= 0 && selok; if (MODE == 0) ok = ok && dist < 512;
                        if (kh == 0) s0[4 * rq + e] = ok ? s0[4 * rq + e] + tb[e] : -INFINITY; else s1[4 * rq + e] = ok ? s1[4 * rq + e] + tb[e] : -INFINITY; }
                }
            AF_SMH(s0, s1, 0.f, al);
            AF_SMT(s0, s1, al);
            AF_RESC(al);
            AF_PV(sb);
            sb ^= 1;
        }
    }
#undef AF_LOAD
#undef AF_WRITE
#undef AF_S
#undef AF_SMH
#undef AF_SMT
#undef AF_RESC
#undef AF_PV
#undef AF_PV_SMH
#undef AF_LDK
#undef AF_MMK
#undef AF_LDV
#undef AF_MMV
#undef AF_VP
#undef AF_CB
    const float inv = lrun > 0.f ? 1.f / lrun : 0.f;
    int lane2 = lane; asm volatile("" : "+v"(lane2));
    const int hi2 = lane2 >> 5, tl2 = 32 * qhalf + (lane2 & 31);
    const size_t tok = (size_t)b * SEQ + 64 * qb + tl2;
    if (MODE == 0) {
#pragma unroll
        for (int dt = 0; dt < 4; ++dt)
#pragma unroll
            for (int rq = 0; rq < 4; ++rq) { u32x2 w; w.x = cvtpk(o[dt][4 * rq] * inv, o[dt][4 * rq + 1] * inv); w.y = cvtpk(o[dt][4 * rq + 2] * inv, o[dt][4 * rq + 3] * inv);
                *(u32x2*)(P.ow() + tok * 2048 + head * 128 + 32 * dt + 8 * rq + 4 * hi2) = w; }
    } else {
        const float* gp = P.small() + tok * 64 + 16 + head * 3;
        const float g0 = sigmoidf_(gp[0]), g1 = sigmoidf_(gp[1]), g2 = sigmoidf_(gp[2]);
#pragma unroll
        for (int dt = 0; dt < 4; ++dt)
#pragma unroll
            for (int rq = 0; rq < 4; ++rq) { const int col = head * 128 + 32 * dt + 8 * rq + 4 * hi2;
                const u32x2 cw = *(const u32x2*)(P.oc() + tok * 2048 + col), ww = *(const u32x2*)(P.ow() + tok * 2048 + col), zw = *(const u32x2*)(P.U() + tok * UW + UNZ + col);
                const float o0 = o[dt][4 * rq] * inv, o1 = o[dt][4 * rq + 1] * inv, o2 = o[dt][4 * rq + 2] * inv, o3 = o[dt][4 * rq + 3] * inv;
                const float y0 = (g0 * bflo(cw.x) + g1 * o0 + g2 * bflo(ww.x)) * siluf_(bflo(zw.x)), y1 = (g0 * bfhi(cw.x) + g1 * o1 + g2 * bfhi(ww.x)) * siluf_(bfhi(zw.x));
                const float y2 = (g0 * bflo(cw.y) + g1 * o2 + g2 * bflo(ww.y)) * siluf_(bflo(zw.y)), y3 = (g0 * bfhi(cw.y) + g1 * o3 + g2 * bfhi(ww.y)) * siluf_(bfhi(zw.y));
                *(unsigned*)(P.y8() + tok * 2048 + col) = pk_fp8x4(__builtin_amdgcn_fmed3f(16.f * y0, -440.f, 440.f), __builtin_amdgcn_fmed3f(16.f * y1, -440.f, 440.f), __builtin_amdgcn_fmed3f(16.f * y2, -440.f, 440.f), __builtin_amdgcn_fmed3f(16.f * y3, -440.f, 440.f)); }
    }
    __syncthreads();
}

#ifndef R_CMP
#define R_CMP 1
#endif
#ifndef R_WIN
#define R_WIN 1
#endif
#ifndef R_ML1
#define R_ML1 1
#endif
#ifndef R_CA
#define R_CA 1
#endif
#ifndef R_ML2
#define R_ML2 1
#endif
#ifndef R_SEL
#define R_SEL 1
#endif
#ifndef R_ML3
#define R_ML3 1
#endif
#ifndef REP_P0
#define REP_P0 1
#endif
#ifndef REP_P1
#define REP_P1 1
#endif
#ifndef REP_P2
#define REP_P2 1
#endif
#ifndef REP_P3
#define REP_P3 1
#endif
#ifndef REP_P4
#define REP_P4 1
#endif
#ifndef REP_P5
#define REP_P5 1
#endif
constexpr int LDS_BYTES = 131072 + 1024;
constexpr int LDS_SLOT = 131072;
extern __shared__ __attribute__((aligned(16))) unsigned char dyn_lds[];

__device__ __forceinline__ int next_task(unsigned* ctr, LAS unsigned char* lds_) {
    LAS int* slot = (LAS int*)(opq(lds_) + LDS_SLOT);
    __syncthreads();
    if (opaque_tid() == 0) *slot = (int)atomicAdd(ctr, 1u);
    __syncthreads();
    return *slot;
}

#define XB_TMO      128
#define XB_XCNT(j)  (256  + 64 * (j))
#define XB_XSUB(j)  (1280 + 64 * (j))
#define XB_XGEN(j)  (2304 + 64 * (j))
#define XB_TOP      3328
#define XB_TOPGEN   3392
#define XCD_BAR_WORDS 3456
#define XB_SPIN_CAP (1u << 18)
__device__ __forceinline__ unsigned xb_ld(unsigned* p)              { return __hip_atomic_load(p, __ATOMIC_RELAXED, __HIP_MEMORY_SCOPE_AGENT); }
__device__ __forceinline__ unsigned xb_add(unsigned* p, unsigned v) { return __hip_atomic_fetch_add(p, v, __ATOMIC_RELAXED, __HIP_MEMORY_SCOPE_AGENT); }
__device__ __forceinline__ unsigned xb_xcc_id() { return (unsigned)__builtin_amdgcn_s_getreg((3 << 11) | 20) & 0xFu; }
#define XB_SPIN(cond, bar) do { unsigned _sp = 0; while (cond) { __builtin_amdgcn_s_sleep(1); \
    if ((++_sp & 255u) == 0u) { if (xb_ld(&(bar)[XB_TMO])) break; if (_sp > XB_SPIN_CAP) { atomicAdd(&(bar)[XB_TMO], 1u); break; } } } } while (0)
__device__ __forceinline__ void xcd_barrier_post(unsigned* bar) { if (threadIdx.x == 0) (void)xb_add(&bar[XB_XCNT(xb_xcc_id())], 1u); }
__device__ __forceinline__ void xcd_barrier_complete(unsigned* bar, unsigned x, unsigned& nloc, unsigned& nx) {
    const unsigned G = gridDim.x * gridDim.y * gridDim.z;
    unsigned sum, cnt, mine, sp = 0u;
    for (;;) {
        sum = 0u; cnt = 0u; mine = 0u;
#pragma unroll
        for (unsigned j = 0; j < 16; ++j) { const unsigned c = xb_ld(&bar[XB_XCNT(j)]); sum += c; cnt += (c > 0u) ? 1u : 0u; mine = (j == x) ? c : mine; }
        if (sum == G) break;
        __builtin_amdgcn_s_sleep(1);
        if ((++sp & 255u) == 0u) { if (xb_ld(&bar[XB_TMO])) break; if (sp > XB_SPIN_CAP) { atomicAdd(&bar[XB_TMO], 1u); break; } }
    }
    nloc = mine > 0u ? mine : 1u; nx = cnt > 0u ? cnt : 1u;
}
__device__ __forceinline__ void xcd_barrier(unsigned* bar, volatile LAS unsigned* st) {
    asm volatile("s_waitcnt vmcnt(0)" ::: "memory");
    __syncthreads();
    if (threadIdx.x == 0) {
        const unsigned x = xb_xcc_id();
        __builtin_amdgcn_s_waitcnt(0);
        unsigned nloc = st[0], nx = st[1];
        if (nloc == 0u) { xcd_barrier_complete(bar, x, nloc, nx); st[0] = nloc; st[1] = nx; }
        const unsigned old = xb_add(&bar[XB_XSUB(x)], 1u);
        const unsigned gen = old / nloc;
        if (old + 1u == (gen + 1u) * nloc) {
            __builtin_amdgcn_fence(__ATOMIC_RELEASE, "agent");
            asm volatile("s_waitcnt vmcnt(0)" ::: "memory");
            const unsigned og = xb_add(&bar[XB_TOP], 1u);
            const unsigned tg = og / nx;
            if (og + 1u == (tg + 1u) * nx) xb_add(&bar[XB_TOPGEN], 1u);
            else XB_SPIN(xb_ld(&bar[XB_TOPGEN]) == tg, bar);
            __builtin_amdgcn_fence(__ATOMIC_ACQUIRE, "agent");
            xb_add(&bar[XB_XGEN(x)], 1u);
            asm volatile("s_waitcnt vmcnt(0)" ::: "memory");
        } else {
            XB_SPIN(xb_ld(&bar[XB_XGEN(x)]) == gen, bar);
            __builtin_amdgcn_fence(__ATOMIC_ACQUIRE, "agent");
            asm volatile("s_waitcnt vmcnt(0)" ::: "memory");
        }
    }
    __syncthreads();
}

struct KArgs { const float* in[20]; float* out; unsigned char* ws; };
__global__ void __launch_bounds__(512, 2) hymba_mega(KArgs ka) {
    Params P; fill_params(P, (void* const*)ka.in, (void*)ka.out, (void*)ka.ws);
    cg::grid_group grid = cg::this_grid();
    LAS unsigned char* lds = (LAS unsigned char*)dyn_lds;
    const int bid = blockIdx.x, G = gridDim.x;
    if (threadIdx.x == 0) { *(volatile LAS unsigned*)(lds + LDS_SLOT + 64) = 0u; *(volatile LAS unsigned*)(lds + LDS_SLOT + 68) = 0u; }
    __syncthreads();
    xcd_barrier_post(P.ctl() + 4096);
    if (ka.out == nullptr) grid.sync();
#define GSYNC() xcd_barrier(P.ctl() + 4096, (volatile LAS unsigned*)(opq(lds) + LDS_SLOT + 64))
#define PH_P0 { phase0(P, lds, bid, G); GSYNC(); }
#define PH_P1 { phase_gemm1(P, lds, bid, G); phase_gemm_pe(P, lds, bid, G); GSYNC(); }
#define PH_P2(CB) { \
        for (int t = next_task(P.ctl() + (CB) + 0, lds); t < 32 * R_CMP + 512 * R_WIN + 512 * R_ML1 + 64; t = next_task(P.ctl() + (CB) + 0, lds)) { \
            if (t < 32 * R_CMP) cmp_gemm_task(P, lds, t % 32); \
            else if (t < 32 * R_CMP + 512 * R_WIN) { const int u = (t - 32 * R_CMP) % 512; attn_fast<0>(P, lds, u & 7, 63 - (u >> 3)); } \
            else if (t < 32 * R_CMP + 512 * R_WIN + 512 * R_ML1) ml_step1(P, lds, (t - 32 * R_CMP - 512 * R_WIN) % 512); \
            else ksnorm_task(P, t - (32 * R_CMP + 512 * R_WIN + 512 * R_ML1)); \
        } \
        GSYNC(); }
#define PH_P3(CB) { \
        for (int t = next_task(P.ctl() + (CB) + 64, lds); t < 256 * R_ML2 + 128 * R_CMP; t = next_task(P.ctl() + (CB) + 64, lds)) { \
            if (t < 256 * R_ML2) { const int u = t % 256; ml_step2(P, u >> 4, u & 15); } \
            else cmp_task(P, lds, (t - 256 * R_ML2) % 128); \
        } \
        GSYNC(); }
#define PH_P4(CB) { \
        for (int t = next_task(P.ctl() + (CB) + 128, lds); t < 512 * R_SEL + 512 * R_ML3; t = next_task(P.ctl() + (CB) + 128, lds)) { \
            if (t < 512 * R_SEL) { const int u = t % 512; attn_task<1>(P, lds, u & 7, 63 - (u >> 3)); __threadfence_block(); __syncthreads(); attn_fast<2>(P, lds, u & 7, 63 - (u >> 3)); } \
            else ml_step3(P, lds, (t - 512 * R_SEL) % 512); \
        } \
        GSYNC(); }
#define PH_P5 { phase_gemm2(P, lds, bid, G); GSYNC(); }
    PH_P0
#if REP_P0 > 1
    PH_P0
#endif
    PH_P1
#if REP_P1 > 1
    PH_P1
#endif
    PH_P2(0)
#if REP_P2 > 1
    PH_P2(256)
#endif
    PH_P3(0)
#if REP_P3 > 1
    PH_P3(256)
#endif
    PH_P4(0)
#if REP_P4 > 1
    PH_P4(256)
#endif
    PH_P5
#if REP_P5 > 1
    PH_P5
#endif
    phase_gemm3(P, lds, bid, G);
}

extern "C" void kernel_launch(void* const* d_in, const int* in_sizes, int n_in, void* d_out, int out_size, void* d_ws, size_t ws_size, hipStream_t stream) {
    static int grid_blocks = 0;
    if (!grid_blocks) {
        if (ws_size < WS_END) { fprintf(stderr, "kernel_launch: workspace too small: %zu < %zu\n", ws_size, (size_t)WS_END); grid_blocks = -1; return; }
        int dev = 0, cus = 0, per_cu = 0;
        (void)hipGetDevice(&dev);
        (void)hipDeviceGetAttribute(&cus, hipDeviceAttributeMultiprocessorCount, dev);
        (void)hipFuncSetAttribute((const void*)hymba_mega, hipFuncAttributeMaxDynamicSharedMemorySize, LDS_BYTES);
        (void)hipOccupancyMaxActiveBlocksPerMultiprocessor(&per_cu, (const void*)hymba_mega, 512, LDS_BYTES);
        if (per_cu < 1) { fprintf(stderr, "kernel_launch: occupancy query says %d blocks per CU\n", per_cu); per_cu = 1; }
        grid_blocks = cus * (per_cu > 1 ? 1 : per_cu);
    }
    if (grid_blocks < 0) return;
    (void)hipMemsetAsync((char*)d_ws + WS_CTL, 0, 32768, stream);
    KArgs ka{}; for (int i = 0; i < 20; ++i) ka.in[i] = (const float*)d_in[i]; ka.out = (float*)d_out; ka.ws = (unsigned char*)d_ws;
    void* args[] = {&ka};
    hipError_t e = hipLaunchCooperativeKernel((const void*)hymba_mega, dim3(grid_blocks), dim3(512), args, LDS_BYTES, stream);
    if (e != hipSuccess) fprintf(stderr, "cooperative launch failed: %s (grid %d)\n", hipGetErrorString(e), grid_blocks);
}
```

```cpp
#include <hip/hip_runtime.h>
#include <hip/hip_cooperative_groups.h>
#include <cstdio>
#include <cstdint>
namespace cg = cooperative_groups;

#define LAS __attribute__((address_space(3)))
typedef unsigned short bf16_t;
typedef short bf16x8 __attribute__((ext_vector_type(8)));
typedef short bf16x4 __attribute__((ext_vector_type(4)));
typedef float f32x4 __attribute__((ext_vector_type(4)));
typedef float f32x2 __attribute__((ext_vector_type(2)));
typedef unsigned u32x4 __attribute__((ext_vector_type(4)));
typedef unsigned u32x2 __attribute__((ext_vector_type(2)));

constexpr int DM = 4096, NB = 2, SEQ = 4096, MTOK = NB * SEQ;
constexpr int INW = 15424;
constexpr int UW = 12288;
constexpr int UQ = 0, UK = 1024, UO = 2048, UZ = 4096, UNQ = 6144, UKC = 8192, UVC = 8704, UKS = 9216, UKW = 9728, UNZ = 10240;
constexpr int WT_SMALL = 12288;
constexpr int WT_T = 12544;
constexpr int WT_ROWS = 15616;
constexpr int TV = 0, TVS = 2048, TVW = 2560, TROWS = 3072;
constexpr float EPS = 1e-6f;

__device__ __forceinline__ unsigned f2bf(float f) { unsigned u = __float_as_uint(f); return (u + 0x7fffu + ((u >> 16) & 1u)) >> 16; }
typedef __bf16 bf16x2v __attribute__((ext_vector_type(2)));
__device__ __forceinline__ unsigned pk2(float lo, float hi) { const f32x2 v = {lo, hi}; return __builtin_bit_cast(unsigned, __builtin_convertvector(v, bf16x2v)); }
__device__ __forceinline__ float bflo(unsigned w) { return __uint_as_float(w << 16); }
__device__ __forceinline__ float bfhi(unsigned w) { return __uint_as_float(w & 0xffff0000u); }
__device__ __forceinline__ float bf2f(bf16_t b) { return __uint_as_float(((unsigned)b) << 16); }
extern __shared__ __attribute__((aligned(16))) unsigned char dyn_lds[];
#define TID_TAB_OFF (147456 + 128)
__device__ __forceinline__ unsigned hw_wave_slot() { return (unsigned)__builtin_amdgcn_s_getreg((5 << 11) | 4) & 63u; }
__device__ __forceinline__ int opaque_tid() {
    const int w = __builtin_amdgcn_readfirstlane(*(const volatile __attribute__((address_space(3))) int*)((__attribute__((address_space(3))) unsigned char*)dyn_lds + TID_TAB_OFF + 4 * hw_wave_slot()));
    unsigned z = 0u; asm volatile("" : "+s"(z));
    int t = (w << 6) | (int)__builtin_amdgcn_mbcnt_hi(~0u, __builtin_amdgcn_mbcnt_lo(~0u, z)); asm volatile("" : "+v"(t)); return t; }
__device__ __forceinline__ LAS unsigned char* opq(LAS unsigned char* p) { unsigned v = (unsigned)(uintptr_t)p; asm volatile("" : "+s"(v)); return (LAS unsigned char*)(uintptr_t)v; }
#define DPP_F(v, ctrl) __builtin_bit_cast(float, __builtin_amdgcn_update_dpp(0, __builtin_bit_cast(int, (v)), (ctrl), 0xF, 0xF, true))
__device__ __forceinline__ float row16_sum(float v) { v += DPP_F(v, 0xB1); v += DPP_F(v, 0x4E); v += DPP_F(v, 0x141); v += DPP_F(v, 0x140); return v; }
__device__ __forceinline__ void swap16(float& a, float& b) { asm volatile("v_nop\n\tv_nop\n\tv_permlane16_swap_b32 %0, %1" : "+v"(a), "+v"(b)); }
__device__ __forceinline__ void swap32(float& a, float& b) { asm volatile("v_nop\n\tv_nop\n\tv_permlane32_swap_b32 %0, %1" : "+v"(a), "+v"(b)); }
__device__ __forceinline__ float xq_sum(float v) { float a = v, b = v; swap16(a, b); v = a + b; a = v; b = v; swap32(a, b); return a + b; }
__device__ __forceinline__ float wave_sum(float v) { return xq_sum(row16_sum(v)); }
__device__ __forceinline__ float xq_max(float v) { float a = v, b = v; swap16(a, b); v = fmaxf(a, b); a = v; b = v; swap32(a, b); return fmaxf(a, b); }
__device__ __forceinline__ float shfl_up_l(float v, int o, int lane_) { const int src = lane_ - o < 0 ? lane_ : lane_ - o; return __builtin_bit_cast(float, __builtin_amdgcn_ds_bpermute(src << 2, __builtin_bit_cast(int, v))); }
__device__ __forceinline__ float row16_max(float v) { v = fmaxf(v, DPP_F(v, 0xB1)); v = fmaxf(v, DPP_F(v, 0x4E)); v = fmaxf(v, DPP_F(v, 0x141)); v = fmaxf(v, DPP_F(v, 0x140)); return v; }
__device__ __forceinline__ float wave_max(float v) { return xq_max(row16_max(v)); }
__device__ __forceinline__ float sigmoidf_(float x) { return __builtin_amdgcn_rcpf(1.f + __expf(-x)); }
__device__ __forceinline__ float siluf_(float x) { return x * __builtin_amdgcn_rcpf(1.f + __expf(-x)); }

__device__ __forceinline__ unsigned pk_fp8x4(float a, float b, float c, float d) {
    int p = 0; p = __builtin_amdgcn_cvt_pk_fp8_f32(a, b, p, false); p = __builtin_amdgcn_cvt_pk_fp8_f32(c, d, p, true); return (unsigned)p;
}
__device__ __forceinline__ int w8_row(int dr) { return (dr >= 6144 && dr < 12288) ? dr - 6144 : (dr >= 14592 ? 6144 + (dr - 14592) : -1); }
__device__ __forceinline__ int wt_row(int c) {
    int r;
    if (c < 2048) r = c;
    else if (c < 4096) r = WT_T + TV + (c - 2048);
    else if (c < 6144) r = UO + (c - 4096);
    else if (c < 8192) r = UZ + (c - 6144);
    else if (c < 8208) r = WT_SMALL + (c - 8192);
    else if (c < 10256) r = UNQ + (c - 8208);
    else if (c < 11280) r = UKC + (c - 10256);
    else if (c < 11792) r = UKS + (c - 11280);
    else if (c < 12304) r = WT_T + TVS + (c - 11792);
    else if (c < 12816) r = UKW + (c - 12304);
    else if (c < 13328) r = WT_T + TVW + (c - 12816);
    else if (c < 13376) r = WT_SMALL + 16 + (c - 13328);
    else r = UNZ + (c - 13376);
    return r;
}

namespace pg8 {
constexpr int BM = 256, BK = 64, HALF = 128, HTB = HALF * BK * 2, STAGE_BYTES = 8 * HTB, NXCD = 8, WGM = 8;
__host__ __device__ __forceinline__ int lds_byte(int r, int c) { const int st = (r >> 4) * 2 + (c >> 5), rr = r & 15, cc = c & 31, ob = rr * 64 + cc * 2; return st * 1024 + (ob ^ (((ob >> 9) & 1) << 5)); }
__host__ __device__ __forceinline__ void stage_rc(int b, int& R, int& C) { const int st = b / 1024, sb = b % 1024, swz = sb ^ (((sb >> 9) & 1) << 5); R = (st >> 1) * 16 + swz / 64; C = (st & 1) * 32 + (swz % 64) / 2; }
__host__ __device__ __forceinline__ int perm32(int rho) { const int n = rho >> 4, i = rho & 15; return 8 * (i >> 2) + 4 * n + (i & 3); }

struct Unit { const char* a; const char* b; int pm, pn, kind; };

__device__ __forceinline__ void tile_order(int L, int nM, int nN, int& pm, int& pn) {
    const int nwg = nM * nN; int wgid = L;
    { const int q = nwg / NXCD, r = nwg % NXCD, xcd = wgid % NXCD, off = wgid / NXCD; wgid = (xcd < r ? xcd * (q + 1) : r * (q + 1) + (xcd - r) * q) + off; }
    const int nig = WGM * nN, gid = wgid / nig, fm = gid * WGM, gsz = (nM - fm) < WGM ? (nM - fm) : WGM;
    pm = fm + ((wgid % nig) % gsz); pn = (wgid % nig) / gsz;
}
struct Sched2 {
    const char* a0; const char* b0; int nM0, nN0, kind0;
    const char* a1; const char* b1; int nM1, nN1, kind1;
    int K, G, c; int i0 = 0, n = 1 << 30;
    __device__ __forceinline__ bool next(int i, Unit& u) const {
        if (i >= n) return false;
        const long L = (long)(i0 + i) * G + c; const int n0 = nM0 * nN0, n1 = nM1 * nN1; const size_t tstep = (size_t)BM * K * 2;
        if (L < n0) { int pm, pn; tile_order((int)L, nM0, nN0, pm, pn); u.pm = pm; u.pn = pn; u.kind = kind0; u.a = a0 + (size_t)pm * tstep; u.b = b0 + (size_t)pn * tstep; return true; }
        if (L < n0 + n1) { int pm, pn; tile_order((int)(L - n0), nM1, nN1, pm, pn); u.pm = pm; u.pn = pn; u.kind = kind1; u.a = a1 + (size_t)pm * tstep; u.b = b1 + (size_t)pn * tstep; return true; }
        return false;
    }
};

struct SchedG1B {
    const char* hb; const char* wt; int G, c;
    __device__ __forceinline__ bool next(int i, Unit& u) const {
        const int L = i * G + c; const size_t tstep = (size_t)BM * 4096 * 2; int pm, pn;
        if (L < 768) { tile_order(L, 32, 24, pm, pn); u.kind = 0; u.pm = pm; u.pn = pn; u.a = hb + (size_t)pm * tstep; u.b = wt + (size_t)pn * tstep; return true; }
        if (L < 800) { pm = L - 768; u.kind = 0; u.pm = pm; u.pn = 48; u.a = hb + (size_t)pm * tstep; u.b = wt + (size_t)48 * tstep; return true; }
        if (L < 1056) { tile_order(L - 800, 8, 32, pm, pn); u.kind = 1; u.pm = pm; u.pn = pn; u.a = wt + (size_t)(49 + pm) * tstep; u.b = hb + (size_t)pn * tstep; return true; }
        return false;
    }
};
struct SchedG1F {
    const char* hb8; const char* w8; int G, c;
    __device__ __forceinline__ bool next(int i, Unit& u) const {
        int M;
        if (G == 256) { int h = i; if (c < 32) h += 2;
            if (h == 0) M = c - 32; else if (h == 1) M = 224 + (c - 32); else if (h == 2) M = 448 + c; else if (h == 3 && c < 192) M = 704 + c; else return false; }
        else { M = i * G + c; if (M >= 896) return false; }
        const size_t tstep = (size_t)BM * 4096; int pm, pn;
        if (M < 768) { tile_order(M, 32, 24, pm, pn); u.kind = 0; u.pm = pm; u.pn = 24 + pn; u.a = hb8 + (size_t)pm * tstep; u.b = w8 + (size_t)pn * tstep; }
        else { tile_order(M - 768, 4, 32, pm, pn); u.kind = 1; u.pm = 8 + pm; u.pn = pn; u.a = w8 + (size_t)(24 + pm) * tstep; u.b = hb8 + (size_t)pn * tstep; }
        return true;
    }
};

__device__ __forceinline__ unsigned cvt_pk_bf16(float lo, float hi) { return pk2(lo, hi); }

__device__ __forceinline__ const char* uniform_ptr(const char* p) {
    const unsigned long long v = (unsigned long long)p;
    const unsigned lo = __builtin_amdgcn_readfirstlane((unsigned)v), hi = __builtin_amdgcn_readfirstlane((unsigned)(v >> 32));
    return (const char*)(((unsigned long long)hi << 32) | lo);
}
typedef int i32x8 __attribute__((ext_vector_type(8)));
typedef int i32x4v __attribute__((ext_vector_type(4)));
__device__ __forceinline__ i32x8 cat8(bf16x8 a, bf16x8 b) { const i32x4v x = __builtin_bit_cast(i32x4v, a), y = __builtin_bit_cast(i32x4v, b); return (i32x8){x[0], x[1], x[2], x[3], y[0], y[1], y[2], y[3]}; }
template <class Epi, class Sched, bool FP8 = false>
__device__ __forceinline__ void gemm_phase(LAS unsigned char* lds, const int K, const Sched& S, const Epi& E) {
    const int tid = opaque_tid(), wid = __builtin_amdgcn_readfirstlane(tid >> 6), lane = tid & 63, wr = wid >> 2, wc = wid & 3, fr = lane & 15, fq = lane >> 4;
    const int nt = K / BK;
    unsigned voffA[2], voffB[2];
#pragma unroll
    for (int i = 0; i < 2; ++i) { int R, C; stage_rc(tid * 16 + i * 8192, R, C); const int Rb = (R & ~31) + perm32(R & 31);
        voffA[i] = (unsigned)(R * K + C) * 2u; voffB[i] = (unsigned)(Rb * K + C) * 2u; }
    const size_t kstep = (size_t)(BK * 2);
    const size_t hstep = (size_t)HALF * K * 2;
    const unsigned ldsw = (unsigned)wid * 1024u;
    int aoff = lds_byte(wr * 64 + fr, fq * 8), boff = lds_byte(wc * 32 + fr, fq * 8); asm volatile("" : "+v"(aoff), "+v"(boff));
#define PG8_SA(b, h) (((b) * 2 + (h)) * HTB)
#define PG8_SB(b, h) ((4 + (b) * 2 + (h)) * HTB)
#define PG8_VOFF(i_, isB_) ([&]() -> unsigned { int R_, C_; stage_rc((opaque_tid()) * 16 + (i_) * 8192, R_, C_); if (isB_) R_ = (R_ & ~31) + perm32(R_ & 31); return (unsigned)(R_ * K + C_) * 2u; }())
#define PG8_STAGE(bufoff, gbase, voff) do { _Pragma("unroll") for (int _i = 0; _i < 2; ++_i) { \
        unsigned vo_ = (voff)[_i]; if constexpr (FP8) { vo_ = (voff)[0]; asm volatile("" : "+v"(vo_)); vo_ += (unsigned)_i * (unsigned)(64 * K * 2); }     \
        __builtin_amdgcn_global_load_lds((const unsigned*)((const char*)(gbase) + vo_), (LAS unsigned*)(lds + (bufoff) + ldsw + _i * 8192), 16, 0, 0); } } while (0)
#define PG8_LDA(dst, b, h) do { if constexpr (FP8) { _Pragma("unroll") for (int m = 0; m < 4; ++m) { const i32x4v lo_ = *(const LAS i32x4v*)(lds + PG8_SA(b, h) + aoff + m * 2048), hi_ = *(const LAS i32x4v*)(lds + PG8_SA(b, h) + aoff + m * 2048 + 1024); \
            dst##8[m] = __builtin_shufflevector(lo_, hi_, 0, 1, 2, 3, 4, 5, 6, 7); } } \
        else { _Pragma("unroll") for (int m = 0; m < 4; ++m) _Pragma("unroll") for (int k = 0; k < 2; ++k) dst[m][k] = *(const LAS bf16x8*)(lds + PG8_SA(b, h) + aoff + m * 2048 + k * 1024); } } while (0)
#define PG8_LDB(dst, b, h) do { if constexpr (FP8) { _Pragma("unroll") for (int n = 0; n < 2; ++n) { const i32x4v lo_ = *(const LAS i32x4v*)(lds + PG8_SB(b, h) + boff + n * 2048), hi_ = *(const LAS i32x4v*)(lds + PG8_SB(b, h) + boff + n * 2048 + 1024); \
            dst##8[n] = __builtin_shufflevector(lo_, hi_, 0, 1, 2, 3, 4, 5, 6, 7); } } \
        else { _Pragma("unroll") for (int n = 0; n < 2; ++n) _Pragma("unroll") for (int k = 0; k < 2; ++k) dst[n][k] = *(const LAS bf16x8*)(lds + PG8_SB(b, h) + boff + n * 2048 + k * 1024); } } while (0)
#define PG8_MMA(ai, bj, At, Bt) do { __builtin_amdgcn_s_setprio(1); _Pragma("unroll") for (int m = 0; m < 4; ++m) _Pragma("unroll") for (int n = 0; n < 2; ++n) { \
        if constexpr (FP8) acc[ai][bj][m][n] = __builtin_amdgcn_mfma_scale_f32_16x16x128_f8f6f4(Bt##8[n], At##8[m], acc[ai][bj][m][n], 0, 0, 0, 121, 0, 127); \
        else { _Pragma("unroll") for (int k = 0; k < 2; ++k) acc[ai][bj][m][n] = __builtin_amdgcn_mfma_f32_16x16x32_bf16(Bt[n][k], At[m][k], acc[ai][bj][m][n], 0, 0, 0); } } \
        __builtin_amdgcn_s_setprio(0); } while (0)
#define PG8_WAIT_V(n) asm volatile("s_waitcnt vmcnt(" #n ")" ::: "memory")
#define PG8_WAIT_L(n) asm volatile("s_waitcnt lgkmcnt(" #n ")" ::: "memory")
#define PG8_BAR __builtin_amdgcn_s_barrier()
#define PG8_SCHED __builtin_amdgcn_sched_barrier(0)
    Unit cur, nxt; int ui = 0;
    if (!S.next(0, cur)) return;
    f32x4 acc[2][2][4][2];
#pragma unroll
    for (int a = 0; a < 2; ++a)
#pragma unroll
        for (int b = 0; b < 2; ++b)
#pragma unroll
            for (int m = 0; m < 4; ++m)
#pragma unroll
                for (int n = 0; n < 2; ++n) acc[a][b][m][n] = (f32x4){0.f, 0.f, 0.f, 0.f};
    bf16x8 At[4][2], B0[2][2], B1[2][2];
    i32x8 At8[4], B08[2], B18[2];
    const char* cA = cur.a; const char* cB = cur.b;
    PG8_STAGE(PG8_SB(0, 0), cB, voffB); PG8_STAGE(PG8_SB(0, 1), cB + hstep, voffB); PG8_STAGE(PG8_SA(0, 0), cA, voffA); PG8_STAGE(PG8_SA(0, 1), cA + hstep, voffA);
    if (wr == 1) PG8_BAR;
    PG8_WAIT_V(2); PG8_BAR;
    PG8_STAGE(PG8_SB(1, 0), cB + kstep, voffB); PG8_STAGE(PG8_SA(1, 0), cA + kstep, voffA); PG8_STAGE(PG8_SB(1, 1), cB + hstep + kstep, voffB);
    PG8_WAIT_V(6); PG8_BAR;
    for (;;) {
        const bool has_next = S.next(ui + 1, nxt);
        const char* nA = has_next ? nxt.a : cA; const char* nB = has_next ? nxt.b : cB;
        for (int t = 0; t < nt; t += 2) {
            const bool last = (t == nt - 2);
            const char* a1 = uniform_ptr(cA + (size_t)(t + 1) * kstep);
            const char* a2 = uniform_ptr(last ? nA : cA + (size_t)(t + 2) * kstep); const char* b2 = uniform_ptr(last ? nB : cB + (size_t)(t + 2) * kstep);
            const char* a3 = uniform_ptr(a2 + kstep); const char* b3 = uniform_ptr(b2 + kstep);
            PG8_LDB(B0, 0, 0); PG8_LDB(B1, 0, 1); PG8_SCHED; PG8_LDA(At, 0, 0); PG8_STAGE(PG8_SA(1, 1), a1 + hstep, voffA);
            PG8_WAIT_V(8); PG8_WAIT_L(0); PG8_BAR; PG8_MMA(0, 0, At, B0); PG8_MMA(0, 1, At, B1); PG8_BAR; PG8_SCHED;
            PG8_LDA(At, 0, 1); PG8_STAGE(PG8_SB(0, 0), b2, voffB); PG8_STAGE(PG8_SB(0, 1), b2 + hstep, voffB); PG8_STAGE(PG8_SA(0, 0), a2, voffA);
            PG8_WAIT_V(8); PG8_WAIT_L(0); PG8_BAR; PG8_MMA(1, 0, At, B0); PG8_MMA(1, 1, At, B1); PG8_BAR; PG8_SCHED;
            PG8_LDB(B0, 1, 0); PG8_LDB(B1, 1, 1); PG8_SCHED; PG8_LDA(At, 1, 0); PG8_STAGE(PG8_SA(0, 1), a2 + hstep, voffA);
            PG8_WAIT_V(8); PG8_WAIT_L(0); PG8_BAR; PG8_MMA(0, 0, At, B0); PG8_MMA(0, 1, At, B1); PG8_BAR; PG8_SCHED;
            PG8_LDA(At, 1, 1); PG8_STAGE(PG8_SB(1, 0), b3, voffB); PG8_STAGE(PG8_SB(1, 1), b3 + hstep, voffB); PG8_STAGE(PG8_SA(1, 0), a3, voffA);
            PG8_WAIT_V(8); PG8_WAIT_L(0); PG8_BAR; PG8_MMA(1, 0, At, B0); PG8_MMA(1, 1, At, B1); PG8_BAR; PG8_SCHED;
        }
        if (wr == 0) PG8_BAR;
        E(acc, cur, wr, wc, fr, fq);
        if (!has_next) break;
#pragma unroll
        for (int a = 0; a < 2; ++a)
#pragma unroll
            for (int b = 0; b < 2; ++b)
#pragma unroll
                for (int m = 0; m < 4; ++m)
#pragma unroll
                    for (int n = 0; n < 2; ++n) acc[a][b][m][n] = (f32x4){0.f, 0.f, 0.f, 0.f};
        cur = nxt; cA = nA; cB = nB; ++ui;
        if (wr == 1) PG8_BAR;
    }
    PG8_WAIT_V(0);
    PG8_BAR;
#undef PG8_SA
#undef PG8_SB
#undef PG8_STAGE
#undef PG8_LDA
#undef PG8_LDB
#undef PG8_MMA
#undef PG8_WAIT_V
#undef PG8_WAIT_L
#undef PG8_BAR
#undef PG8_SCHED
}

struct UnitM { int pm, pn; };
struct SchedM {
    const char* a; const char* b; const char* a8; const char* b8; int nM, nN, G, c;
    __device__ __forceinline__ bool next(int i, UnitM& u) const {
        const long L = (long)i * G + c; if (L >= (long)nM * nN) return false;
        int pm, pn; tile_order((int)L, nM, nN, pm, pn); u.pm = __builtin_amdgcn_readfirstlane(pm); u.pn = __builtin_amdgcn_readfirstlane(pn); return true;
    }
};
template <class Epi>
__device__ __forceinline__ void gemm_phase_mixed(LAS unsigned char* lds, const SchedM& S, const Epi& E) {
    constexpr int NT1 = 32, NT = 48;
    const int tid = opaque_tid(), wid = __builtin_amdgcn_readfirstlane(tid >> 6), lane = tid & 63, wr = wid >> 2, wc = wid & 3, fr = lane & 15, fq = lane >> 4;
    unsigned voffA0, voffB0;
    { int R, C; stage_rc(tid * 16, R, C); const int Rb = (R & ~31) + perm32(R & 31); voffA0 = (unsigned)(R * 8192 + 2 * C); voffB0 = (unsigned)(Rb * 8192 + 2 * C); }
    const unsigned ldsw = (unsigned)wid * 1024u;
    const int aoff = lds_byte(wr * 64 + fr, fq * 8), boff = lds_byte(wc * 32 + fr, fq * 8);
#define MX_SA(b, h) (((b) * 2 + (h)) * HTB)
#define MX_SB(b, h) ((4 + (b) * 2 + (h)) * HTB)
#define MX_STAGE(bufoff, ISB, PX, tt, half, VOFF0, M) do { \
        const char* gb_ = uniform_ptr((M) ? ((ISB) ? S.b8 : S.a8) + (size_t)(PX) * (256 * 2048) + (size_t)((tt) - NT1) * 128 + (size_t)(half) * 128 * 2048 \
                                          : ((ISB) ? S.b : S.a) + (size_t)(PX) * (256 * 8192) + (size_t)(tt) * 128 + (size_t)(half) * 128 * 8192); \
        unsigned v0_ = (VOFF0); asm volatile("" : "+v"(v0_)); if (M) v0_ -= (v0_ >> 13) * 6144u; \
        _Pragma("unroll") for (int _i = 0; _i < 2; ++_i) { const unsigned vo_ = v0_ + (unsigned)_i * ((M) ? 64u * 2048u : 64u * 8192u); \
            __builtin_amdgcn_global_load_lds((const unsigned*)(gb_ + vo_), (LAS unsigned*)(lds + (bufoff) + ldsw + _i * 8192), 16, 0, 0); } } while (0)
#define MX_PIN(ai, bj) do { _Pragma("unroll") for (int m = 0; m < 4; ++m) _Pragma("unroll") for (int n = 0; n < 2; ++n) asm volatile("" : "+v"(acc[ai][bj][m][n])); } while (0)
#define MX_LDA0(b, h) do { _Pragma("unroll") for (int m = 0; m < 4; ++m) _Pragma("unroll") for (int k = 0; k < 2; ++k) At[m][k] = *(const LAS bf16x8*)(lds + MX_SA(b, h) + aoff + m * 2048 + k * 1024); } while (0)
#define MX_LDB0(dst, b, h) do { _Pragma("unroll") for (int n = 0; n < 2; ++n) _Pragma("unroll") for (int k = 0; k < 2; ++k) dst[n][k] = *(const LAS bf16x8*)(lds + MX_SB(b, h) + boff + n * 2048 + k * 1024); } while (0)
#define MX_MMA0(ai, bj, Bt) do { __builtin_amdgcn_s_setprio(1); _Pragma("unroll") for (int m = 0; m < 4; ++m) _Pragma("unroll") for (int n = 0; n < 2; ++n) _Pragma("unroll") for (int k = 0; k < 2; ++k) \
        acc[ai][bj][m][n] = __builtin_amdgcn_mfma_f32_16x16x32_bf16(Bt[n][k], At[m][k], acc[ai][bj][m][n], 0, 0, 0); MX_PIN(ai, bj); __builtin_amdgcn_s_setprio(0); } while (0)
#define MX_LDA1(b, h) do { _Pragma("unroll") for (int m = 0; m < 4; ++m) { const i32x4v lo_ = *(const LAS i32x4v*)(lds + MX_SA(b, h) + aoff + m * 2048), hi_ = *(const LAS i32x4v*)(lds + MX_SA(b, h) + aoff + m * 2048 + 1024); \
        At8[m] = __builtin_shufflevector(lo_, hi_, 0, 1, 2, 3, 4, 5, 6, 7); } } while (0)
#define MX_LDB1(dst, b, h) do { _Pragma("unroll") for (int n = 0; n < 2; ++n) { const i32x4v lo_ = *(const LAS i32x4v*)(lds + MX_SB(b, h) + boff + n * 2048), hi_ = *(const LAS i32x4v*)(lds + MX_SB(b, h) + boff + n * 2048 + 1024); \
        dst##8[n] = __builtin_shufflevector(lo_, hi_, 0, 1, 2, 3, 4, 5, 6, 7); } } while (0)
#define MX_MMA1(ai, bj, Bt) do { __builtin_amdgcn_s_setprio(1); _Pragma("unroll") for (int m = 0; m < 4; ++m) _Pragma("unroll") for (int n = 0; n < 2; ++n) \
        acc[ai][bj][m][n] = __builtin_amdgcn_mfma_scale_f32_16x16x128_f8f6f4(Bt##8[n], At8[m], acc[ai][bj][m][n], 0, 0, 0, 121, 0, 123); MX_PIN(ai, bj); __builtin_amdgcn_s_setprio(0); } while (0)
#define MX_WAIT_V(n) asm volatile("s_waitcnt vmcnt(" #n ")" ::: "memory")
#define MX_WAIT_L(n) asm volatile("s_waitcnt lgkmcnt(" #n ")" ::: "memory")
#define MX_BAR __builtin_amdgcn_s_barrier()
#define MX_SCHED __builtin_amdgcn_sched_barrier(0)
#define MX_BODY(F, G) do { \
        MX_LDB##F(B0, 0, 0); MX_LDB##F(B1, 0, 1); MX_SCHED; MX_LDA##F(0, 0); MX_STAGE(MX_SA(1, 1), 0, cur.pm, t + 1, 1, voffA0, F); \
        MX_WAIT_V(8); MX_WAIT_L(0); MX_BAR; MX_MMA##F(0, 0, B0); MX_MMA##F(0, 1, B1); MX_BAR; MX_SCHED; \
        MX_LDA##F(0, 1); MX_STAGE(MX_SB(0, 0), 1, xpn, i2, 0, voffB0, G); MX_STAGE(MX_SB(0, 1), 1, xpn, i2, 1, voffB0, G); MX_STAGE(MX_SA(0, 0), 0, xpm, i2, 0, voffA0, G); \
        MX_WAIT_V(8); MX_WAIT_L(0); MX_BAR; MX_MMA##F(1, 0, B0); MX_MMA##F(1, 1, B1); MX_BAR; MX_SCHED; \
        MX_LDB##F(B0, 1, 0); MX_LDB##F(B1, 1, 1); MX_SCHED; MX_LDA##F(1, 0); MX_STAGE(MX_SA(0, 1), 0, xpm, i2, 1, voffA0, G); \
        MX_WAIT_V(8); MX_WAIT_L(0); MX_BAR; MX_MMA##F(0, 0, B0); MX_MMA##F(0, 1, B1); MX_BAR; MX_SCHED; \
        MX_LDA##F(1, 1); MX_STAGE(MX_SB(1, 0), 1, xpn, i3, 0, voffB0, G); MX_STAGE(MX_SB(1, 1), 1, xpn, i3, 1, voffB0, G); MX_STAGE(MX_SA(1, 0), 0, xpm, i3, 0, voffA0, G); \
        MX_WAIT_V(8); MX_WAIT_L(0); MX_BAR; MX_MMA##F(1, 0, B0); MX_MMA##F(1, 1, B1); MX_BAR; MX_SCHED; } while (0)
    UnitM cur, nxt; int ui = 0;
    if (!S.next(0, cur)) return;
    f32x4 acc[2][2][4][2];
#pragma unroll
    for (int a = 0; a < 2; ++a)
#pragma unroll
        for (int b = 0; b < 2; ++b)
#pragma unroll
            for (int m = 0; m < 4; ++m)
#pragma unroll
                for (int n = 0; n < 2; ++n) acc[a][b][m][n] = (f32x4){0.f, 0.f, 0.f, 0.f};
    bf16x8 At[4][2], B0[2][2], B1[2][2];
    i32x8 At8[4], B08[2], B18[2];
    MX_STAGE(MX_SB(0, 0), 1, cur.pn, 0, 0, voffB0, 0); MX_STAGE(MX_SB(0, 1), 1, cur.pn, 0, 1, voffB0, 0); MX_STAGE(MX_SA(0, 0), 0, cur.pm, 0, 0, voffA0, 0); MX_STAGE(MX_SA(0, 1), 0, cur.pm, 0, 1, voffA0, 0);
    if (wr == 1) MX_BAR;
    MX_WAIT_V(2); MX_BAR;
    MX_STAGE(MX_SB(1, 0), 1, cur.pn, 1, 0, voffB0, 0); MX_STAGE(MX_SA(1, 0), 0, cur.pm, 1, 0, voffA0, 0); MX_STAGE(MX_SB(1, 1), 1, cur.pn, 1, 1, voffB0, 0);
    MX_WAIT_V(6); MX_BAR;
    for (;;) {
        const bool has_next = S.next(ui + 1, nxt);
        if (!has_next) nxt = cur;
        { const int xpm = cur.pm, xpn = cur.pn;
          for (int t = 0; t < NT1 - 2; t += 2) { const int i2 = t + 2, i3 = t + 3; MX_BODY(0, 0); }
          { const int t = NT1 - 2, i2 = NT1, i3 = NT1 + 1; MX_BODY(0, 1); }
          for (int t = NT1; t < NT - 2; t += 2) { const int i2 = t + 2, i3 = t + 3; MX_BODY(1, 1); } }
        { const int xpm = nxt.pm, xpn = nxt.pn; const int t = NT - 2, i2 = 0, i3 = 1; MX_BODY(1, 0); }
        if (wr == 0) MX_BAR;
        { Unit eu; eu.a = nullptr; eu.b = nullptr; eu.pm = cur.pm; eu.pn = cur.pn; eu.kind = 0; E(acc, eu, wr, wc, fr, fq); }
        if (!has_next) break;
#pragma unroll
        for (int a = 0; a < 2; ++a)
#pragma unroll
            for (int b = 0; b < 2; ++b)
#pragma unroll
                for (int m = 0; m < 4; ++m)
#pragma unroll
                    for (int n = 0; n < 2; ++n) acc[a][b][m][n] = (f32x4){0.f, 0.f, 0.f, 0.f};
        cur = nxt; ++ui;
        if (wr == 1) MX_BAR;
    }
    MX_WAIT_V(0);
    MX_BAR;
#undef MX_SA
#undef MX_SB
#undef MX_STAGE
#undef MX_LDA0
#undef MX_PIN
#undef MX_LDB0
#undef MX_MMA0
#undef MX_LDA1
#undef MX_LDB1
#undef MX_MMA1
#undef MX_WAIT_V
#undef MX_WAIT_L
#undef MX_BAR
#undef MX_SCHED
#undef MX_BODY
}

struct SchedC {
    const char* U; const char* w1k; const char* w1v; int ukc, uvc; int unit;
    __device__ __forceinline__ bool next(int i, UnitM& u) const { if (i > 0) return false; const int kv = unit & 1, pnh = (unit >> 1) & 1, bg = unit >> 2;
        u.pm = __builtin_amdgcn_readfirstlane(kv * 8 + bg); u.pn = __builtin_amdgcn_readfirstlane(kv * 2 + pnh); return true; }
    __device__ __forceinline__ const char* abase(int ca) const { const int kv = ca >> 3, bg = ca & 7; return U + ((size_t)((bg >> 2) * SEQ) * UW + (kv ? uvc : ukc) + (bg & 3) * 128) * 2; }
    __device__ __forceinline__ const char* bbase(int cb) const { return ((cb >> 1) ? w1v : w1k) + (size_t)(cb & 1) * 2048 * 2; }
};
template <class Epi>
__device__ __forceinline__ void gemm_cmp(LAS unsigned char* lds, const SchedC& S, const Epi& E) {
    constexpr int NT = 32; constexpr unsigned PITCHA = 16u * UW * 2u;
    const int tid = opaque_tid(), wid = __builtin_amdgcn_readfirstlane(tid >> 6), lane = tid & 63, wr = wid >> 2, wc = wid & 3, fr = lane & 15, fq = lane >> 4;
    unsigned voffA0, voffB0;
    { int R, C; stage_rc(tid * 16, R, C); const int Rb = (R & ~31) + perm32(R & 31); voffA0 = (unsigned)R * PITCHA + 2u * C; voffB0 = (unsigned)(Rb * 8192 + 2 * C); }
    const unsigned ldsw = (unsigned)wid * 1024u;
    const int aoff = lds_byte(wr * 64 + fr, fq * 8), boff = lds_byte(wc * 32 + fr, fq * 8);
#define MX_SA(b, h) (((b) * 2 + (h)) * HTB)
#define MX_SB(b, h) ((4 + (b) * 2 + (h)) * HTB)
#define MX_STAGE(bufoff, ISB, PX, tt, half, VOFF0, M) do { \
        const char* gb_ = uniform_ptr((ISB) ? S.bbase(PX) + (size_t)(tt) * 128 + (size_t)(half) * 128 * 8192 \
                                            : S.abase(PX) + (size_t)((tt) >> 1) * (UW * 2) + (size_t)((tt) & 1) * 128 + (size_t)(half) * 128 * PITCHA); \
        unsigned v0_ = (VOFF0); asm volatile("" : "+v"(v0_)); \
        _Pragma("unroll") for (int _i = 0; _i < 2; ++_i) { const unsigned vo_ = v0_ + (unsigned)_i * ((ISB) ? 64u * 8192u : 64u * PITCHA); \
            __builtin_amdgcn_global_load_lds((const unsigned*)(gb_ + vo_), (LAS unsigned*)(lds + (bufoff) + ldsw + _i * 8192), 16, 0, 0); } } while (0)
#define MX_PIN(ai, bj) do { _Pragma("unroll") for (int m = 0; m < 4; ++m) _Pragma("unroll") for (int n = 0; n < 2; ++n) asm volatile("" : "+v"(acc[ai][bj][m][n])); } while (0)
#define MX_LDA0(b, h) do { _Pragma("unroll") for (int m = 0; m < 4; ++m) _Pragma("unroll") for (int k = 0; k < 2; ++k) At[m][k] = *(const LAS bf16x8*)(lds + MX_SA(b, h) + aoff + m * 2048 + k * 1024); } while (0)
#define MX_LDB0(dst, b, h) do { _Pragma("unroll") for (int n = 0; n < 2; ++n) _Pragma("unroll") for (int k = 0; k < 2; ++k) dst[n][k] = *(const LAS bf16x8*)(lds + MX_SB(b, h) + boff + n * 2048 + k * 1024); } while (0)
#define MX_MMA0(ai, bj, Bt) do { __builtin_amdgcn_s_setprio(1); _Pragma("unroll") for (int m = 0; m < 4; ++m) _Pragma("unroll") for (int n = 0; n < 2; ++n) _Pragma("unroll") for (int k = 0; k < 2; ++k) \
        acc[ai][bj][m][n] = __builtin_amdgcn_mfma_f32_16x16x32_bf16(Bt[n][k], At[m][k], acc[ai][bj][m][n], 0, 0, 0); MX_PIN(ai, bj); __builtin_amdgcn_s_setprio(0); } while (0)
#define MX_WAIT_V(n) asm volatile("s_waitcnt vmcnt(" #n ")" ::: "memory")
#define MX_WAIT_L(n) asm volatile("s_waitcnt lgkmcnt(" #n ")" ::: "memory")
#define MX_BAR __builtin_amdgcn_s_barrier()
#define MX_SCHED __builtin_amdgcn_sched_barrier(0)
#define MX_BODY(F, G) do { \
        MX_LDB##F(B0, 0, 0); MX_LDB##F(B1, 0, 1); MX_SCHED; MX_LDA##F(0, 0); MX_STAGE(MX_SA(1, 1), 0, cur.pm, t + 1, 1, voffA0, F); \
        MX_WAIT_V(8); MX_WAIT_L(0); MX_BAR; MX_MMA##F(0, 0, B0); MX_MMA##F(0, 1, B1); MX_BAR; MX_SCHED; \
        MX_LDA##F(0, 1); MX_STAGE(MX_SB(0, 0), 1, xpn, i2, 0, voffB0, G); MX_STAGE(MX_SB(0, 1), 1, xpn, i2, 1, voffB0, G); MX_STAGE(MX_SA(0, 0), 0, xpm, i2, 0, voffA0, G); \
        MX_WAIT_V(8); MX_WAIT_L(0); MX_BAR; MX_MMA##F(1, 0, B0); MX_MMA##F(1, 1, B1); MX_BAR; MX_SCHED; \
        MX_LDB##F(B0, 1, 0); MX_LDB##F(B1, 1, 1); MX_SCHED; MX_LDA##F(1, 0); MX_STAGE(MX_SA(0, 1), 0, xpm, i2, 1, voffA0, G); \
        MX_WAIT_V(8); MX_WAIT_L(0); MX_BAR; MX_MMA##F(0, 0, B0); MX_MMA##F(0, 1, B1); MX_BAR; MX_SCHED; \
        MX_LDA##F(1, 1); MX_STAGE(MX_SB(1, 0), 1, xpn, i3, 0, voffB0, G); MX_STAGE(MX_SB(1, 1), 1, xpn, i3, 1, voffB0, G); MX_STAGE(MX_SA(1, 0), 0, xpm, i3, 0, voffA0, G); \
        MX_WAIT_V(8); MX_WAIT_L(0); MX_BAR; MX_MMA##F(1, 0, B0); MX_MMA##F(1, 1, B1); MX_BAR; MX_SCHED; } while (0)
    UnitM cur, nxt; int ui = 0;
    if (!S.next(0, cur)) return;
    f32x4 acc[2][2][4][2];
#pragma unroll
    for (int a = 0; a < 2; ++a)
#pragma unroll
        for (int b = 0; b < 2; ++b)
#pragma unroll
            for (int m = 0; m < 4; ++m)
#pragma unroll
                for (int n = 0; n < 2; ++n) acc[a][b][m][n] = (f32x4){0.f, 0.f, 0.f, 0.f};
    bf16x8 At[4][2], B0[2][2], B1[2][2];
    MX_STAGE(MX_SB(0, 0), 1, cur.pn, 0, 0, voffB0, 0); MX_STAGE(MX_SB(0, 1), 1, cur.pn, 0, 1, voffB0, 0); MX_STAGE(MX_SA(0, 0), 0, cur.pm, 0, 0, voffA0, 0); MX_STAGE(MX_SA(0, 1), 0, cur.pm, 0, 1, voffA0, 0);
    if (wr == 1) MX_BAR;
    MX_WAIT_V(2); MX_BAR;
    MX_STAGE(MX_SB(1, 0), 1, cur.pn, 1, 0, voffB0, 0); MX_STAGE(MX_SA(1, 0), 0, cur.pm, 1, 0, voffA0, 0); MX_STAGE(MX_SB(1, 1), 1, cur.pn, 1, 1, voffB0, 0);
    MX_WAIT_V(6); MX_BAR;
    for (;;) {
        const bool has_next = S.next(ui + 1, nxt);
        if (!has_next) nxt = cur;
        { const int xpm = cur.pm, xpn = cur.pn;
          for (int t = 0; t < NT - 2; t += 2) { const int i2 = t + 2, i3 = t + 3; MX_BODY(0, 0); } }
        { const int xpm = nxt.pm, xpn = nxt.pn; const int t = NT - 2, i2 = 0, i3 = 1; MX_BODY(0, 0); }
        if (wr == 0) MX_BAR;
        { Unit eu; eu.a = nullptr; eu.b = nullptr; eu.pm = cur.pm; eu.pn = cur.pn; eu.kind = 0; E(acc, eu, wr, wc, fr, fq); }
        if (!has_next) break;
#pragma unroll
        for (int a = 0; a < 2; ++a)
#pragma unroll
            for (int b = 0; b < 2; ++b)
#pragma unroll
                for (int m = 0; m < 4; ++m)
#pragma unroll
                    for (int n = 0; n < 2; ++n) acc[a][b][m][n] = (f32x4){0.f, 0.f, 0.f, 0.f};
        cur = nxt; ++ui;
        if (wr == 1) MX_BAR;
    }
    MX_WAIT_V(0);
    MX_BAR;
#undef MX_SA
#undef MX_SB
#undef MX_STAGE
#undef MX_LDA0
#undef MX_PIN
#undef MX_LDB0
#undef MX_MMA0
#undef MX_WAIT_V
#undef MX_WAIT_L
#undef MX_BAR
#undef MX_SCHED
#undef MX_BODY
}
}

struct EpiStore {
    bf16_t* U; float* small; bf16_t* T; bf16_t* O2; int ldc2;
    __device__ __forceinline__ void operator()(const f32x4 (&acc)[2][2][4][2], const pg8::Unit& u, int wr, int wc, int fr_, int fq_) const {
        const int lane_ = opaque_tid() & 63, fr = lane_ & 15, fq = lane_ >> 4; (void)fr_; (void)fq_;
        const int row0 = u.pm * 256 + wr * 64 + fr;
        if (u.kind == 0 && u.pn == 48) {
            int fq2 = fq; asm volatile("" : "+v"(fq2));
            if (wc < 2) {
#pragma unroll
                for (int ai = 0; ai < 2; ++ai)
#pragma unroll
                    for (int m = 0; m < 4; ++m) { float* rp = small + (size_t)(row0 + ai * 128 + m * 16) * 64 + wc * 32 + 8 * fq2;
                        *(f32x4*)rp = acc[ai][0][m][0]; *(f32x4*)(rp + 4) = acc[ai][0][m][1]; }
            }
            return;
        }
        bf16_t* base = u.kind == 0 ? U : (u.kind == 1 ? T : O2); const int ldc = u.kind == 0 ? UW : (u.kind == 1 ? MTOK : ldc2);
        const int col0 = u.pn * 256 + wc * 32 + 8 * fq;
#pragma unroll
        for (int ai = 0; ai < 2; ++ai)
#pragma unroll
            for (int m = 0; m < 4; ++m) { bf16_t* rowp = base + (size_t)(row0 + ai * 128 + m * 16) * ldc + col0;
#pragma unroll
                for (int bj = 0; bj < 2; ++bj) { const f32x4 v0 = acc[ai][bj][m][0], v1 = acc[ai][bj][m][1];
                    u32x4 w; w.x = pg8::cvt_pk_bf16(v0[0], v0[1]); w.y = pg8::cvt_pk_bf16(v0[2], v0[3]); w.z = pg8::cvt_pk_bf16(v1[0], v1[1]); w.w = pg8::cvt_pk_bf16(v1[2], v1[3]);
                    *(u32x4*)(rowp + bj * 128) = w; } }
    }
};
struct EpiZ {
    float* Z;
    __device__ __forceinline__ void operator()(const f32x4 (&acc)[2][2][4][2], const pg8::Unit& u, int wr, int wc, int fr_, int fq_) const {
        const int lane_ = opaque_tid() & 63, fr = lane_ & 15, fq = lane_ >> 4; (void)fr_; (void)fq_;
        float* base = Z + ((size_t)u.pm * 256 + wr * 64 + fr) * 512 + (u.pn & 1) * 256 + wc * 32 + 8 * fq;
#pragma unroll
        for (int ai = 0; ai < 2; ++ai)
#pragma unroll
            for (int m = 0; m < 4; ++m)
#pragma unroll
                for (int bj = 0; bj < 2; ++bj) { float* rp = base + (size_t)(ai * 128 + m * 16) * 512 + bj * 128; *(f32x4*)rp = acc[ai][bj][m][0]; *(f32x4*)(rp + 4) = acc[ai][bj][m][1]; }
    }
};
struct EpiRes {
    const float* x; bf16_t* x1b;
    __device__ __forceinline__ void operator()(const f32x4 (&acc)[2][2][4][2], const pg8::Unit& u, int wr, int wc, int fr, int fq) const {
        const int row0 = u.pm * 256 + wr * 64 + fr, col0 = u.pn * 256 + wc * 32 + 8 * fq;
#pragma unroll
        for (int ai = 0; ai < 2; ++ai) {
            f32x4 xa[4][2][2];
#pragma unroll
            for (int m = 0; m < 4; ++m) { const size_t off = (size_t)(row0 + ai * 128 + m * 16) * DM + col0;
#pragma unroll
                for (int bj = 0; bj < 2; ++bj) { xa[m][bj][0] = *(const f32x4*)(x + off + bj * 128); xa[m][bj][1] = *(const f32x4*)(x + off + bj * 128 + 4); } }
            __builtin_amdgcn_sched_barrier(0);
#pragma unroll
            for (int m = 0; m < 4; ++m) { const size_t off = (size_t)(row0 + ai * 128 + m * 16) * DM + col0;
#pragma unroll
                for (int bj = 0; bj < 2; ++bj) { const f32x4 v0 = acc[ai][bj][m][0] + xa[m][bj][0], v1 = acc[ai][bj][m][1] + xa[m][bj][1];
                    u32x4 w; w.x = pk2(v0[0], v0[1]); w.y = pk2(v0[2], v0[3]); w.z = pk2(v1[0], v1[1]); w.w = pk2(v1[2], v1[3]);
                    *(u32x4*)(x1b + off + bj * 128) = w; } }
            __builtin_amdgcn_sched_barrier(0);
        }
    }
};
struct EpiGate {
    float* out; const bf16_t* x1b; const bf16_t* pe;
    __device__ __forceinline__ void operator()(const f32x4 (&acc)[2][2][4][2], const pg8::Unit& u, int wr, int wc, int fr, int fq) const {
        const int row0 = u.pm * 256 + wr * 64 + fr, col0 = u.pn * 256 + wc * 32 + 8 * fq;
#pragma unroll
        for (int ai = 0; ai < 2; ++ai) {
            u32x4 xw[4][2], pw[4][2];
#pragma unroll
            for (int m = 0; m < 4; ++m) { const size_t off = (size_t)(row0 + ai * 128 + m * 16) * DM + col0;
#pragma unroll
                for (int bj = 0; bj < 2; ++bj) { xw[m][bj] = *(const u32x4*)(x1b + off + bj * 128); pw[m][bj] = *(const u32x4*)(pe + off + bj * 128); } }
            __builtin_amdgcn_sched_barrier(0);
#pragma unroll
            for (int m = 0; m < 4; ++m) { const size_t off = (size_t)(row0 + ai * 128 + m * 16) * DM + col0;
#pragma unroll
                for (int bj = 0; bj < 2; ++bj) { const u32x4 xv = xw[m][bj], pv = pw[m][bj];
                    const f32x4 a0 = acc[ai][bj][m][0], a1 = acc[ai][bj][m][1];
                    f32x4 v0, v1;
                    v0[0] = bflo(xv.x) + sigmoidf_(a0[0]) * bflo(pv.x); v0[1] = bfhi(xv.x) + sigmoidf_(a0[1]) * bfhi(pv.x);
                    v0[2] = bflo(xv.y) + sigmoidf_(a0[2]) * bflo(pv.y); v0[3] = bfhi(xv.y) + sigmoidf_(a0[3]) * bfhi(pv.y);
                    v1[0] = bflo(xv.z) + sigmoidf_(a1[0]) * bflo(pv.z); v1[1] = bfhi(xv.z) + sigmoidf_(a1[1]) * bfhi(pv.z);
                    v1[2] = bflo(xv.w) + sigmoidf_(a1[2]) * bflo(pv.w); v1[3] = bfhi(xv.w) + sigmoidf_(a1[3]) * bfhi(pv.w);
                    *(f32x4*)(out + off + bj * 128) = v0; *(f32x4*)(out + off + bj * 128 + 4) = v1; } }
            __builtin_amdgcn_sched_barrier(0);
        }
    }
};

constexpr size_t MiB = 1u << 20;
constexpr size_t WS_CTL = 0;
constexpr size_t WS_HB = 1 * MiB;
constexpr size_t WS_WT = WS_HB + 64 * MiB;
constexpr size_t WS_WOT = WS_WT + 122 * MiB;
constexpr size_t WS_WGT = WS_WOT + 32 * MiB;
constexpr size_t WS_WPT = WS_WGT + 32 * MiB;
constexpr size_t WS_PB = WS_WPT + 2 * MiB;
constexpr size_t WS_W1K = WS_PB + 4 * MiB;
constexpr size_t WS_W1V = WS_W1K + 2 * MiB;
constexpr size_t WS_W2 = WS_W1V + 2 * MiB;
constexpr size_t WS_U = WS_W2 + 1 * MiB;
constexpr size_t WS_T = WS_U + 192 * MiB;
constexpr size_t WS_SMALL = WS_T + 48 * MiB;
constexpr size_t WS_PE = WS_SMALL + 2 * MiB;
constexpr size_t WS_DCT = WS_PE + 64 * MiB;
constexpr size_t WS_CT = WS_DCT + 64 * MiB;
constexpr size_t WS_MLS = WS_CT + 64 * MiB;
constexpr size_t WS_NSA = WS_MLS + 2 * MiB;
constexpr size_t WS_OC = WS_NSA + 2 * MiB;
constexpr size_t WS_OW = WS_OC + 32 * MiB;
constexpr size_t WS_HB8 = WS_OW + 32 * MiB;
constexpr size_t WS_W8 = WS_HB8 + 32 * MiB;
constexpr size_t WS_Y8 = WS_W8 + 28 * MiB;
constexpr size_t WS_WO8 = WS_Y8 + 16 * MiB;
constexpr size_t WS_Z = WS_WO8 + 8 * MiB;
constexpr size_t WS_CP = WS_Z + 8 * MiB;
constexpr size_t WS_END = WS_CP + 1 * MiB;

struct Params {
    const float *x, *p, *norm_w, *w_in, *conv_w, *i_bias, *f_bias, *hnorm_w, *qnorm_w, *knorm_w, *pe_k, *pe_v, *k_w1, *k_w2, *v_w1, *v_w2, *rel_bias, *w_out, *ple_proj, *ple_gate;
    float* out;
    unsigned char* ws;
    __device__ __forceinline__ unsigned* ctl() const { return (unsigned*)(ws + (WS_CTL)); }
    __device__ __forceinline__ bf16_t* hb() const { return (bf16_t*)(ws + (WS_HB)); }
    __device__ __forceinline__ bf16_t* Wt() const { return (bf16_t*)(ws + (WS_WT)); }
    __device__ __forceinline__ bf16_t* WoT() const { return (bf16_t*)(ws + (WS_WOT)); }
    __device__ __forceinline__ bf16_t* WgT() const { return (bf16_t*)(ws + (WS_WGT)); }
    __device__ __forceinline__ bf16_t* WpT() const { return (bf16_t*)(ws + (WS_WPT)); }
    __device__ __forceinline__ bf16_t* pb() const { return (bf16_t*)(ws + (WS_PB)); }
    __device__ __forceinline__ bf16_t* w1kT() const { return (bf16_t*)(ws + (WS_W1K)); }
    __device__ __forceinline__ bf16_t* w1vT() const { return (bf16_t*)(ws + (WS_W1V)); }
    __device__ __forceinline__ bf16_t* w2kT() const { return (bf16_t*)(ws + (WS_W2)); }
    __device__ __forceinline__ bf16_t* w2vT() const { return (bf16_t*)(ws + (WS_W2 + 65536)); }
    __device__ __forceinline__ bf16_t* U() const { return (bf16_t*)(ws + (WS_U)); }
    __device__ __forceinline__ bf16_t* T() const { return (bf16_t*)(ws + (WS_T)); }
    __device__ __forceinline__ float* small() const { return (float*)(ws + (WS_SMALL)); }
    __device__ __forceinline__ bf16_t* y() const { return (bf16_t*)(ws + (WS_HB)); }
    __device__ __forceinline__ bf16_t* x1b() const { return (bf16_t*)(ws + (WS_WT)); }
    __device__ __forceinline__ bf16_t* pe() const { return (bf16_t*)(ws + (WS_PE)); }
    __device__ __forceinline__ bf16_t* dCt() const { return (bf16_t*)(ws + (WS_DCT)); }
    __device__ __forceinline__ bf16_t* Ct() const { return (bf16_t*)(ws + (WS_CT)); }
    __device__ __forceinline__ float* dn() const { return (float*)(ws + (WS_MLS)); }
    __device__ __forceinline__ float* nst() const { return (float*)(ws + (WS_MLS + 4 * 131072)); }
    __device__ __forceinline__ float* cbL() const { return (float*)(ws + (WS_MLS + 4 * 262144)); }
    __device__ __forceinline__ float* cgmax() const { return (float*)(ws + (WS_MLS + 4 * 263168)); }
    __device__ __forceinline__ float* cm() const { return (float*)(ws + (WS_MLS + 4 * 264192)); }
    __device__ __forceinline__ float* mb() const { return (float*)(ws + (WS_MLS + 4 * 265216)); }
    __device__ __forceinline__ float* mg() const { return (float*)(ws + (WS_MLS + 4 * (265216 + 65536))); }
    __device__ __forceinline__ bf16_t* kcmp() const { return (bf16_t*)(ws + (WS_NSA)); }
    __device__ __forceinline__ bf16_t* vcmpT() const { return (bf16_t*)(ws + (WS_NSA + 524288)); }
    __device__ __forceinline__ unsigned long long* sel() const { return (unsigned long long*)(ws + (WS_NSA + 1048576)); }
    __device__ __forceinline__ unsigned long long* selu() const { return (unsigned long long*)(ws + (WS_NSA + 1048576 + 262144)); }
    __device__ __forceinline__ bf16_t* oc() const { return (bf16_t*)(ws + (WS_OC)); }
    __device__ __forceinline__ bf16_t* ow() const { return (bf16_t*)(ws + (WS_OW)); }
    __device__ __forceinline__ unsigned char* hb8() const { return (unsigned char*)(ws + (WS_HB8)); }
    __device__ __forceinline__ unsigned char* W8() const { return (unsigned char*)(ws + (WS_W8)); }
    __device__ __forceinline__ unsigned char* y8() const { return (unsigned char*)(ws + (WS_Y8)); }
    __device__ __forceinline__ unsigned char* Wo8() const { return (unsigned char*)(ws + (WS_WO8)); }
    __device__ __forceinline__ float* Z() const { return (float*)(ws + (WS_Z)); }
    __device__ __forceinline__ float* cpart() const { return (float*)(ws + (WS_CP)); }
};
__host__ __device__ inline void fill_params(Params& P, void* const* d_in, void* d_out, void* d_ws) {
    const float* const* in = (const float* const*)d_in;
    P.x = in[0]; P.p = in[1]; P.norm_w = in[2]; P.w_in = in[3]; P.conv_w = in[4]; P.i_bias = in[5]; P.f_bias = in[6]; P.hnorm_w = in[7]; P.qnorm_w = in[8]; P.knorm_w = in[9];
    P.pe_k = in[10]; P.pe_v = in[11]; P.k_w1 = in[12]; P.k_w2 = in[13]; P.v_w1 = in[14]; P.v_w2 = in[15]; P.rel_bias = in[16]; P.w_out = in[17]; P.ple_proj = in[18]; P.ple_gate = in[19];
    P.out = (float*)d_out; P.ws = (unsigned char*)d_ws;
}

struct P0It { const float* W; bf16_t* WT; unsigned char* P8; const float* pev; float* cp; int K, N, item; bool remap; };
__device__ __forceinline__ P0It p0_decode(const Params& P, int r) {
    constexpr int I_IN = (DM / 64) * (INW / 32), I_SQ = (DM / 64) * (DM / 32), I_PP = (256 / 64) * (DM / 32), I_W1 = (DM / 64) * (256 / 32), I_W2 = (256 / 64) * (128 / 32);
    P0It a; a.pev = nullptr; a.cp = nullptr; a.P8 = nullptr; a.remap = false;
    if (r < I_IN) { a.W = P.w_in; a.K = DM; a.N = INW; a.WT = P.Wt(); a.remap = true; a.P8 = P.W8(); a.item = r; return a; } r -= I_IN;
    if (r < I_PP) { a.W = P.ple_proj; a.K = 256; a.N = DM; a.WT = P.WpT(); a.item = r; return a; } r -= I_PP;
    if (r < I_W1) { a.W = P.k_w1; a.K = DM; a.N = 256; a.WT = P.w1kT(); a.pev = P.pe_k; a.cp = P.cpart(); a.item = r; return a; } r -= I_W1;
    if (r < I_W1) { a.W = P.v_w1; a.K = DM; a.N = 256; a.WT = P.w1vT(); a.pev = P.pe_v; a.cp = P.cpart() + 64 * 256; a.item = r; return a; } r -= I_W1;
    if (r < I_W2) { a.W = P.k_w2; a.K = 256; a.N = 128; a.WT = P.w2kT(); a.item = r; return a; } r -= I_W2;
    a.W = P.v_w2; a.K = 256; a.N = 128; a.WT = P.w2vT(); a.item = r; return a;
}
__device__ __forceinline__ void p0_load(const P0It& a, int lane, float (&wv)[32]) {
    const int nblk = a.N / 32, kb = a.item / nblk, nb = a.item % nblk;
    const float* wp = a.W + (size_t)(64 * kb + (lane >> 5)) * a.N + 32 * nb + (lane & 31);
#pragma unroll
    for (int i = 0; i < 32; ++i) wv[i] = wp[(size_t)(2 * i) * a.N];
}
__device__ __forceinline__ void p0_finish(const P0It& a, LAS float* scr, int lane, const float (&wv)[32]) {
    const float* W = a.W; const int K = a.K, N = a.N; bf16_t* WT = a.WT; const bool remap = a.remap; unsigned char* P8 = a.P8; const float* pev = a.pev; float* cp = a.cp;
    const int nblk = N / 32, kb = a.item / nblk, nb = a.item % nblk, k0 = 64 * kb, n0 = 32 * nb; (void)W;
#pragma unroll
    for (int i = 0; i < 32; ++i) scr[(2 * i + (lane >> 5)) * 33 + (lane & 31)] = wv[i];
    asm volatile("s_waitcnt lgkmcnt(0)" ::: "memory");
    if (pev != nullptr) {
        const int n = lane & 31, kh = lane >> 5; float s = 0.f;
#pragma unroll 8
        for (int kk = 0; kk < 32; ++kk) s += scr[(kh * 32 + kk) * 33 + n] * pev[k0 + kh * 32 + kk];
        { float a_ = s, b_ = s; swap32(a_, b_); s = a_ + b_; }
        if (lane < 32) cp[(size_t)kb * N + n0 + n] = s;
    }
    const int c = lane & 7;
#pragma unroll
    for (int j = 0; j < 4; ++j) { const int n = (lane >> 3) + 8 * j; const LAS float* s = scr + (8 * c) * 33 + n;
        u32x4 o; o.x = pk2(s[0 * 33], s[1 * 33]); o.y = pk2(s[2 * 33], s[3 * 33]); o.z = pk2(s[4 * 33], s[5 * 33]); o.w = pk2(s[6 * 33], s[7 * 33]);
        const int dr = remap ? wt_row(n0 + n) : (n0 + n);
        int r8 = remap ? w8_row(dr) : -1; int kk8 = k0;
        if (!remap && P8 != nullptr && k0 >= 2048) { r8 = dr; kk8 = k0 - 2048; }
        const size_t pitch8 = remap ? 4096 : 2048;
        if (r8 < 0) *(u32x4*)(WT + (size_t)dr * K + k0 + 8 * c) = o;
        else { u32x2 q8; q8.x = pk_fp8x4(64.f * s[0 * 33], 64.f * s[1 * 33], 64.f * s[2 * 33], 64.f * s[3 * 33]); q8.y = pk_fp8x4(64.f * s[4 * 33], 64.f * s[5 * 33], 64.f * s[6 * 33], 64.f * s[7 * 33]);
               *(u32x2*)(P8 + (size_t)r8 * pitch8 + kk8 + 8 * c) = q8; } }
    asm volatile("s_waitcnt lgkmcnt(0)" ::: "memory");
}
__device__ __forceinline__ void p0_norm_load(const float* xrow, int lane, f32x4 (&v)[16]) {
    const f32x4* xr = (const f32x4*)xrow + lane;
#pragma unroll
    for (int j = 0; j < 16; ++j) v[j] = xr[64 * j];
}
__device__ __forceinline__ void p0_norm_finish(const f32x4 (&v)[16], const float* w, bf16_t* orow, unsigned char* orow8, int lane) {
    const f32x4* wr = (const f32x4*)w + lane; float s = 0.f;
#pragma unroll
    for (int j = 0; j < 16; ++j) s += (v[j][0] * v[j][0] + v[j][1] * v[j][1]) + (v[j][2] * v[j][2] + v[j][3] * v[j][3]);
    const float rstd = 1.f / sqrtf(wave_sum(s) * (1.f / DM) + EPS);
    u32x2* o8 = (u32x2*)orow + lane;
#pragma unroll
    for (int j = 0; j < 16; ++j) { const f32x4 ww = wr[64 * j]; const float h0 = v[j][0] * rstd * ww[0], h1 = v[j][1] * rstd * ww[1], h2 = v[j][2] * rstd * ww[2], h3 = v[j][3] * rstd * ww[3];
        u32x2 o; o.x = pk2(h0, h1); o.y = pk2(h2, h3); o8[64 * j] = o;
        ((unsigned*)orow8)[lane + 64 * j] = pk_fp8x4(h0, h1, h2, h3); }
}
__device__ __forceinline__ void phase0(const Params& P, LAS unsigned char* lds_, int bid, int nblk) {
    LAS unsigned char* lds = opq(lds_);
    const int tid = opaque_tid(), lane = tid & 63, wave = tid >> 6;
    LAS float* scr = (LAS float*)(lds + wave * 8704);
    const int gw = bid * 8 + wave, NGW = nblk * 8;
    constexpr int I_IN = (DM / 64) * (INW / 32), I_SQ = (DM / 64) * (DM / 32), I_PP = (256 / 64) * (DM / 32), I_W1 = (DM / 64) * (256 / 32), I_W2 = (256 / 64) * (128 / 32);
    constexpr int NITEMS = I_IN + I_PP + 2 * I_W1 + 2 * I_W2;
    {
        int it = gw; P0It A, B; float wa[32], wb[32];
        if (it < NITEMS) { A = p0_decode(P, it); p0_load(A, lane, wa); }
        while (it < NITEMS) {
            int itn = it + NGW; const bool hb = itn < NITEMS;
            if (hb) { B = p0_decode(P, itn); p0_load(B, lane, wb); }
            __builtin_amdgcn_sched_barrier(0);
            p0_finish(A, scr, lane, wa);
            if (!hb) break;
            it = itn; itn = it + NGW; const bool ha = itn < NITEMS;
            if (ha) { A = p0_decode(P, itn); p0_load(A, lane, wa); }
            __builtin_amdgcn_sched_barrier(0);
            p0_finish(B, scr, lane, wb);
            if (!ha) break;
            it = itn;
        }
    }
    {
        int m = gw; f32x4 va[16], vb[16];
        if (m < MTOK) p0_norm_load(P.x + (size_t)m * DM, lane, va);
        while (m < MTOK) {
            int mn = m + NGW; const bool hb = mn < MTOK;
            if (hb) p0_norm_load(P.x + (size_t)mn * DM, lane, vb);
            __builtin_amdgcn_sched_barrier(0);
            p0_norm_finish(va, P.norm_w, P.hb() + (size_t)m * DM, P.hb8() + (size_t)m * DM, lane);
            if (!hb) break;
            m = mn; mn = m + NGW; const bool ha = mn < MTOK;
            if (ha) p0_norm_load(P.x + (size_t)mn * DM, lane, va);
            __builtin_amdgcn_sched_barrier(0);
            p0_norm_finish(vb, P.norm_w, P.hb() + (size_t)m * DM, P.hb8() + (size_t)m * DM, lane);
            if (!ha) break;
            m = mn;
        }
    }
    for (size_t i = (size_t)bid * 512 + tid; i < (size_t)MTOK * 256 / 8; i += (size_t)nblk * 512) {
        const f32x4 a = ((const f32x4*)P.p)[2 * i], b = ((const f32x4*)P.p)[2 * i + 1];
        u32x4 o; o.x = pk2(a[0], a[1]); o.y = pk2(a[2], a[3]); o.z = pk2(b[0], b[1]); o.w = pk2(b[2], b[3]); ((u32x4*)P.pb())[i] = o; }
    { u32x4* z = (u32x4*)(P.Wt() + (size_t)(WT_SMALL + 64) * DM); const size_t n = (size_t)(WT_T - WT_SMALL - 64) * DM / 8;
      for (size_t i = (size_t)bid * 512 + tid; i < n; i += (size_t)nblk * 512) z[i] = (u32x4){0u, 0u, 0u, 0u}; }
}

__device__ __forceinline__ void wg_conv_share(const Params& P, LAS unsigned char* lds_, int bid, int nblk, bool wout) {
    LAS unsigned char* lds = opq(lds_);
    const int tid = opaque_tid(), lane = tid & 63, wave = tid >> 6;
    LAS float* scr = (LAS float*)(lds + wave * 8704);
    constexpr int I_SQ = (DM / 64) * (DM / 32);
    const int gw = bid * 8 + wave, NGW = nblk * 8;
    P0It A; A.W = wout ? P.w_out : P.ple_gate; A.K = DM; A.N = DM; A.WT = wout ? P.WoT() : P.WgT(); A.P8 = wout ? P.Wo8() : nullptr; A.pev = nullptr; A.cp = nullptr; A.remap = false; A.item = gw;
    P0It B = A; float wa[32], wb[32];
    int it = gw;
    if (it < I_SQ) p0_load(A, lane, wa);
    while (it < I_SQ) {
        int itn = it + NGW; const bool hb = itn < I_SQ;
        if (hb) { B.item = itn; p0_load(B, lane, wb); }
        __builtin_amdgcn_sched_barrier(0);
        p0_finish(A, scr, lane, wa);
        if (!hb) break;
        it = itn; itn = it + NGW; const bool ha = itn < I_SQ;
        if (ha) { A.item = itn; p0_load(A, lane, wa); }
        __builtin_amdgcn_sched_barrier(0);
        p0_finish(B, scr, lane, wb);
        if (!ha) break;
        it = itn;
    }
    __syncthreads();
}

__device__ __forceinline__ void phase_gemm1(const Params& P, LAS unsigned char* lds, int bid, int nblk) {
    EpiStore E{P.U(), P.small(), P.T(), nullptr, 0};
    { pg8::SchedG1B S; S.hb = (const char*)P.hb(); S.wt = (const char*)P.Wt(); S.G = nblk; S.c = bid;
      pg8::gemm_phase<EpiStore, pg8::SchedG1B, false>(lds, DM, S, E); }
    { pg8::SchedG1F S; S.hb8 = (const char*)P.hb8(); S.w8 = (const char*)P.W8(); S.G = nblk; S.c = bid;
      pg8::gemm_phase<EpiStore, pg8::SchedG1F, true>(lds, DM / 2, S, E); }
}
__device__ __forceinline__ void phase_gemm_pe(const Params& P, LAS unsigned char* lds, int bid, int nblk, int i0, int n) {
    if (n <= 0) return;
    pg8::Sched2 S; S.K = 256; S.G = nblk; S.c = bid; S.i0 = i0; S.n = n;
    S.a0 = (const char*)P.pb(); S.b0 = (const char*)P.WpT(); S.nM0 = MTOK / 256; S.nN0 = DM / 256; S.kind0 = 2;
    S.a1 = nullptr; S.b1 = nullptr; S.nM1 = 0; S.nN1 = 0; S.kind1 = 2;
    EpiStore E{nullptr, nullptr, nullptr, P.pe(), DM};
    pg8::gemm_phase<EpiStore, pg8::Sched2>(lds, 256, S, E);
}
__device__ __forceinline__ void phase_gemm2(const Params& P, LAS unsigned char* lds, int bid, int nblk) {
    pg8::SchedM S; S.a = (const char*)P.y(); S.b = (const char*)P.WoT(); S.a8 = (const char*)P.y8(); S.b8 = (const char*)P.Wo8(); S.nM = MTOK / 256; S.nN = DM / 256; S.G = nblk; S.c = bid;
    EpiRes E{P.x, P.x1b()};
    pg8::gemm_phase_mixed<EpiRes>(lds, S, E);
}
__device__ __forceinline__ void phase_gemm3(const Params& P, LAS unsigned char* lds, int bid, int nblk) {
    pg8::Sched2 S; S.K = DM; S.G = nblk; S.c = bid;
    S.a0 = (const char*)P.x1b(); S.b0 = (const char*)P.WgT(); S.nM0 = MTOK / 256; S.nN0 = DM / 256; S.kind0 = 0;
    S.a1 = nullptr; S.b1 = nullptr; S.nM1 = 0; S.nN1 = 0; S.kind1 = 0;
    EpiGate E{P.out, P.x1b(), P.pe()};
    pg8::gemm_phase<EpiGate, pg8::Sched2>(lds, DM, S, E);
}

#define MFMA16(a, b, c) __builtin_amdgcn_mfma_f32_16x16x32_bf16((a), (b), (c), 0, 0, 0)
__device__ __forceinline__ bf16x8 mk_frag(u32x4 w) { return __builtin_bit_cast(bf16x8, w); }
__device__ __forceinline__ bf16x8 mk_frag2(u32x2 lo, u32x2 hi) { u32x4 w; w.x = lo.x; w.y = lo.y; w.z = hi.x; w.w = hi.y; return __builtin_bit_cast(bf16x8, w); }

struct ConvW { f32x4 w0[4], w1[4]; };
__device__ __forceinline__ void conv_load_w(const Params& P, int chan0, ConvW& cw) {
#pragma unroll
    for (int j = 0; j < 4; ++j) { cw.w0[j] = *(const f32x4*)(P.conv_w + j * 2048 + chan0); cw.w1[j] = *(const f32x4*)(P.conv_w + j * 2048 + chan0 + 4); }
}
__device__ __forceinline__ void conv_load_x(const Params& P, int b, int spos, int ucol0, u32x4 (&raw)[4]) {
#pragma unroll
    for (int j = 0; j < 4; ++j) { const int ts = spos - 3 + j, tc = ts < 0 ? 0 : ts; raw[j] = *(const u32x4*)(P.U() + (size_t)(b * SEQ + tc) * UW + ucol0); }
}
__device__ __forceinline__ void conv_apply(const ConvW& cw, const u32x4 (&raw)[4], int spos, float (&o)[8]) {
#pragma unroll
    for (int e = 0; e < 8; ++e) o[e] = 0.f;
#pragma unroll
    for (int j = 0; j < 4; ++j) {
        const float z = (spos - 3 + j) < 0 ? 0.f : 1.f;
        o[0] += z * cw.w0[j][0] * bflo(raw[j].x); o[1] += z * cw.w0[j][1] * bfhi(raw[j].x); o[2] += z * cw.w0[j][2] * bflo(raw[j].y); o[3] += z * cw.w0[j][3] * bfhi(raw[j].y);
        o[4] += z * cw.w1[j][0] * bflo(raw[j].z); o[5] += z * cw.w1[j][1] * bfhi(raw[j].z); o[6] += z * cw.w1[j][2] * bflo(raw[j].w); o[7] += z * cw.w1[j][3] * bfhi(raw[j].w);
    }
#pragma unroll
    for (int e = 0; e < 8; ++e) o[e] = siluf_(o[e]);
}

__device__ __forceinline__ void ml_step1(const Params& P, LAS unsigned char* lds_, int task) {
    LAS unsigned char* lds = opq(lds_);
    const int tid = opaque_tid(), lane = tid & 63, wave = tid >> 6, q4 = lane >> 4, l15 = lane & 15, half = wave >> 2, hw = wave & 3, ht = tid & 255;
    const int ch = 2 * task + half;
    const int bh = ch >> 6, c = ch & 63, b = bh >> 3, h = bh & 7, tok0 = b * SEQ + c * 64;
    LAS bf16_t* kT = (LAS bf16_t*)(lds + half * 18944);
    LAS float* wk = (LAS float*)(lds + half * 18944 + 18432);
    LAS bf16_t* vts = (LAS bf16_t*)(lds + 37888 + half * 36864);
    u32x4 vst[8];
#pragma unroll
    for (int i = 0; i < 8; ++i) { const int id = ht + 256 * i; vst[i] = *(const u32x4*)(P.T() + (size_t)(TV + h * 256 + (id >> 3)) * MTOK + tok0 + 8 * (id & 7)); }
    if (hw == 0) {
        const float fi = P.small()[(size_t)(tok0 + lane) * 64 + h] + P.i_bias[h];
        const float ff = P.small()[(size_t)(tok0 + lane) * 64 + 8 + h] + P.f_bias[h];
        const float lf = fminf(ff, 0.f) - log1pf(expf(-fabsf(ff)));
        float bc = lf;
#pragma unroll
        for (int o = 1; o < 64; o <<= 1) { const float v = shfl_up_l(bc, o, lane); if (lane >= o) bc += v; }
        const float g = fi - bc; const float gm = wave_max(g);
        const float bL = __builtin_bit_cast(float, __builtin_amdgcn_readlane(__builtin_bit_cast(int, bc), 63));
        wk[lane] = expf(g - gm);
        P.mb()[(size_t)bh * SEQ + c * 64 + lane] = bc; P.mg()[(size_t)bh * SEQ + c * 64 + lane] = g;
        if (lane == 0) { P.cbL()[ch] = bL; P.cgmax()[ch] = gm; }
    }
    float kv[4][8];
    { ConvW cw; conv_load_w(P, 1024 + h * 128 + (ht & 15) * 8, cw);
      u32x4 raw[4][4];
#pragma unroll
      for (int i = 0; i < 4; ++i) { const int id = ht + 256 * i, s = id >> 4, d8 = id & 15; conv_load_x(P, b, c * 64 + s, UK + h * 128 + d8 * 8, raw[i]); }
#pragma unroll
      for (int i = 0; i < 4; ++i) { const int id = ht + 256 * i, s = id >> 4; conv_apply(cw, raw[i], c * 64 + s, kv[i]); } }
#pragma unroll
    for (int i = 0; i < 8; ++i) { const int id = ht + 256 * i; *(LAS u32x4*)(vts + (id >> 3) * 72 + 8 * (id & 7)) = vst[i]; }
    __syncthreads();
#pragma unroll
    for (int i = 0; i < 4; ++i) {
        const int id = ht + 256 * i, s = id >> 4, d8 = id & 15;
        const float sc = wk[s] * 0.08838834764831845f;
#pragma unroll
        for (int e = 0; e < 8; ++e) kT[(d8 * 8 + e) * 72 + s] = (bf16_t)f2bf(kv[i][e] * sc);
    }
    __syncthreads();
    if (ht < 128) { float s = 0.f; for (int j = 0; j < 64; ++j) s += bf2f(kT[ht * 72 + j]); P.dn()[(size_t)ch * 128 + ht] = s; }
    bf16x8 af[2][2];
#pragma unroll
    for (int dt = 0; dt < 2; ++dt)
#pragma unroll
        for (int ks = 0; ks < 2; ++ks) af[dt][ks] = *(const LAS bf16x8*)(kT + (32 * hw + 8 * (l15 >> 2) + 4 * dt + (l15 & 3)) * 72 + 32 * ks + 8 * q4);
    const LAS bf16_t* vp = vts + l15 * 72 + 8 * q4;
    bf16_t* op = P.dCt() + ((size_t)ch * 256 + l15) * 128 + 32 * hw + 8 * q4;
#pragma unroll 8
    for (int vt = 0; vt < 16; ++vt) {
        bf16x8 bfr[2];
#pragma unroll
        for (int ks = 0; ks < 2; ++ks) bfr[ks] = *(const LAS bf16x8*)(vp + (16 * vt) * 72 + 32 * ks);
        f32x4 acc0 = {0.f, 0.f, 0.f, 0.f}, acc1 = {0.f, 0.f, 0.f, 0.f};
#pragma unroll
        for (int ks = 0; ks < 2; ++ks) { acc0 = MFMA16(af[0][ks], bfr[ks], acc0); acc1 = MFMA16(af[1][ks], bfr[ks], acc1); }
        u32x4 w; w.x = pk2(acc0[0], acc0[1]); w.y = pk2(acc0[2], acc0[3]); w.z = pk2(acc1[0], acc1[1]); w.w = pk2(acc1[2], acc1[3]);
        *(u32x4*)(op + (size_t)(16 * vt) * 128) = w;
    }
    __syncthreads();
}

__device__ __forceinline__ void ml_step2(const Params& P, int bh, int part) {
    const int tid = opaque_tid(), lane = tid & 63; const size_t e4 = ((size_t)part * 512 + tid) * 4;
    const float bLl = P.cbL()[bh * 64 + lane], gml = P.cgmax()[bh * 64 + lane];
    float decl = 0.f, scl = 0.f, ml = 0.f;
    {
        float m = 0.f;
#pragma unroll
        for (int c = 0; c < 64; ++c) {
            const float bL = __builtin_bit_cast(float, __builtin_amdgcn_readlane(__builtin_bit_cast(int, bLl), c)), gm = __builtin_bit_cast(float, __builtin_amdgcn_readlane(__builtin_bit_cast(int, gml), c));
            const float mn = fmaxf(bL + m, bL + gm), dec = __expf(bL + m - mn), sc = __expf(bL + gm - mn);
            if (lane == c) { decl = dec; scl = sc; ml = m; }
            m = mn;
        }
    }
    if (part == 0 && tid < 64) P.cm()[bh * 64 + tid] = ml;
    const bool do_n = (part == 0 && tid < 128);
    f32x4 C = {0.f, 0.f, 0.f, 0.f}; float nn = 0.f;
    const bf16_t* __restrict__ dsrc = P.dCt() + (size_t)bh * 64 * 32768 + e4;
    bf16_t* __restrict__ cdst = P.Ct() + (size_t)bh * 64 * 32768 + e4;
    for (int c0 = 0; c0 < 64; c0 += 32) {
        u32x2 d[32]; float dnv[32];
#pragma unroll
        for (int i = 0; i < 32; ++i) { d[i] = *(const u32x2*)(dsrc + (size_t)(c0 + i) * 32768); dnv[i] = do_n ? P.dn()[(size_t)(bh * 64 + c0 + i) * 128 + tid] : 0.f; }
#pragma unroll
        for (int i = 0; i < 32; ++i) {
            const int c = c0 + i;
            { u32x2 w; w.x = pk2(C[0], C[1]); w.y = pk2(C[2], C[3]); *(u32x2*)(cdst + (size_t)c * 32768) = w; }
            if (do_n) P.nst()[(size_t)(bh * 64 + c) * 128 + tid] = nn;
            const float decc = __builtin_bit_cast(float, __builtin_amdgcn_readlane(__builtin_bit_cast(int, decl), c)), scc = __builtin_bit_cast(float, __builtin_amdgcn_readlane(__builtin_bit_cast(int, scl), c));
            C[0] = decc * C[0] + scc * bflo(d[i].x); C[1] = decc * C[1] + scc * bfhi(d[i].x); C[2] = decc * C[2] + scc * bflo(d[i].y); C[3] = decc * C[3] + scc * bfhi(d[i].y);
            nn = decc * nn + scc * dnv[i];
        }
    }
}

__device__ __forceinline__ void ml_step3(const Params& P, LAS unsigned char* lds_, int task) {
    LAS unsigned char* lds = opq(lds_);
    const int tid = opaque_tid(), lane = tid & 63, wave = tid >> 6, q4 = lane >> 4, l15 = lane & 15, half = wave >> 2, tq = wave & 3, ht = tid & 255;
    const int ch = 2 * task + half;
    const int bh = ch >> 6, c = ch & 63, b = bh >> 3, h = bh & 7, tok0 = b * SEQ + c * 64;
    LAS unsigned char* hl = lds + half * 36864;
    LAS bf16_t* qs = (LAS bf16_t*)hl;
    LAS bf16_t* ks_ = (LAS bf16_t*)(hl + 17408);
    LAS float* fb = (LAS float*)(hl + 34816);
    LAS float* fg = fb + 64;
    LAS float* fpm = fb + 128;
    u32x4 cst[4], vst[2];
#define ML3_LOAD(B) do { \
        _Pragma("unroll") for (int i = 0; i < 4; ++i) { const int id = ht + 256 * i; cst[i] = *(const u32x4*)(P.Ct() + ((size_t)ch * 256 + 64 * (B) + (id >> 4)) * 128 + 8 * (id & 15)); } \
        _Pragma("unroll") for (int i = 0; i < 2; ++i) { const int id = ht + 256 * i; vst[i] = *(const u32x4*)(P.T() + (size_t)(TV + h * 256 + 64 * (B) + (id >> 3)) * MTOK + tok0 + 8 * (id & 7)); } } while (0)
#define ML3_SB(BUF) ((BUF) ? hl : lds + 73728 + half * 28672)
#define ML3_WRITE(BUF) do { LAS bf16_t* cts_ = (LAS bf16_t*)ML3_SB(BUF); LAS bf16_t* vts_ = (LAS bf16_t*)(ML3_SB(BUF) + 17408); \
        _Pragma("unroll") for (int i = 0; i < 4; ++i) { const int id = ht + 256 * i; *(LAS u32x4*)(cts_ + (id >> 4) * 136 + 8 * (id & 15)) = cst[i]; } \
        _Pragma("unroll") for (int i = 0; i < 2; ++i) { const int id = ht + 256 * i; *(LAS u32x4*)(vts_ + (id >> 3) * 72 + 8 * (id & 7)) = vst[i]; } } while (0)
    ML3_LOAD(0);
#pragma unroll
    for (int isk = 0; isk < 2; ++isk) {
        ConvW cw; conv_load_w(P, isk * 1024 + h * 128 + (ht & 15) * 8, cw);
        u32x4 raw[4][4];
#pragma unroll
        for (int i = 0; i < 4; ++i) { const int id = ht + 256 * i, s = id >> 4, d8 = id & 15; conv_load_x(P, b, c * 64 + s, (isk ? UK : UQ) + h * 128 + d8 * 8, raw[i]); }
#pragma unroll
        for (int i = 0; i < 4; ++i) { const int id = ht + 256 * i, s = id >> 4, d8 = id & 15;
            float o[8]; conv_apply(cw, raw[i], c * 64 + s, o);
            const float sc = isk ? 0.08838834764831845f : 1.f;
            u32x4 w; w.x = pk2(o[0] * sc, o[1] * sc); w.y = pk2(o[2] * sc, o[3] * sc); w.z = pk2(o[4] * sc, o[5] * sc); w.w = pk2(o[6] * sc, o[7] * sc);
            *(LAS u32x4*)((isk ? ks_ : qs) + s * 136 + d8 * 8) = w; }
    }
    if (tq == 0) {
        const float bc = P.mb()[(size_t)bh * SEQ + c * 64 + lane], g = P.mg()[(size_t)bh * SEQ + c * 64 + lane];
        float pm = g;
#pragma unroll
        for (int o = 1; o < 64; o <<= 1) { const float v = shfl_up_l(pm, o, lane); if (lane >= o) pm = fmaxf(pm, v); }
        fb[lane] = bc; fg[lane] = g; fpm[lane] = pm;
    }
    const float m_c = P.cm()[ch];
    const int t = 16 * tq + l15;
    const size_t tok = (size_t)(tok0 + t);
    __syncthreads();
    bf16x8 qf[4];
#pragma unroll
    for (int ks = 0; ks < 4; ++ks) qf[ks] = *(const LAS bf16x8*)(qs + t * 136 + 32 * ks + 8 * q4);
    const float Mt = fmaxf(m_c, fpm[t]);
    float sc[4][4]; float rowsum = 0.f;
#pragma unroll
    for (int st = 0; st < 4; ++st) {
        f32x4 a = {0.f, 0.f, 0.f, 0.f};
#pragma unroll
        for (int ks = 0; ks < 4; ++ks) { const bf16x8 kf = *(const LAS bf16x8*)(ks_ + (16 * st + l15) * 136 + 32 * ks + 8 * q4); a = MFMA16(kf, qf[ks], a); }
#pragma unroll
        for (int r = 0; r < 4; ++r) { const int s = 16 * st + 4 * q4 + r; const float v = (s <= t) ? a[r] * __expf(fg[s] - Mt) : 0.f; sc[st][r] = v; rowsum += v; }
    }
    rowsum = xq_sum(rowsum);
    bf16x8 pf[2];
#pragma unroll
    for (int k2 = 0; k2 < 2; ++k2) { u32x4 w; w.x = pk2(sc[2 * k2][0], sc[2 * k2][1]); w.y = pk2(sc[2 * k2][2], sc[2 * k2][3]); w.z = pk2(sc[2 * k2 + 1][0], sc[2 * k2 + 1][1]); w.w = pk2(sc[2 * k2 + 1][2], sc[2 * k2 + 1][3]); pf[k2] = mk_frag(w); }
    float qn = 0.f;
    { const float* np = P.nst() + (size_t)ch * 128;
#pragma unroll
      for (int ks = 0; ks < 4; ++ks) { const f32x4 n0 = *(const f32x4*)(np + 32 * ks + 8 * q4), n1 = *(const f32x4*)(np + 32 * ks + 8 * q4 + 4);
          const u32x4 qw = __builtin_bit_cast(u32x4, qf[ks]);
          qn += bflo(qw.x) * n0[0] + bfhi(qw.x) * n0[1] + bflo(qw.y) * n0[2] + bfhi(qw.y) * n0[3] + bflo(qw.z) * n1[0] + bfhi(qw.z) * n1[1] + bflo(qw.w) * n1[2] + bfhi(qw.w) * n1[3]; }
      qn = xq_sum(qn); }
    const float inter = __expf(m_c - Mt);
    const float den = inter * qn + rowsum;
    const float inv = 1.f / fmaxf(fabsf(den), __expf(-(fb[t] + Mt)));
    f32x4 hv[16]; float ss = 0.f;
    __syncthreads();
#pragma unroll
    for (int vb = 0; vb < 4; ++vb) {
        ML3_WRITE(vb & 1);
        if (vb < 3) ML3_LOAD(vb + 1);
        __syncthreads();
        const LAS bf16_t* cts = (const LAS bf16_t*)ML3_SB(vb & 1) + l15 * 136 + 8 * q4;
        const LAS bf16_t* vts = (const LAS bf16_t*)(ML3_SB(vb & 1) + 17408) + l15 * 72 + 4 * q4;
#pragma unroll
        for (int v = 0; v < 4; ++v) { const int vt = 4 * vb + v;
            f32x4 a1 = {0.f, 0.f, 0.f, 0.f}, a2 = {0.f, 0.f, 0.f, 0.f};
#pragma unroll
            for (int ks = 0; ks < 4; ++ks) a1 = MFMA16(*(const LAS bf16x8*)(cts + (16 * v) * 136 + 32 * ks), qf[ks], a1);
#pragma unroll
            for (int k2 = 0; k2 < 2; ++k2) { const LAS bf16_t* vp = vts + (16 * v) * 72 + 32 * k2; a2 = MFMA16(mk_frag2(*(const LAS u32x2*)vp, *(const LAS u32x2*)(vp + 16)), pf[k2], a2); }
#pragma unroll
            for (int r = 0; r < 4; ++r) { const float hh = (inter * a1[r] + a2[r]) * inv; hv[vt][r] = hh; ss += hh * hh; } }
    }
#undef ML3_LOAD
#undef ML3_SB
#undef ML3_WRITE
    ss = xq_sum(ss);
    const float rstd = __builtin_amdgcn_rsqf(ss * (1.f / 256.f) + EPS);
    {
        u32x2 owv[16], zwv[16]; f32x4 nwv[16];
#pragma unroll
        for (int vt = 0; vt < 16; ++vt) { const int v = 16 * vt + 4 * q4;
            owv[vt] = *(const u32x2*)(P.U() + tok * UW + UO + h * 256 + v); zwv[vt] = *(const u32x2*)(P.U() + tok * UW + UZ + h * 256 + v); nwv[vt] = *(const f32x4*)(P.hnorm_w + h * 256 + v); }
        __builtin_amdgcn_sched_barrier(0);
#pragma unroll
        for (int vt = 0; vt < 16; ++vt) {
            const int v = 16 * vt + 4 * q4;
            const u32x2 ow = owv[vt], zw = zwv[vt]; const f32x4 nw = nwv[vt];
            const float o0 = bflo(ow.x), o1 = bfhi(ow.x), o2 = bflo(ow.y), o3 = bfhi(ow.y), z0 = bflo(zw.x), z1 = bfhi(zw.x), z2 = bflo(zw.y), z3 = bfhi(zw.y);
            const float y0 = hv[vt][0] * rstd * nw[0] * sigmoidf_(o0) * siluf_(z0), y1 = hv[vt][1] * rstd * nw[1] * sigmoidf_(o1) * siluf_(z1);
            const float y2 = hv[vt][2] * rstd * nw[2] * sigmoidf_(o2) * siluf_(z2), y3 = hv[vt][3] * rstd * nw[3] * sigmoidf_(o3) * siluf_(z3);
            u32x2 w; w.x = pk2(y0, y1); w.y = pk2(y2, y3);
            *(u32x2*)(P.y() + tok * DM + h * 256 + v) = w;
        }
    }
    __syncthreads();
}

constexpr float LOG2E = 1.4426950408889634f;
__device__ __forceinline__ void cmp_gemm_task(const Params& P, LAS unsigned char* lds, int unit) {
    pg8::SchedC S; S.U = (const char*)P.U(); S.w1k = (const char*)P.w1kT(); S.w1v = (const char*)P.w1vT(); S.ukc = UKC; S.uvc = UVC; S.unit = unit;
    EpiZ E{P.Z()};
    pg8::gemm_cmp<EpiZ>(lds, S, E);
    __syncthreads();
}
__device__ __forceinline__ void cmp_task(const Params& P, LAS unsigned char* lds_, int task) {
    LAS unsigned char* lds = opq(lds_);
    const int tid = opaque_tid(), lane = tid & 63, wave = tid >> 6, q4 = lane >> 4, l15 = lane & 15;
    const int kv = task & 1, bg = (task >> 1) & 7, it = task >> 4;
    LAS float* cs = (LAS float*)lds;
    LAS bf16_t* H1 = (LAS bf16_t*)(lds + 16384);
    LAS float* O2 = (LAS float*)(lds + 33280);
    const bf16_t* w2T = kv ? P.w2vT() : P.w2kT();
    if (tid < 256) { const float* cp = P.cpart() + (size_t)kv * 64 * 256 + tid; float pv[64];
#pragma unroll
        for (int kb = 0; kb < 64; ++kb) pv[kb] = cp[kb * 256];
        __builtin_amdgcn_sched_barrier(0);
        float s = 0.f;
#pragma unroll
        for (int kb = 0; kb < 64; ++kb) s += pv[kb];
        cs[tid] = s; }
    __syncthreads();
    { const int m = tid >> 4, n0 = (tid & 15) * 16, i = 32 * it + m, i1 = i + 1 > 255 ? 255 : i + 1;
      const float* z0 = P.Z() + ((size_t)(kv * 8 + bg) * 256 + i) * 512 + n0; const float* z1 = P.Z() + ((size_t)(kv * 8 + bg) * 256 + i1) * 512 + 256 + n0;
#pragma unroll
      for (int j = 0; j < 4; ++j) { const f32x4 a = *(const f32x4*)(z0 + 4 * j), b = *(const f32x4*)(z1 + 4 * j), c = *(const LAS f32x4*)(cs + n0 + 4 * j);
          u32x2 w; w.x = pk2(siluf_(a[0] + b[0] + c[0]), siluf_(a[1] + b[1] + c[1])); w.y = pk2(siluf_(a[2] + b[2] + c[2]), siluf_(a[3] + b[3] + c[3]));
          *(LAS u32x2*)(H1 + m * 264 + n0 + 4 * j) = w; } }
    __syncthreads();
    {
        f32x4 a2[2] = {(f32x4){0.f, 0.f, 0.f, 0.f}, (f32x4){0.f, 0.f, 0.f, 0.f}};
#pragma unroll
        for (int ks = 0; ks < 8; ++ks) {
            const bf16x8 af = mk_frag(*(const u32x4*)(w2T + (size_t)(16 * wave + l15) * 256 + 32 * ks + 8 * q4));
#pragma unroll
            for (int mt = 0; mt < 2; ++mt) { const bf16x8 bf = *(const LAS bf16x8*)(H1 + (16 * mt + l15) * 264 + 32 * ks + 8 * q4); a2[mt] = MFMA16(af, bf, a2[mt]); }
        }
#pragma unroll
        for (int mt = 0; mt < 2; ++mt) *(LAS f32x4*)(O2 + (16 * mt + l15) * 132 + 16 * wave + 4 * q4) = a2[mt];
    }
    __syncthreads();
    if (kv == 0) {
        const int m = 4 * wave + q4, i = 32 * it + m;
        const LAS float* op = O2 + m * 132 + 8 * l15; float v[8]; float ss = 0.f;
#pragma unroll
        for (int e = 0; e < 8; ++e) { v[e] = op[e]; ss += v[e] * v[e]; }
        ss = row16_sum(ss);
        const float rstd = (i == 255) ? 0.f : __builtin_amdgcn_rsqf(ss * (1.f / 128.f) + EPS);
        const f32x4 w0 = *(const f32x4*)(P.knorm_w + 8 * l15), w1 = *(const f32x4*)(P.knorm_w + 8 * l15 + 4);
        u32x4 w; w.x = pk2(v[0] * rstd * w0[0], v[1] * rstd * w0[1]); w.y = pk2(v[2] * rstd * w0[2], v[3] * rstd * w0[3]);
        w.z = pk2(v[4] * rstd * w1[0], v[5] * rstd * w1[1]); w.w = pk2(v[6] * rstd * w1[2], v[7] * rstd * w1[3]);
        *(u32x4*)(P.kcmp() + ((size_t)bg * 256 + i) * 128 + 8 * l15) = w;
    } else {
        const int d = tid >> 2, ms = (tid & 3) * 8; float v[8];
#pragma unroll
        for (int e = 0; e < 8; ++e) v[e] = (32 * it + ms + e == 255) ? 0.f : O2[(ms + e) * 132 + d];
        u32x4 w; w.x = pk2(v[0], v[1]); w.y = pk2(v[2], v[3]); w.z = pk2(v[4], v[5]); w.w = pk2(v[6], v[7]);
        *(u32x4*)(P.vcmpT() + ((size_t)bg * 128 + d) * 256 + 32 * it + ms) = w;
    }
    __syncthreads();
}

__device__ __forceinline__ void ksnorm_task(const Params& P, int task) {
    const int tid = opaque_tid(), l16 = tid & 15, r0 = tid >> 4;
    const f32x4 w0 = *(const f32x4*)(P.knorm_w + 128 + 8 * l16), w1 = *(const f32x4*)(P.knorm_w + 128 + 8 * l16 + 4);
    u32x4 rawv[16];
#pragma unroll
    for (int p = 0; p < 16; ++p) { const int row = 32 * p + r0, tok = 128 * task + (row >> 2), g = row & 3; rawv[p] = *(const u32x4*)(P.U() + (size_t)tok * UW + UKS + g * 128 + 8 * l16); }
    __builtin_amdgcn_sched_barrier(0);
#pragma unroll
    for (int p = 0; p < 16; ++p) {
        const int row = 32 * p + r0, tok = 128 * task + (row >> 2), g = row & 3;
        bf16_t* ptr = P.U() + (size_t)tok * UW + UKS + g * 128 + 8 * l16;
        const u32x4 raw = rawv[p];
        float v[8] = {bflo(raw.x), bfhi(raw.x), bflo(raw.y), bfhi(raw.y), bflo(raw.z), bfhi(raw.z), bflo(raw.w), bfhi(raw.w)};
        float ss = 0.f;
#pragma unroll
        for (int e = 0; e < 8; ++e) ss += v[e] * v[e];
        ss = row16_sum(ss);
        const float rstd = __builtin_amdgcn_rsqf(ss * (1.f / 128.f) + EPS);
        u32x4 o; o.x = pk2(v[0] * rstd * w0[0], v[1] * rstd * w0[1]); o.y = pk2(v[2] * rstd * w0[2], v[3] * rstd * w0[3]);
        o.z = pk2(v[4] * rstd * w1[0], v[5] * rstd * w1[1]); o.w = pk2(v[6] * rstd * w1[2], v[7] * rstd * w1[3]);
        *(u32x4*)ptr = o;
    }
}

__device__ __forceinline__ int rel_bucket(int n) {
    if (n < 16) return n;
    int v = 16 + (int)(logf((float)n * (1.f / 16.f)) / 2.0794415416798357f * 16.f);
    return v > 31 ? 31 : v;
}

__device__ __forceinline__ unsigned cvtpk(float lo, float hi) { return pk2(lo, hi); }
template <int MODE>
__device__ __forceinline__ void attn_task(const Params& P, LAS unsigned char* lds_, int bg, int qb) {
    LAS unsigned char* lds = opq(lds_);
    const int tid = opaque_tid(), lane = tid & 63, wave = __builtin_amdgcn_readfirstlane(tid >> 6), q4 = lane >> 4, l15 = lane & 15;
    const int b = bg >> 2, g = bg & 3, hd = wave >> 1, qhalf = wave & 1, head = g * 4 + hd;
    LAS float* tab = (LAS float*)(lds + 35840);
    LAS float* imps = (LAS float*)(lds + 38912);
    LAS unsigned* um = (LAS unsigned*)(lds + 104448);
    bf16x8 qf[2][4];
    u32x4 qraw[2][4];
#pragma unroll
    for (int qt = 0; qt < 2; ++qt) { const size_t tok = (size_t)b * SEQ + 64 * qb + 32 * qhalf + 16 * qt + l15;
#pragma unroll
        for (int ks = 0; ks < 4; ++ks) qraw[qt][ks] = *(const u32x4*)(P.U() + tok * UW + UNQ + head * 128 + 32 * ks + 8 * q4); }
    __builtin_amdgcn_sched_barrier(0);
    unsigned long long rem;
    if (MODE == 0) { const int jl = qb - 8 < 0 ? 0 : qb - 8; rem = ((2ull << qb) - 1ull) & ~((1ull << jl) - 1ull); }
    else if (MODE == 1) { rem = (2ull << ((4 * qb + 2) >> 6)) - 1ull; }
    else { rem = P.selu()[bg * 64 + qb] & ((2ull << qb) - 1ull); }
    const int krow = tid >> 4, kc16 = tid & 15, vrow = tid >> 3, vc8 = tid & 7;
    const bf16_t* kbase = (MODE == 1) ? P.kcmp() + ((size_t)bg * 256 + krow) * 128 + 8 * kc16 : P.U() + ((size_t)b * SEQ + krow) * UW + (MODE == 0 ? UKW : UKS) + g * 128 + 8 * kc16;
    const size_t kstride = (MODE == 1) ? (size_t)32 * 128 : (size_t)32 * UW;
    const bf16_t* vbase = (MODE == 1) ? P.vcmpT() + ((size_t)bg * 128 + vrow) * 256 + 8 * vc8 : P.T() + (size_t)((MODE == 0 ? TVW : TVS) + g * 128 + vrow) * MTOK + (size_t)b * SEQ + 8 * vc8;
    const size_t vstride = (MODE == 1) ? (size_t)64 * 256 : (size_t)64 * MTOK;
    const size_t ktile = (MODE == 1) ? (size_t)64 * 128 : (size_t)64 * UW;
    f32x4 kw0 = {1.f, 1.f, 1.f, 1.f}, kw1 = {1.f, 1.f, 1.f, 1.f};
    if (MODE == 0) { const float* kw = P.knorm_w + 256 + 8 * kc16; kw0 = *(const f32x4*)kw; kw1 = *(const f32x4*)(kw + 4); }
    u32x4 kr[2], vr[2];
#define AT_LOAD(J) do { _Pragma("unroll") for (int _i = 0; _i < 2; ++_i) { kr[_i] = *(const u32x4*)(kbase + (size_t)(J) * ktile + _i * kstride); vr[_i] = *(const u32x4*)(vbase + (size_t)(J) * 64 + _i * vstride); } } while (0)
    int j = __builtin_ctzll(rem); rem &= rem - 1ull;
    AT_LOAD(j);
    __builtin_amdgcn_sched_barrier(0);
    for (int i = tid; i < 4 * 129; i += 512) { const int hh = i / 129, dd = i % 129; tab[hh * 132 + dd] = P.rel_bias[rel_bucket(dd) * 16 + g * 4 + hh] * LOG2E; }
    __builtin_amdgcn_sched_barrier(0);
#pragma unroll
    for (int qt = 0; qt < 2; ++qt) {
        float ss = 0.f;
#pragma unroll
        for (int ks = 0; ks < 4; ++ks) { const u32x4 rw = qraw[qt][ks];
            const float a0 = bflo(rw.x), a1 = bfhi(rw.x), a2 = bflo(rw.y), a3 = bfhi(rw.y), a4 = bflo(rw.z), a5 = bfhi(rw.z), a6 = bflo(rw.w), a7 = bfhi(rw.w);
            ss += a0 * a0 + a1 * a1 + a2 * a2 + a3 * a3 + a4 * a4 + a5 * a5 + a6 * a6 + a7 * a7; }
        ss = xq_sum(ss);
        const float sc = __builtin_amdgcn_rsqf(ss * (1.f / 128.f) + EPS) * (0.08838834764831845f * LOG2E);
#pragma unroll
        for (int ks = 0; ks < 4; ++ks) { const u32x4 rw = qraw[qt][ks]; const f32x4 w0 = *(const f32x4*)(P.qnorm_w + 32 * ks + 8 * q4), w1 = *(const f32x4*)(P.qnorm_w + 32 * ks + 8 * q4 + 4);
            u32x4 w; w.x = cvtpk(bflo(rw.x) * sc * w0[0], bfhi(rw.x) * sc * w0[1]); w.y = cvtpk(bflo(rw.y) * sc * w0[2], bfhi(rw.y) * sc * w0[3]);
            w.z = cvtpk(bflo(rw.z) * sc * w1[0], bfhi(rw.z) * sc * w1[1]); w.w = cvtpk(bflo(rw.w) * sc * w1[2], bfhi(rw.w) * sc * w1[3]);
            qf[qt][ks] = mk_frag(w); }
    }
    LAS bf16x8* qst = (LAS bf16x8*)(lds + 38912) + wave * 512 + lane;
    if (MODE == 1) {
#pragma unroll
        for (int qt = 0; qt < 2; ++qt)
#pragma unroll
            for (int ks = 0; ks < 4; ++ks) qst[(qt * 4 + ks) * 64] = qf[qt][ks];
    }
    unsigned long long smask[2] = {0ull, 0ull};
    if (MODE == 2) {
#pragma unroll
        for (int qt = 0; qt < 2; ++qt) smask[qt] = P.sel()[(size_t)bg * SEQ + 64 * qb + 32 * qhalf + 16 * qt + l15];
    }
    f32x4 ao[8][2]; f32x4 ai[4][2];
#pragma unroll
    for (int dt = 0; dt < 8; ++dt) { ao[dt][0] = (f32x4){0.f, 0.f, 0.f, 0.f}; ao[dt][1] = (f32x4){0.f, 0.f, 0.f, 0.f}; }
#pragma unroll
    for (int nt = 0; nt < 4; ++nt) { ai[nt][0] = (f32x4){0.f, 0.f, 0.f, 0.f}; ai[nt][1] = (f32x4){0.f, 0.f, 0.f, 0.f}; }
    float mrun[2] = {-1e30f, -1e30f}, lsum[2] = {0.f, 0.f};
    int buf = 0;
    for (;;) {
        LAS bf16_t* Ks = (LAS bf16_t*)(lds + buf * ((MODE == 1) ? 104512 : 38912));
        LAS bf16_t* Vs = Ks + 17408 / 2;
#pragma unroll
        for (int i = 0; i < 2; ++i) {
            u32x4 raw = kr[i];
            if (MODE == 0) {
                float v[8] = {bflo(raw.x), bfhi(raw.x), bflo(raw.y), bfhi(raw.y), bflo(raw.z), bfhi(raw.z), bflo(raw.w), bfhi(raw.w)};
                float ss = 0.f;
#pragma unroll
                for (int e = 0; e < 8; ++e) ss += v[e] * v[e];
                ss = row16_sum(ss);
                const float rstd = __builtin_amdgcn_rsqf(ss * (1.f / 128.f) + EPS);
                raw.x = cvtpk(v[0] * rstd * kw0[0], v[1] * rstd * kw0[1]); raw.y = cvtpk(v[2] * rstd * kw0[2], v[3] * rstd * kw0[3]);
                raw.z = cvtpk(v[4] * rstd * kw1[0], v[5] * rstd * kw1[1]); raw.w = cvtpk(v[6] * rstd * kw1[2], v[7] * rstd * kw1[3]);
            }
            *(LAS u32x4*)(Ks + (krow + 32 * i) * 136 + 8 * kc16) = raw;
            *(LAS u32x4*)(Vs + (vrow + 64 * i) * 72 + 8 * vc8) = vr[i];
        }
        __syncthreads();
        const bool more = rem != 0ull; int jn = j;
        if (more) { jn = __builtin_ctzll(rem); rem &= rem - 1ull; AT_LOAD(jn); }
        f32x4 s[4][2];
        {
            const LAS bf16_t* kp = Ks + l15 * 136 + 8 * q4;
            bf16x8 ka[4], kb[4]; bf16x8 qq[2][4];
#pragma unroll
            for (int qt = 0; qt < 2; ++qt)
#pragma unroll
                for (int ks = 0; ks < 4; ++ks) qq[qt][ks] = (MODE == 1) ? qst[(qt * 4 + ks) * 64] : qf[qt][ks];
#define AT_LDK(dst, kt) do { _Pragma("unroll") for (int ks = 0; ks < 4; ++ks) dst[ks] = *(const LAS bf16x8*)(kp + (16 * (kt)) * 136 + 32 * ks); } while (0)
#define AT_MMS(src, kt) do { s[kt][0] = (f32x4){0.f, 0.f, 0.f, 0.f}; s[kt][1] = (f32x4){0.f, 0.f, 0.f, 0.f}; \
            _Pragma("unroll") for (int ks = 0; ks < 4; ++ks) { s[kt][0] = MFMA16(src[ks], qq[0][ks], s[kt][0]); s[kt][1] = MFMA16(src[ks], qq[1][ks], s[kt][1]); } } while (0)
            AT_LDK(ka, 0); AT_LDK(kb, 1); __builtin_amdgcn_sched_barrier(0);
            AT_MMS(ka, 0); __builtin_amdgcn_sched_barrier(0);
            AT_LDK(ka, 2); __builtin_amdgcn_sched_barrier(0);
            AT_MMS(kb, 1); __builtin_amdgcn_sched_barrier(0);
            AT_LDK(kb, 3); __builtin_amdgcn_sched_barrier(0);
            AT_MMS(ka, 2); __builtin_amdgcn_sched_barrier(0);
            AT_MMS(kb, 3); __builtin_amdgcn_sched_barrier(0);
#undef AT_LDK
#undef AT_MMS
        }
        const bool plain = (MODE == 0) ? (qb - j >= 3 && qb - j <= 7) : (MODE == 2 ? (qb - j >= 3) : (64 * qb - 1024 * j - 1039 >= 128));
        const float cbias = tab[hd * 132 + 128];
        bf16x8 pf[2][2];
#pragma unroll
        for (int qt = 0; qt < 2; ++qt) {
            const int tl = 32 * qhalf + 16 * qt + l15;
            const bool selok = (MODE == 2) ? (((smask[qt] >> j) & 1ull) != 0ull) : true;
            float mx = -INFINITY;
            if (plain) {
                const float cb = selok ? cbias : -INFINITY;
#pragma unroll
                for (int kt = 0; kt < 4; ++kt)
#pragma unroll
                    for (int r = 0; r < 4; ++r) { const float v = s[kt][qt][r] + cb; s[kt][qt][r] = v; mx = fmaxf(mx, v); }
            } else if (MODE == 0) {
#pragma unroll
                for (int kt = 0; kt < 4; ++kt) {
                    float tb[4];
#pragma unroll
                    for (int r = 0; r < 4; ++r) {
                        const int dist = 64 * (qb - j) + tl - (16 * kt + 4 * q4 + r);
                        const int di = dist < 0 ? 0 : (dist > 128 ? 128 : dist);
                        tb[r] = tab[hd * 132 + di];
                    }
                    asm volatile("" : "+v"(tb[0]), "+v"(tb[1]), "+v"(tb[2]), "+v"(tb[3]));
#pragma unroll
                    for (int r = 0; r < 4; ++r) {
                        const int dist = 64 * (qb - j) + tl - (16 * kt + 4 * q4 + r);
                        const bool ok = dist >= 0 && dist < 512;
                        const float v = ok ? s[kt][qt][r] + tb[r] : -INFINITY;
                        s[kt][qt][r] = v; mx = fmaxf(mx, v);
                    }
                }
            } else {
#pragma unroll
                for (int kt = 0; kt < 4; ++kt)
#pragma unroll
                    for (int r = 0; r < 4; ++r) {
                        const int kl = 16 * kt + 4 * q4 + r;
                        int dist; bool ok;
                        if (MODE == 1) { dist = 64 * qb + tl - (16 * (64 * j + kl) + 31); ok = dist >= 0; }
                        else { dist = 64 * (qb - j) + tl - kl; ok = dist >= 0 && selok; if (MODE == 0) ok = ok && dist < 512; }
                        const int di = dist < 0 ? 0 : (dist > 128 ? 128 : dist);
                        const float tbv = ((const volatile LAS float*)tab)[hd * 132 + di];
                        const float v = ok ? s[kt][qt][r] + tbv : -INFINITY;
                        s[kt][qt][r] = v; mx = fmaxf(mx, v);
                    }
            }
            mx = xq_max(mx);
            const float mn = fmaxf(mrun[qt], mx), alpha = __builtin_amdgcn_exp2f(mrun[qt] - mn); mrun[qt] = mn;
            float ps = 0.f;
#pragma unroll
            for (int kt = 0; kt < 4; ++kt)
#pragma unroll
                for (int r = 0; r < 4; ++r) { const float p = __builtin_amdgcn_exp2f(s[kt][qt][r] - mn); s[kt][qt][r] = p; ps += p; }
            lsum[qt] = lsum[qt] * alpha + ps;
            if (__ballot(alpha != 1.f) != 0ull) {
#pragma unroll
                for (int dt = 0; dt < 8; ++dt) ao[dt][qt] = ao[dt][qt] * alpha;
                if (MODE == 1) {
#pragma unroll
                    for (int nt = 0; nt < 4; ++nt) ai[nt][qt] = ai[nt][qt] * alpha;
                }
            }
#pragma unroll
            for (int k2 = 0; k2 < 2; ++k2) { u32x4 w; w.x = cvtpk(s[2 * k2][qt][0], s[2 * k2][qt][1]); w.y = cvtpk(s[2 * k2][qt][2], s[2 * k2][qt][3]);
                w.z = cvtpk(s[2 * k2 + 1][qt][0], s[2 * k2 + 1][qt][1]); w.w = cvtpk(s[2 * k2 + 1][qt][2], s[2 * k2 + 1][qt][3]); pf[qt][k2] = mk_frag(w); }
        }
        {
            const LAS bf16_t* vp0 = Vs + l15 * 72 + 4 * q4;
            bf16x8 va[2], vb[2];
#define AT_LDV(dst, dt) do { _Pragma("unroll") for (int k2 = 0; k2 < 2; ++k2) { const LAS bf16_t* vp = vp0 + (16 * (dt)) * 72 + 32 * k2; dst[k2] = mk_frag2(*(const LAS u32x2*)vp, *(const LAS u32x2*)(vp + 16)); } } while (0)
#define AT_MMO(src, dt) do { _Pragma("unroll") for (int k2 = 0; k2 < 2; ++k2) { ao[dt][0] = MFMA16(src[k2], pf[0][k2], ao[dt][0]); ao[dt][1] = MFMA16(src[k2], pf[1][k2], ao[dt][1]); } } while (0)
            AT_LDV(va, 0); AT_LDV(vb, 1); __builtin_amdgcn_sched_barrier(0);
            AT_MMO(va, 0); __builtin_amdgcn_sched_barrier(0); AT_LDV(va, 2); __builtin_amdgcn_sched_barrier(0);
            AT_MMO(vb, 1); __builtin_amdgcn_sched_barrier(0); AT_LDV(vb, 3); __builtin_amdgcn_sched_barrier(0);
            AT_MMO(va, 2); __builtin_amdgcn_sched_barrier(0); AT_LDV(va, 4); __builtin_amdgcn_sched_barrier(0);
            AT_MMO(vb, 3); __builtin_amdgcn_sched_barrier(0); AT_LDV(vb, 5); __builtin_amdgcn_sched_barrier(0);
            AT_MMO(va, 4); __builtin_amdgcn_sched_barrier(0); AT_LDV(va, 6); __builtin_amdgcn_sched_barrier(0);
            AT_MMO(vb, 5); __builtin_amdgcn_sched_barrier(0); AT_LDV(vb, 7); __builtin_amdgcn_sched_barrier(0);
            AT_MMO(va, 6); __builtin_amdgcn_sched_barrier(0);
            AT_MMO(vb, 7); __builtin_amdgcn_sched_barrier(0);
#undef AT_LDV
#undef AT_MMO
        }
        if (MODE == 1) {
#pragma unroll
            for (int nt = 0; nt < 4; ++nt)
#pragma unroll
                for (int k2 = 0; k2 < 2; ++k2) {
                    const int n = 16 * nt + l15, cb = 64 * j + 32 * k2 + 4 * q4;
                    unsigned e[8];
#pragma unroll
                    for (int jj = 0; jj < 8; ++jj) { const int c = cb + (jj < 4 ? jj : 12 + jj); e[jj] = (c >= 4 * n - 1 && c <= 4 * n + 3) ? 0x3F80u : 0u; }
                    u32x4 w; w.x = e[0] | (e[1] << 16); w.y = e[2] | (e[3] << 16); w.z = e[4] | (e[5] << 16); w.w = e[6] | (e[7] << 16);
                    const bf16x8 of = mk_frag(w);
                    ai[nt][0] = MFMA16(of, pf[0][k2], ai[nt][0]); ai[nt][1] = MFMA16(of, pf[1][k2], ai[nt][1]);
                }
        }
        if (!more) break;
        buf ^= 1;
        j = jn;
    }
#undef AT_LOAD
    float inv[2];
#pragma unroll
    for (int qt = 0; qt < 2; ++qt) { const float l = xq_sum(lsum[qt]); inv[qt] = l > 0.f ? 1.f / l : 0.f; }
    if (MODE == 0 || MODE == 1) {
        bf16_t* ob = (MODE == 0) ? P.ow() : P.oc();
        const int lane2 = opaque_tid() & 63;
        const int l15b = lane2 & 15, q4b = lane2 >> 4;
#pragma unroll
        for (int qt = 0; qt < 2; ++qt) { const size_t tok = (size_t)b * SEQ + 64 * qb + 32 * qhalf + 16 * qt + l15b;
#pragma unroll
            for (int dt = 0; dt < 8; ++dt) { const f32x4 o = ao[dt][qt] * inv[qt]; u32x2 w; w.x = cvtpk(o[0], o[1]); w.y = cvtpk(o[2], o[3]);
                *(u32x2*)(ob + tok * 2048 + head * 128 + 16 * dt + 4 * q4b) = w; } }
    }
    if (MODE == 1) {
        __syncthreads();
#pragma unroll
        for (int qt = 0; qt < 2; ++qt)
#pragma unroll
            for (int nt = 0; nt < 4; ++nt) { const int lane3 = opaque_tid() & 63; *(LAS f32x4*)(imps + (hd * 64 + 32 * qhalf + 16 * qt + (lane3 & 15)) * 64 + 16 * nt + 4 * (lane3 >> 4)) = ai[nt][qt] * inv[qt]; }
        __syncthreads();
        unsigned long long uni = 0ull;
        const unsigned long long validm = (qb >= 63) ? ~0ull : ((2ull << qb) - 1ull);
        for (int qq0 = 0; qq0 < 8; qq0 += 4) {
            unsigned key[4]; unsigned long long mk[4];
#pragma unroll
            for (int u = 0; u < 4; ++u) { const int tl = 8 * wave + qq0 + u;
                float v = imps[(0 * 64 + tl) * 64 + lane] + imps[(1 * 64 + tl) * 64 + lane] + imps[(2 * 64 + tl) * 64 + lane] + imps[(3 * 64 + tl) * 64 + lane];
                if (lane == 0 || lane == qb || lane == qb - 1) v = 1e4f;
                key[u] = (lane <= qb) ? __builtin_bit_cast(unsigned, fmaxf(v, 0.f)) : 0u; }
            if (qb < 16) {
#pragma unroll
                for (int u = 0; u < 4; ++u) mk[u] = validm;
            } else {
                unsigned T[4] = {0u, 0u, 0u, 0u};
                for (int bit = 30; bit >= 0; --bit) {
#pragma unroll
                    for (int u = 0; u < 4; ++u) { const unsigned cand = T[u] | (1u << bit); const int cnt = __builtin_popcountll(__ballot(key[u] >= cand));
                        T[u] = cnt >= 16 ? cand : T[u]; }
                }
#pragma unroll
                for (int u = 0; u < 4; ++u) { const unsigned long long gt = __ballot(key[u] > T[u]), eq = __ballot(key[u] == T[u]) & validm;
                    const int r = 16 - __builtin_popcountll(gt);
                    const int below = (int)__builtin_amdgcn_mbcnt_hi((unsigned)(eq >> 32), __builtin_amdgcn_mbcnt_lo((unsigned)eq, 0u));
                    mk[u] = gt | __ballot(key[u] == T[u] && lane <= qb && below < r); }
            }
#pragma unroll
            for (int u = 0; u < 4; ++u) { uni |= mk[u]; if (lane == 0) P.sel()[(size_t)bg * SEQ + 64 * qb + 8 * wave + qq0 + u] = mk[u]; }
        }
        if (lane == 0) { um[2 * wave] = (unsigned)uni; um[2 * wave + 1] = (unsigned)(uni >> 32); }
        __syncthreads();
        if (tid == 0) { unsigned lo = 0u, hi = 0u; for (int w = 0; w < 8; ++w) { lo |= um[2 * w]; hi |= um[2 * w + 1]; } P.selu()[bg * 64 + qb] = ((unsigned long long)hi << 32) | lo; }
    }
    if (MODE == 2) {
#pragma unroll
        for (int qt = 0; qt < 2; ++qt) { const size_t tok = (size_t)b * SEQ + 64 * qb + 32 * qhalf + 16 * qt + l15;
            const float* gp = P.small() + tok * 64 + 16 + head * 3;
            const float g0 = sigmoidf_(gp[0]), g1 = sigmoidf_(gp[1]), g2 = sigmoidf_(gp[2]);
#pragma unroll
            for (int dt = 0; dt < 8; ++dt) { const int col = head * 128 + 16 * dt + 4 * q4;
                const u32x2 cw = *(const u32x2*)(P.oc() + tok * 2048 + col), ww = *(const u32x2*)(P.ow() + tok * 2048 + col), zw = *(const u32x2*)(P.U() + tok * UW + UNZ + col);
                const f32x4 o = ao[dt][qt] * inv[qt];
                const float y0 = (g0 * bflo(cw.x) + g1 * o[0] + g2 * bflo(ww.x)) * siluf_(bflo(zw.x)), y1 = (g0 * bfhi(cw.x) + g1 * o[1] + g2 * bfhi(ww.x)) * siluf_(bfhi(zw.x));
                const float y2 = (g0 * bflo(cw.y) + g1 * o[2] + g2 * bflo(ww.y)) * siluf_(bflo(zw.y)), y3 = (g0 * bfhi(cw.y) + g1 * o[3] + g2 * bfhi(ww.y)) * siluf_(bfhi(zw.y));
                u32x2 w; w.x = cvtpk(y0, y1); w.y = cvtpk(y2, y3);
                *(u32x2*)(P.y() + tok * DM + 2048 + col) = w; } }
    }
    __syncthreads();
}

typedef float f32x16 __attribute__((ext_vector_type(16)));
#define MFMA32(a, b, c) __builtin_amdgcn_mfma_f32_32x32x16_bf16((a), (b), (c), 0, 0, 0)
__device__ __forceinline__ float half_swap_max(float v) { float a = v, b = v; swap32(a, b); return fmaxf(a, b); }
__device__ __forceinline__ float half_swap_sum(float v) { float a = v, b = v; swap32(a, b); return a + b; }
template <int MODE>
__device__ __forceinline__ void attn_fast(const Params& P, LAS unsigned char* lds_, int bg, int qb) {
    LAS unsigned char* lds = opq(lds_);
    const int tid = opaque_tid(), lane = tid & 63, wave = tid >> 6, r32 = lane & 31, hi = lane >> 5;
    const int b = bg >> 2, g = bg & 3, hd = wave >> 1, qhalf = wave & 1, head = g * 4 + hd, tl = 32 * qhalf + r32;
    constexpr int BUFB = 35840;
    LAS float* tab = (LAS float*)(lds + 3 * BUFB);
    LAS float* tabR = tab + 4 * 132;
    unsigned long long pset, sset;
    {
        const unsigned long long upto = (2ull << qb) - 1ull;
        const unsigned long long near = upto & ~((qb >= 3) ? ((1ull << (qb - 2)) - 1ull) : 0ull);
        if (MODE == 0) { const int jl = qb - 8 < 0 ? 0 : qb - 8; const unsigned long long win = upto & ~((1ull << jl) - 1ull);
            sset = near | ((qb >= 8) ? (1ull << (qb - 8)) : 0ull); pset = win & ~sset; }
        else { const unsigned long long un = P.selu()[bg * 64 + qb] & upto; sset = near & un; pset = un & ~near; }
    }
    const int krow = tid >> 4, kc16 = tid & 15, vrow = tid >> 3, vc8 = tid & 7;
    const bf16_t* kbase = P.U() + ((size_t)b * SEQ + krow) * UW + (MODE == 0 ? UKW : UKS) + g * 128 + 8 * kc16;
    const bf16_t* vbase = P.T() + (size_t)((MODE == 0 ? TVW : TVS) + g * 128 + vrow) * MTOK + (size_t)b * SEQ + 8 * vc8;
    f32x4 kw0 = {1.f, 1.f, 1.f, 1.f}, kw1 = {1.f, 1.f, 1.f, 1.f};
    if (MODE == 0) { const float* kw = P.knorm_w + 256 + 8 * kc16; kw0 = *(const f32x4*)kw; kw1 = *(const f32x4*)(kw + 4); }
    u32x4 kr[2], vr[2];
#define AF_LOAD(J) do { _Pragma("unroll") for (int _i = 0; _i < 2; ++_i) { kr[_i] = *(const u32x4*)(kbase + (size_t)(J) * 64 * UW + (size_t)_i * 32 * UW); vr[_i] = *(const u32x4*)(vbase + (size_t)(J) * 64 + (size_t)_i * 64 * MTOK); } } while (0)
    bf16x8 qf[8];
    {
        const size_t tok = (size_t)b * SEQ + 64 * qb + tl;
        u32x4 raw[8]; float ss = 0.f;
#pragma unroll
        for (int ks = 0; ks < 8; ++ks) raw[ks] = *(const u32x4*)(P.U() + tok * UW + UNQ + head * 128 + 16 * ks + 8 * hi);
        __builtin_amdgcn_sched_barrier(0);
        { const int jf_ = pset ? __builtin_ctzll(pset) : (sset ? __builtin_ctzll(sset) : 0); AF_LOAD(jf_); }
        __builtin_amdgcn_sched_barrier(0);
    for (int i = tid; i < 4 * 129; i += 512) { const int hh = i / 129, dd = i % 129; tab[hh * 132 + dd] = P.rel_bias[rel_bucket(dd) * 16 + g * 4 + hh] * LOG2E; }
    for (int i = tid; i < 4 * 320; i += 512) { const int hh = i / 320, ii = i % 320; const int dd = 191 - ii;
        tabR[hh * 320 + ii] = (dd >= 0) ? P.rel_bias[rel_bucket(dd > 128 ? 128 : dd) * 16 + g * 4 + hh] * LOG2E : -INFINITY; }
        __builtin_amdgcn_sched_barrier(0);
#pragma unroll
        for (int ks = 0; ks < 8; ++ks) {
            const float a0 = bflo(raw[ks].x), a1 = bfhi(raw[ks].x), a2 = bflo(raw[ks].y), a3 = bfhi(raw[ks].y), a4 = bflo(raw[ks].z), a5 = bfhi(raw[ks].z), a6 = bflo(raw[ks].w), a7 = bfhi(raw[ks].w);
            ss += a0 * a0 + a1 * a1 + a2 * a2 + a3 * a3 + a4 * a4 + a5 * a5 + a6 * a6 + a7 * a7; }
        ss = half_swap_sum(ss);
        const float sc = __builtin_amdgcn_rsqf(ss * (1.f / 128.f) + EPS) * (0.08838834764831845f * LOG2E);
#pragma unroll
        for (int ks = 0; ks < 8; ++ks) { const f32x4 w0 = *(const f32x4*)(P.qnorm_w + 16 * ks + 8 * hi), w1 = *(const f32x4*)(P.qnorm_w + 16 * ks + 8 * hi + 4);
            u32x4 w; w.x = cvtpk(bflo(raw[ks].x) * sc * w0[0], bfhi(raw[ks].x) * sc * w0[1]); w.y = cvtpk(bflo(raw[ks].y) * sc * w0[2], bfhi(raw[ks].y) * sc * w0[3]);
            w.z = cvtpk(bflo(raw[ks].z) * sc * w1[0], bfhi(raw[ks].z) * sc * w1[1]); w.w = cvtpk(bflo(raw[ks].w) * sc * w1[2], bfhi(raw[ks].w) * sc * w1[3]);
            qf[ks] = mk_frag(w); }
    }
    unsigned long long smask = ~0ull;
    if (MODE == 2) smask = P.sel()[(size_t)bg * SEQ + 64 * qb + tl];
    f32x16 o[4];
#pragma unroll
    for (int dt = 0; dt < 4; ++dt)
#pragma unroll
        for (int r = 0; r < 16; ++r) o[dt][r] = 0.f;
    float mrun = -1e30f, lrun = 0.f;
#define AF_WRITE(BUF) do { LAS bf16_t* Ks_ = (LAS bf16_t*)(lds + (BUF) * BUFB); LAS bf16_t* Vs_ = (LAS bf16_t*)(lds + (BUF) * BUFB + 17408); \
        _Pragma("unroll") for (int i = 0; i < 2; ++i) { u32x4 raw = kr[i]; \
            if (MODE == 0) { float v[8] = {bflo(raw.x), bfhi(raw.x), bflo(raw.y), bfhi(raw.y), bflo(raw.z), bfhi(raw.z), bflo(raw.w), bfhi(raw.w)}; float ss = 0.f; \
                _Pragma("unroll") for (int e = 0; e < 8; ++e) ss += v[e] * v[e]; \
                ss = row16_sum(ss); const float rstd = __builtin_amdgcn_rsqf(ss * (1.f / 128.f) + EPS); \
                raw.x = cvtpk(v[0] * rstd * kw0[0], v[1] * rstd * kw0[1]); raw.y = cvtpk(v[2] * rstd * kw0[2], v[3] * rstd * kw0[3]); \
                raw.z = cvtpk(v[4] * rstd * kw1[0], v[5] * rstd * kw1[1]); raw.w = cvtpk(v[6] * rstd * kw1[2], v[7] * rstd * kw1[3]); } \
            *(LAS u32x4*)(Ks_ + (krow + 32 * i) * 136 + 8 * kc16) = raw; \
            LAS bf16_t* vp_ = Vs_ + (vrow + 64 * i) * 72 + 16 * (vc8 >> 1) + 4 * (vc8 & 1); \
            *(LAS u32x2*)vp_ = (u32x2){vr[i].x, vr[i].y}; *(LAS u32x2*)(vp_ + 8) = (u32x2){vr[i].z, vr[i].w}; } } while (0)
#define AF_LDK(DST, KP, KS2) do { DST[0] = *(const LAS bf16x8*)((KP) + 32 * (KS2)); DST[1] = *(const LAS bf16x8*)((KP) + 32 * 136 + 32 * (KS2)); \
                                  DST[2] = *(const LAS bf16x8*)((KP) + 32 * (KS2) + 16); DST[3] = *(const LAS bf16x8*)((KP) + 32 * 136 + 32 * (KS2) + 16); } while (0)
#define AF_MMK(SRC, S0, S1, KS2) do { S0 = MFMA32(SRC[0], qf[2 * (KS2)], S0); S1 = MFMA32(SRC[1], qf[2 * (KS2)], S1); S0 = MFMA32(SRC[2], qf[2 * (KS2) + 1], S0); S1 = MFMA32(SRC[3], qf[2 * (KS2) + 1], S1); } while (0)
#define AF_S(S0, S1, BUF) do { const LAS bf16_t* kp = (const LAS bf16_t*)(lds + (BUF) * BUFB) + r32 * 136 + 8 * hi; \
        bf16x8 fa[4], fb[4]; \
        _Pragma("unroll") for (int r = 0; r < 16; ++r) { S0[r] = 0.f; S1[r] = 0.f; } \
        AF_LDK(fa, kp, 0); AF_LDK(fb, kp, 1); __builtin_amdgcn_sched_barrier(0); \
        AF_MMK(fa, S0, S1, 0); __builtin_amdgcn_sched_barrier(0); AF_LDK(fa, kp, 2); __builtin_amdgcn_sched_barrier(0); \
        AF_MMK(fb, S0, S1, 1); __builtin_amdgcn_sched_barrier(0); AF_LDK(fb, kp, 3); __builtin_amdgcn_sched_barrier(0); \
        AF_MMK(fa, S0, S1, 2); __builtin_amdgcn_sched_barrier(0); \
        AF_MMK(fb, S0, S1, 3); __builtin_amdgcn_sched_barrier(0); } while (0)
#define AF_SMH(S0, S1, CB, ALPHA) do { float mx = fmaxf(S0[0], S1[0]); \
        _Pragma("unroll") for (int r = 1; r < 16; ++r) mx = fmaxf(mx, fmaxf(S0[r], S1[r])); \
        mx = half_swap_max(mx) + (CB); \
        const bool keep = __all(mx - mrun <= 11.5f); \
        const float mn = keep ? mrun : fmaxf(mrun, mx); ALPHA = __builtin_amdgcn_exp2f(mrun - mn); mrun = mn; \
        const float cc = (CB) - mn; \
        _Pragma("unroll") for (int r = 0; r < 16; ++r) { S0[r] = __builtin_amdgcn_exp2f(S0[r] + cc); S1[r] = __builtin_amdgcn_exp2f(S1[r] + cc); } } while (0)
#define AF_SMT(S0, S1, ALPHA) do { float ps = S0[0] + S1[0]; \
        _Pragma("unroll") for (int r = 1; r < 16; ++r) ps += S0[r] + S1[r]; \
        ps = half_swap_sum(ps); lrun = lrun * (ALPHA) + ps; \
        _Pragma("unroll") for (int s2 = 0; s2 < 2; ++s2) { \
            u32x4 w; w.x = cvtpk(S0[8 * s2 + 0], S0[8 * s2 + 1]); w.y = cvtpk(S0[8 * s2 + 2], S0[8 * s2 + 3]); w.z = cvtpk(S0[8 * s2 + 4], S0[8 * s2 + 5]); w.w = cvtpk(S0[8 * s2 + 6], S0[8 * s2 + 7]); pf[0][s2] = mk_frag(w); \
            u32x4 x; x.x = cvtpk(S1[8 * s2 + 0], S1[8 * s2 + 1]); x.y = cvtpk(S1[8 * s2 + 2], S1[8 * s2 + 3]); x.z = cvtpk(S1[8 * s2 + 4], S1[8 * s2 + 5]); x.w = cvtpk(S1[8 * s2 + 6], S1[8 * s2 + 7]); pf[1][s2] = mk_frag(x); } } while (0)
#define AF_RESC(ALPHA) do { if (__any((ALPHA) != 1.f)) { _Pragma("unroll") for (int dt = 0; dt < 4; ++dt) o[dt] = o[dt] * (ALPHA); } } while (0)
#define AF_LDV(DST, VP, dt) do { _Pragma("unroll") for (int kh = 0; kh < 2; ++kh) _Pragma("unroll") for (int s2 = 0; s2 < 2; ++s2) { \
            DST[2 * kh + s2] = *(const LAS bf16x8*)((VP) + (32 * (dt)) * 72 + 32 * kh + 16 * s2); } } while (0)
#define AF_MMV(SRC, dt) do { o[dt] = MFMA32(SRC[0], pf[0][0], o[dt]); o[dt] = MFMA32(SRC[1], pf[0][1], o[dt]); o[dt] = MFMA32(SRC[2], pf[1][0], o[dt]); o[dt] = MFMA32(SRC[3], pf[1][1], o[dt]); } while (0)
#define AF_VP(BUF) ((const LAS bf16_t*)(lds + (BUF) * BUFB + 17408) + r32 * 72 + 8 * hi)
#define AF_PV(BUF) do { const LAS bf16_t* vp0 = AF_VP(BUF); bf16x8 va[4], vb[4]; \
        AF_LDV(va, vp0, 0); AF_LDV(vb, vp0, 1); __builtin_amdgcn_sched_barrier(0); \
        AF_MMV(va, 0); __builtin_amdgcn_sched_barrier(0); AF_LDV(va, vp0, 2); __builtin_amdgcn_sched_barrier(0); \
        AF_MMV(vb, 1); __builtin_amdgcn_sched_barrier(0); AF_LDV(vb, vp0, 3); __builtin_amdgcn_sched_barrier(0); \
        AF_MMV(va, 2); __builtin_amdgcn_sched_barrier(0); AF_MMV(vb, 3); __builtin_amdgcn_sched_barrier(0); } while (0)
#define AF_PV_SMH(BUF, S0, S1, CB, ALPHA) do { const LAS bf16_t* vp0 = AF_VP(BUF); bf16x8 va[4], vb[4]; float mx; \
        AF_LDV(va, vp0, 0); AF_LDV(vb, vp0, 1); __builtin_amdgcn_sched_barrier(0); \
        AF_MMV(va, 0); mx = fmaxf(S0[0], S0[1]); _Pragma("unroll") for (int r = 2; r < 16; ++r) mx = fmaxf(mx, S0[r]); __builtin_amdgcn_sched_barrier(0); \
        AF_LDV(va, vp0, 2); __builtin_amdgcn_sched_barrier(0); \
        AF_MMV(vb, 1); _Pragma("unroll") for (int r = 0; r < 16; ++r) mx = fmaxf(mx, S1[r]); \
        mx = half_swap_max(mx) + (CB); \
        const bool keep = __all(mx - mrun <= 11.5f); \
        const float mn = keep ? mrun : fmaxf(mrun, mx); ALPHA = __builtin_amdgcn_exp2f(mrun - mn); mrun = mn; \
        const float cc = (CB) - mn; __builtin_amdgcn_sched_barrier(0); \
        AF_LDV(vb, vp0, 3); __builtin_amdgcn_sched_barrier(0); \
        AF_MMV(va, 2); _Pragma("unroll") for (int r = 0; r < 16; ++r) S0[r] = __builtin_amdgcn_exp2f(S0[r] + cc); __builtin_amdgcn_sched_barrier(0); \
        AF_MMV(vb, 3); _Pragma("unroll") for (int r = 0; r < 16; ++r) S1[r] = __builtin_amdgcn_exp2f(S1[r] + cc); __builtin_amdgcn_sched_barrier(0); } while (0)
    bf16x8 pf[2][2];
    const float cbias = 0.f;
    (void)cbias;
    unsigned long long srem = sset; int js = -1;
    if (srem) { js = __builtin_ctzll(srem); srem &= srem - 1ull; }
    if (pset) {
        unsigned long long rem = pset;
        f32x16 s0, s1; float al = 1.f;
        int jt0 = __builtin_ctzll(rem); rem &= rem - 1ull;
        AF_WRITE(0);
        int jn1 = -1; if (rem) { jn1 = __builtin_ctzll(rem); rem &= rem - 1ull; AF_LOAD(jn1); }
        __syncthreads();
        const float cb_all = tab[hd * 132 + 128];
#define AF_CB(J) ((MODE == 2) ? ((((smask >> (J)) & 1ull) != 0ull) ? cb_all : -INFINITY) : cb_all)
        int bufS = 0;
        if (jn1 >= 0) AF_WRITE(1);
        int jn2 = -1; if (rem) { jn2 = __builtin_ctzll(rem); rem &= rem - 1ull; AF_LOAD(jn2); }
        AF_S(s0, s1, 0);
        { const float cb = AF_CB(jt0); AF_SMH(s0, s1, cb, al); }
        AF_RESC(al);
        int jcur = jn1, jnext = jn2;
        while (jcur >= 0) {
            const int bufN = bufS == 2 ? 0 : bufS + 1;
            const int bufW = bufN == 2 ? 0 : bufN + 1;
            __syncthreads();
            if (jnext >= 0) AF_WRITE(bufW);
            int jn3 = -1; if (rem) { jn3 = __builtin_ctzll(rem); rem &= rem - 1ull; AF_LOAD(jn3); }
            AF_SMT(s0, s1, al);
            __builtin_amdgcn_sched_barrier(0);
            AF_S(s0, s1, bufN);
            { const float cb = AF_CB(jcur); AF_PV_SMH(bufS, s0, s1, cb, al); }
            AF_RESC(al);
            bufS = bufN; jcur = jnext; jnext = jn3;
        }
        if (js >= 0) AF_LOAD(js);
        AF_SMT(s0, s1, al);
        AF_PV(bufS);
    }
    if (js >= 0) {
        __syncthreads();
        int sb = 0;
        while (js >= 0) {
            const int j = js;
            AF_WRITE(sb);
            __syncthreads();
            js = -1; if (srem) { js = __builtin_ctzll(srem); srem &= srem - 1ull; AF_LOAD(js); }
            f32x16 s0, s1; float al;
            AF_S(s0, s1, sb);
            const bool selok = (MODE == 2) ? (((smask >> j) & 1ull) != 0ull) : true;
            if (MODE == 0 && qb - j == 8) {
                const float cbe = tab[hd * 132 + 128];
#pragma unroll
                for (int kh = 0; kh < 2; ++kh)
#pragma unroll
                    for (int rq = 0; rq < 4; ++rq)
#pragma unroll
                        for (int e2 = 0; e2 < 4; ++e2) { const int kl = 32 * kh + 8 * rq + 4 * hi + e2; const bool ok = (512 + tl - kl) < 512;
                            if (kh == 0) s0[4 * rq + e2] = ok ? s0[4 * rq + e2] + cbe : -INFINITY; else s1[4 * rq + e2] = ok ? s1[4 * rq + e2] + cbe : -INFINITY; }
            } else {
                int bi = 191 - 64 * (qb - j) - tl + 4 * hi;
                if (MODE == 2 && !selok) bi = 256;
                const LAS float* tp = tabR + hd * 320 + bi;
#pragma unroll
                for (int kh = 0; kh < 2; ++kh)
#pragma unroll
                    for (int rq = 0; rq < 4; ++rq) {
                        float tb[4];
#pragma unroll
                        for (int e2 = 0; e2 < 4; ++e2) tb[e2] = tp[32 * kh + 8 * rq + e2];
                        asm volatile("" : "+v"(tb[0]), "+v"(tb[1]), "+v"(tb[2]), "+v"(tb[3]));
#pragma unroll
                        for (int e2 = 0; e2 < 4; ++e2) { if (kh == 0) s0[4 * rq + e2] += tb[e2]; else s1[4 * rq + e2] += tb[e2]; }
                    }
            }
            AF_SMH(s0, s1, 0.f, al);
            AF_SMT(s0, s1, al);
            AF_RESC(al);
            AF_PV(sb);
            sb ^= 1;
        }
    }
#undef AF_LOAD
#undef AF_WRITE
#undef AF_S
#undef AF_SMH
#undef AF_SMT
#undef AF_RESC
#undef AF_PV
#undef AF_PV_SMH
#undef AF_LDK
#undef AF_MMK
#undef AF_LDV
#undef AF_MMV
#undef AF_VP
#undef AF_CB
    const float inv = lrun > 0.f ? 1.f / lrun : 0.f;
    __syncthreads();
    {
        int lane2 = lane; asm volatile("" : "+v"(lane2));
        LAS bf16_t* ost = (LAS bf16_t*)lds + (size_t)(hd * 64 + 32 * qhalf + (lane2 & 31)) * 136 + 4 * (lane2 >> 5);
#pragma unroll
        for (int dt = 0; dt < 4; ++dt)
#pragma unroll
            for (int rq = 0; rq < 4; ++rq) { u32x2 w; w.x = cvtpk(o[dt][4 * rq] * inv, o[dt][4 * rq + 1] * inv); w.y = cvtpk(o[dt][4 * rq + 2] * inv, o[dt][4 * rq + 3] * inv);
                *(LAS u32x2*)(ost + 32 * dt + 8 * rq) = w; }
    }
    __syncthreads();
    {
        int tid2 = tid; asm volatile("" : "+v"(tid2));
#pragma unroll
        for (int i = 0; i < 8; ++i) {
            const int id = tid2 + 512 * i, R = id >> 4, c = id & 15, hd2 = R >> 6;
            const size_t tok = (size_t)b * SEQ + 64 * qb + (R & 63); const int col = (g * 4 + hd2) * 128 + 8 * c;
            const u32x4 ov = *(const LAS u32x4*)((const LAS bf16_t*)lds + R * 136 + 8 * c);
            if (MODE == 0) { *(u32x4*)(P.ow() + tok * 2048 + col) = ov; }
            else {
                const u32x4 cw = *(const u32x4*)(P.oc() + tok * 2048 + col), ww = *(const u32x4*)(P.ow() + tok * 2048 + col), zw = *(const u32x4*)(P.U() + tok * UW + UNZ + col);
                const float* gp = P.small() + tok * 64 + 16 + (g * 4 + hd2) * 3;
                const float g0 = sigmoidf_(gp[0]), g1 = sigmoidf_(gp[1]), g2 = sigmoidf_(gp[2]);
                float y[8];
#define AF_Y(k, C, O, W, Z) y[2 * (k)] = (g0 * bflo(C) + g1 * bflo(O) + g2 * bflo(W)) * siluf_(bflo(Z)); y[2 * (k) + 1] = (g0 * bfhi(C) + g1 * bfhi(O) + g2 * bfhi(W)) * siluf_(bfhi(Z))
                AF_Y(0, cw.x, ov.x, ww.x, zw.x); AF_Y(1, cw.y, ov.y, ww.y, zw.y); AF_Y(2, cw.z, ov.z, ww.z, zw.z); AF_Y(3, cw.w, ov.w, ww.w, zw.w);
#undef AF_Y
#pragma unroll
                for (int k = 0; k < 8; ++k) y[k] = __builtin_amdgcn_fmed3f(16.f * y[k], -440.f, 440.f);
                u32x2 q; q.x = pk_fp8x4(y[0], y[1], y[2], y[3]); q.y = pk_fp8x4(y[4], y[5], y[6], y[7]);
                *(u32x2*)(P.y8() + tok * 2048 + col) = q;
            }
        }
    }
    __syncthreads();
}

#ifndef R_CMP
#define R_CMP 1
#endif
#ifndef R_WIN
#define R_WIN 1
#endif
#ifndef R_ML1
#define R_ML1 1
#endif
#ifndef R_CA
#define R_CA 1
#endif
#ifndef R_ML2
#define R_ML2 1
#endif
#ifndef R_SEL
#define R_SEL 1
#endif
#ifndef R_ML3
#define R_ML3 1
#endif
#ifndef REP_P0
#define REP_P0 1
#endif
#ifndef REP_P1
#define REP_P1 1
#endif
#ifndef REP_P2
#define REP_P2 1
#endif
#ifndef REP_P3
#define REP_P3 1
#endif
#ifndef REP_P4
#define REP_P4 1
#endif
#ifndef REP_P5
#define REP_P5 1
#endif
constexpr int LDS_BYTES = 147456 + 1024;
constexpr int LDS_SLOT = 147456;


__device__ __forceinline__ int next_task(unsigned* ctr, LAS unsigned char* lds_) {
    LAS int* slot = (LAS int*)(opq(lds_) + LDS_SLOT);
    __syncthreads();
    if (opaque_tid() == 0) *slot = (int)atomicAdd(ctr, 1u);
    __syncthreads();
    return *slot;
}

#define XB_TMO      128
#define XB_XCNT(j)  (256  + 64 * (j))
#define XB_XSUB(j)  (1280 + 64 * (j))
#define XB_XGEN(j)  (2304 + 64 * (j))
#define XB_TOP      3328
#define XB_TOPGEN   3392
#define XCD_BAR_WORDS 3456
#define XB_SPIN_CAP (1u << 18)
__device__ __forceinline__ unsigned xb_ld(unsigned* p)              { return __hip_atomic_load(p, __ATOMIC_RELAXED, __HIP_MEMORY_SCOPE_AGENT); }
__device__ __forceinline__ unsigned xb_add(unsigned* p, unsigned v) { return __hip_atomic_fetch_add(p, v, __ATOMIC_RELAXED, __HIP_MEMORY_SCOPE_AGENT); }
__device__ __forceinline__ unsigned xb_xcc_id() { return (unsigned)__builtin_amdgcn_s_getreg((3 << 11) | 20) & 0xFu; }
#define XB_SPIN(cond, bar) do { unsigned _sp = 0; while (cond) { __builtin_amdgcn_s_sleep(1); \
    if ((++_sp & 255u) == 0u) { if (xb_ld(&(bar)[XB_TMO])) break; if (_sp > XB_SPIN_CAP) { atomicAdd(&(bar)[XB_TMO], 1u); break; } } } } while (0)
__device__ __forceinline__ void xcd_barrier_post(unsigned* bar) { if (opaque_tid() == 0) (void)xb_add(&bar[XB_XCNT(xb_xcc_id())], 1u); }
__device__ __forceinline__ void xcd_barrier_complete(unsigned* bar, unsigned x, unsigned& nloc, unsigned& nx) {
    const unsigned G = gridDim.x * gridDim.y * gridDim.z;
    unsigned sum, cnt, mine, sp = 0u;
    for (;;) {
        sum = 0u; cnt = 0u; mine = 0u;
#pragma unroll
        for (unsigned j = 0; j < 16; ++j) { const unsigned c = xb_ld(&bar[XB_XCNT(j)]); sum += c; cnt += (c > 0u) ? 1u : 0u; mine = (j == x) ? c : mine; }
        if (sum == G) break;
        __builtin_amdgcn_s_sleep(1);
        if ((++sp & 255u) == 0u) { if (xb_ld(&bar[XB_TMO])) break; if (sp > XB_SPIN_CAP) { atomicAdd(&bar[XB_TMO], 1u); break; } }
    }
    nloc = mine > 0u ? mine : 1u; nx = cnt > 0u ? cnt : 1u;
}
__device__ __forceinline__ void xcd_barrier(unsigned* bar, volatile LAS unsigned* st) {
    asm volatile("s_waitcnt vmcnt(0)" ::: "memory");
    __syncthreads();
    if (opaque_tid() == 0) {
        const unsigned x = xb_xcc_id();
        __builtin_amdgcn_s_waitcnt(0);
        unsigned nloc = st[0], nx = st[1];
        if (nloc == 0u) { xcd_barrier_complete(bar, x, nloc, nx); st[0] = nloc; st[1] = nx; }
        const unsigned old = xb_add(&bar[XB_XSUB(x)], 1u);
        const unsigned gen = old / nloc;
        if (old + 1u == (gen + 1u) * nloc) {
            __builtin_amdgcn_fence(__ATOMIC_RELEASE, "agent");
            asm volatile("s_waitcnt vmcnt(0)" ::: "memory");
            const unsigned og = xb_add(&bar[XB_TOP], 1u);
            const unsigned tg = og / nx;
            if (og + 1u == (tg + 1u) * nx) xb_add(&bar[XB_TOPGEN], 1u);
            else XB_SPIN(xb_ld(&bar[XB_TOPGEN]) == tg, bar);
            __builtin_amdgcn_fence(__ATOMIC_ACQUIRE, "agent");
            xb_add(&bar[XB_XGEN(x)], 1u);
            asm volatile("s_waitcnt vmcnt(0)" ::: "memory");
        } else {
            XB_SPIN(xb_ld(&bar[XB_XGEN(x)]) == gen, bar);
            __builtin_amdgcn_fence(__ATOMIC_ACQUIRE, "agent");
            asm volatile("s_waitcnt vmcnt(0)" ::: "memory");
        }
    }
    __syncthreads();
}

struct KArgs { const float* in[20]; float* out; unsigned char* ws; };
__global__ void __launch_bounds__(512, 2) hymba_mega(KArgs ka) {
    Params P; fill_params(P, (void* const*)ka.in, (void*)ka.out, (void*)ka.ws);
    cg::grid_group grid = cg::this_grid();
    LAS unsigned char* lds = (LAS unsigned char*)dyn_lds;
    const int bid = blockIdx.x, G = gridDim.x;
    { const int t0 = threadIdx.x;
      if ((t0 & 63) == 0) *(volatile LAS int*)(lds + TID_TAB_OFF + 4 * hw_wave_slot()) = t0 >> 6;
      if (t0 == 0) { *(volatile LAS unsigned*)(lds + LDS_SLOT + 64) = 0u; *(volatile LAS unsigned*)(lds + LDS_SLOT + 68) = 0u; } }
    __syncthreads();
    xcd_barrier_post(P.ctl() + 4096);
    if (ka.out == nullptr) grid.sync();
#define GSYNC() xcd_barrier(P.ctl() + 4096, (volatile LAS unsigned*)(opq(lds) + LDS_SLOT + 64))
#define PH_P0 { phase0(P, lds, bid, G); GSYNC(); }
#define PH_P1 { phase_gemm1(P, lds, bid, G); if (G == 256) { if (bid >= 192) wg_conv_share(P, lds, bid - 192, 64, true); } else wg_conv_share(P, lds, bid, G, true); GSYNC(); }
#define PH_P2(CB) { \
        for (int t = bid; t < 32 * R_CMP + 512 * R_WIN + 512 * R_ML1 + 64; t = G + next_task(P.ctl() + (CB) + 0, lds)) {        \
            if (t < 32 * R_CMP) cmp_gemm_task(P, lds, t % 32); \
            else if (t < 32 * R_CMP + 64) ksnorm_task(P, t - 32 * R_CMP); \
            else if (t < 32 * R_CMP + 64 + 512 * R_WIN) { const int u = (t - 32 * R_CMP - 64) % 512; attn_fast<0>(P, lds, u & 7, 63 - (u >> 3)); } \
            else ml_step1(P, lds, (t - 32 * R_CMP - 64 - 512 * R_WIN) % 512); \
        } \
        GSYNC(); }
#define PH_P3(CB) { \
        for (int t = bid; t < 256 * R_ML2 + 128 * R_CMP; t = G + next_task(P.ctl() + (CB) + 64, lds)) { \
            if (t < 256 * R_ML2) { const int u = t % 256; ml_step2(P, u >> 4, u & 15); } \
            else cmp_task(P, lds, (t - 256 * R_ML2) % 128); \
        } \
        GSYNC(); }
#define PH_P4(CB) { \
        for (int t = bid; t < 512 * R_SEL + 512 * R_ML3; t = G + next_task(P.ctl() + (CB) + 128, lds)) { \
            if (t < 512 * R_SEL) { const int u = t % 512; attn_task<1>(P, lds, u & 7, 63 - (u >> 3)); __threadfence_block(); __syncthreads(); attn_fast<2>(P, lds, u & 7, 63 - (u >> 3)); } \
            else ml_step3(P, lds, (t - 512 * R_SEL) % 512); \
        } \
        GSYNC(); }
#define PH_P5 { const int grp_ = bid % 3; const int npr_ = ((MTOK / 256) * (DM / 256) + G - 1) / G, a_ = grp_ * npr_ / 2;        \
        for (int s_ = 0; s_ < 3; ++s_) { \
            if (s_ == 1) phase_gemm2(P, lds, bid, G); \
            else { if ((grp_ == 0) == (s_ == 2)) wg_conv_share(P, lds, bid, G, false);                                \
                   phase_gemm_pe(P, lds, bid, G, s_ == 0 ? 0 : a_, s_ == 0 ? a_ : npr_ - a_); } } \
        GSYNC(); }
    PH_P0
#if REP_P0 > 1
    PH_P0
#endif
    PH_P1
#if REP_P1 > 1
    PH_P1
#endif
    PH_P2(0)
#if REP_P2 > 1
    PH_P2(256)
#endif
    PH_P3(0)
#if REP_P3 > 1
    PH_P3(256)
#endif
    PH_P4(0)
#if REP_P4 > 1
    PH_P4(256)
#endif
    PH_P5
#if REP_P5 > 1
    PH_P5
#endif
    phase_gemm3(P, lds, bid, G);
}

extern "C" void kernel_launch(void* const* d_in, const int* in_sizes, int n_in, void* d_out, int out_size, void* d_ws, size_t ws_size, hipStream_t stream) {
    static int grid_blocks = 0;
    if (!grid_blocks) {
        if (ws_size < WS_END) { fprintf(stderr, "kernel_launch: workspace too small: %zu < %zu\n", ws_size, (size_t)WS_END); grid_blocks = -1; return; }
        int dev = 0, cus = 0, per_cu = 0;
        (void)hipGetDevice(&dev);
        (void)hipDeviceGetAttribute(&cus, hipDeviceAttributeMultiprocessorCount, dev);
        (void)hipFuncSetAttribute((const void*)hymba_mega, hipFuncAttributeMaxDynamicSharedMemorySize, LDS_BYTES);
        (void)hipOccupancyMaxActiveBlocksPerMultiprocessor(&per_cu, (const void*)hymba_mega, 512, LDS_BYTES);
        if (per_cu < 1) { fprintf(stderr, "kernel_launch: occupancy query says %d blocks per CU\n", per_cu); per_cu = 1; }
        grid_blocks = cus * (per_cu > 1 ? 1 : per_cu);
    }
    if (grid_blocks < 0) return;
    (void)hipMemsetAsync((char*)d_ws + WS_CTL, 0, 32768, stream);
    KArgs ka{}; for (int i = 0; i < 20; ++i) ka.in[i] = (const float*)d_in[i]; ka.out = (float*)d_out; ka.ws = (unsigned char*)d_ws;
    void* args[] = {&ka};
    hipError_t e = hipLaunchCooperativeKernel((const void*)hymba_mega, dim3(grid_blocks), dim3(512), args, LDS_BYTES, stream);
    if (e != hipSuccess) fprintf(stderr, "cooperative launch failed: %s (grid %d)\n", hipGetErrorString(e), grid_blocks);
}
```
